# Optimizing an MI355X kernel written in HIP

```python
import jax, jax.numpy as jnp
from jax import lax
import numpy as np

D_MODEL = 2048
BATCH = 1
SEQ = 8192
DEPTH = 4

N_A = DEPTH // 2
N_B = DEPTH - N_A
MIX = 3 * D_MODEL // 4
MEM_WIDTH = D_MODEL - MIX
POOL_WINDOWS = (2, 4, 8, 16)
N_POOL_GROUPS = len(POOL_WINDOWS)
POOL_CG = MIX // N_POOL_GROUPS
HEAD_DIM = 64
N_Q_HEADS = MIX // HEAD_DIM
N_KV_HEADS = 3
GQA_GROUP = N_Q_HEADS // N_KV_HEADS
WINDOW = 128
BLOCK = 128
MEM_LEN = 256
MEM_HEADS = 4
MEM_HEAD_DIM = MEM_WIDTH // MEM_HEADS
D_FF = 5632
ROPE_THETA = 10000.0
EPS = 1e-5

kernel_name = "yoco_pool_swa_sink_macaron_mem"


def rmsnorm(x, g):
    xf = x.astype(jnp.float32)
    y = xf * lax.rsqrt(jnp.mean(xf * xf, axis=-1, keepdims=True) + EPS)
    return (y * g.astype(jnp.float32)).astype(x.dtype)


def swiglu(x, w_gate, w_up, w_down):
    return (jax.nn.silu(x @ w_gate) * (x @ w_up)) @ w_down


def rope(x, positions):
    hd = x.shape[-1]
    half = hd // 2
    inv_freq = 1.0 / (ROPE_THETA ** (jnp.arange(half, dtype=jnp.float32) * (2.0 / hd)))
    ang = positions.astype(jnp.float32)[..., None] * inv_freq
    cos = jnp.cos(ang)[:, :, None, :]
    sin = jnp.sin(ang)[:, :, None, :]
    xf = x.astype(jnp.float32)
    x1, x2 = xf[..., :half], xf[..., half:]
    out = jnp.concatenate([x1 * cos - x2 * sin, x2 * cos + x1 * sin], axis=-1)
    return out.astype(x.dtype)


def pool_mixer(u, w_grp, scale):
    B, S, C = u.shape
    uf = u.astype(jnp.float32).reshape(B, S, N_POOL_GROUPS, POOL_CG)
    cs = jnp.cumsum(uf, axis=1)
    t1 = jnp.arange(S, dtype=jnp.float32) + 1.0
    pooled = []
    for g, w in enumerate(POOL_WINDOWS):
        c = cs[:, :, g]
        shifted = jnp.pad(c, ((0, 0), (w, 0), (0, 0)))[:, :S]
        cnt = jnp.minimum(t1, float(w))[None, :, None]
        pooled.append((c - shifted) / cnt)
    diff = (jnp.stack(pooled, axis=2) - uf).astype(u.dtype)
    y = jnp.einsum('bsgc,gcd->bsgd', diff, w_grp).reshape(B, S, C)
    return y * scale


def swa_sink_attention(q, k, v, sinks):
    B, S, _, hd = q.shape
    nb = S // BLOCK
    qb = q.reshape(B, nb, BLOCK, N_KV_HEADS, GQA_GROUP, hd)
    kb = k.reshape(B, nb, BLOCK, N_KV_HEADS, hd)
    vb = v.reshape(B, nb, BLOCK, N_KV_HEADS, hd)
    pad = ((0, 0), (1, 0), (0, 0), (0, 0), (0, 0))
    kk = jnp.concatenate([jnp.pad(kb, pad)[:, :nb], kb], axis=2)
    vv = jnp.concatenate([jnp.pad(vb, pad)[:, :nb], vb], axis=2)
    s = jnp.einsum('bnqkgd,bnjkd->bnkgqj', qb, kk).astype(jnp.float32) * (hd ** -0.5)
    qi = jnp.arange(BLOCK)[:, None] + BLOCK
    kj = jnp.arange(2 * BLOCK)[None, :]
    rel = qi - kj
    band = (rel >= 0) & (rel < WINDOW)
    first = (jnp.arange(nb)[:, None, None] > 0) | (kj[None] >= BLOCK)
    valid = band[None] & first
    s = jnp.where(valid[None, :, None, None], s, -jnp.inf)
    sk = sinks.astype(jnp.float32).reshape(N_KV_HEADS, GQA_GROUP)[None, None, :, :, None]
    m = jnp.maximum(jnp.max(s, axis=-1), sk)
    p = jnp.exp(s - m[..., None])
    denom = jnp.sum(p, axis=-1) + jnp.exp(sk - m)
    p = (p / denom[..., None]).astype(v.dtype)
    o = jnp.einsum('bnkgqj,bnjkd->bnqkgd', p, vv)
    return o.reshape(B, S, N_Q_HEADS * hd)


def mem_attention(qm, mk, mv):
    B, S, _ = qm.shape
    q = qm.reshape(B, S, MEM_HEADS, MEM_HEAD_DIM)
    k = mk.reshape(B, -1, MEM_HEADS, MEM_HEAD_DIM)
    v = mv.reshape(B, -1, MEM_HEADS, MEM_HEAD_DIM)
    s = jnp.einsum('bshd,bmhd->bhsm', q, k).astype(jnp.float32) * (MEM_HEAD_DIM ** -0.5)
    p = jax.nn.softmax(s, axis=-1).astype(v.dtype)
    return jnp.einsum('bhsm,bmhd->bshd', p, v).reshape(B, S, MEM_WIDTH)


def setup_inputs(seed: int = 0) -> dict:
    key = jax.random.key(seed)
    ks = jax.random.split(key, 20)
    f32 = jnp.float32
    nrm = lambda k, shape, fan_in: jax.random.normal(k, shape, f32) * (fan_in ** -0.5)
    x = jax.random.normal(ks[0], (BATCH, SEQ, D_MODEL), f32)
    mem = jax.random.normal(ks[1], (BATCH, MEM_LEN, D_MODEL), f32)
    offset = jax.random.randint(ks[2], (BATCH, 1), 0, 1024, dtype=jnp.int32)
    positions = offset + jnp.arange(SEQ, dtype=jnp.int32)[None, :]
    norms = 1.0 + 0.02 * jax.random.normal(ks[3], (DEPTH, 3, D_MODEL), f32)
    ffn_gate = nrm(ks[4], (DEPTH, 2, D_MODEL, D_FF), D_MODEL)
    ffn_up = nrm(ks[5], (DEPTH, 2, D_MODEL, D_FF), D_MODEL)
    ffn_down = nrm(ks[6], (DEPTH, 2, D_FF, D_MODEL), D_FF)
    w_in = nrm(ks[7], (DEPTH, D_MODEL, MIX + MEM_WIDTH), D_MODEL)
    w_out = nrm(ks[8], (DEPTH, MIX + MEM_WIDTH, D_MODEL), MIX + MEM_WIDTH)
    pool_w = nrm(ks[9], (N_A, N_POOL_GROUPS, POOL_CG, POOL_CG), POOL_CG)
    pool_scale = 1.0 + 0.1 * jax.random.normal(ks[10], (N_A, MIX), f32)
    w_kv = nrm(ks[11], (D_MODEL, 2 * N_KV_HEADS * HEAD_DIM), D_MODEL)
    kv_norm = 1.0 + 0.02 * jax.random.normal(ks[12], (D_MODEL,), f32)
    sinks = 0.5 * jax.random.normal(ks[13], (N_B, N_Q_HEADS), f32)
    w_mem_kv = nrm(ks[14], (DEPTH, D_MODEL, 2 * MEM_WIDTH), D_MODEL)
    mem_norm = 1.0 + 0.02 * jax.random.normal(ks[15], (D_MODEL,), f32)
    final_norm = 1.0 + 0.02 * jax.random.normal(ks[16], (D_MODEL,), f32)
    return {"x": x, "mem": mem, "positions": positions, "norms": norms,
            "ffn_gate": ffn_gate, "ffn_up": ffn_up, "ffn_down": ffn_down,
            "w_in": w_in, "w_out": w_out, "pool_w": pool_w, "pool_scale": pool_scale,
            "w_kv": w_kv, "kv_norm": kv_norm, "sinks": sinks, "w_mem_kv": w_mem_kv,
            "mem_norm": mem_norm, "final_norm": final_norm}


def reference(x, mem, positions, norms, ffn_gate, ffn_up, ffn_down, w_in, w_out,
              pool_w, pool_scale, w_kv, kv_norm, sinks, w_mem_kv, mem_norm, final_norm):
    B, S, _ = x.shape
    h = x
    mem_n = rmsnorm(mem, mem_norm)
    k_shared = None
    v_shared = None
    for l in range(DEPTH):
        h = h + 0.5 * swiglu(rmsnorm(h, norms[l, 0]), ffn_gate[l, 0], ffn_up[l, 0], ffn_down[l, 0])
        a = rmsnorm(h, norms[l, 1]) @ w_in[l]
        u, qm = a[..., :MIX], a[..., MIX:]
        if l < N_A:
            y = pool_mixer(u, pool_w[l], pool_scale[l])
        else:
            q = rope(u.reshape(B, S, N_Q_HEADS, HEAD_DIM), positions)
            y = swa_sink_attention(q, k_shared, v_shared, sinks[l - N_A])
        mkv = mem_n @ w_mem_kv[l]
        ym = mem_attention(qm, mkv[..., :MEM_WIDTH], mkv[..., MEM_WIDTH:])
        h = h + jnp.concatenate([y, ym], axis=-1) @ w_out[l]
        h = h + 0.5 * swiglu(rmsnorm(h, norms[l, 2]), ffn_gate[l, 1], ffn_up[l, 1], ffn_down[l, 1])
        if l == N_A - 1:
            kv = rmsnorm(h, kv_norm) @ w_kv
            kvw = N_KV_HEADS * HEAD_DIM
            k_shared = rope(kv[..., :kvw].reshape(B, S, N_KV_HEADS, HEAD_DIM), positions)
            v_shared = kv[..., kvw:].reshape(B, S, N_KV_HEADS, HEAD_DIM)
    return rmsnorm(h, final_norm)
```

```cpp
#include <hip/hip_runtime.h>
#include <cstdio>
#include <cstdint>

namespace ref {
constexpr int S = 8192, D = 2048, FF = 5632, DEPTH = 4, NA = 2, MIX = 1536, MEMW = 512, CG = 384, NQH = 24, NKVH = 3, HD = 64, WIN = 128, ML = 256, MH = 4, MHD = 128;
constexpr float EPS = 1e-5f;
typedef float f32x16 __attribute__((ext_vector_type(16)));

__device__ __forceinline__ float wave_sum(float v) {
#pragma unroll
    for (int o = 1; o < 64; o <<= 1) v += __shfl_xor(v, o);
    return v;
}
__device__ __forceinline__ float wave_max(float v) {
#pragma unroll
    for (int o = 1; o < 64; o <<= 1) v = fmaxf(v, __shfl_xor(v, o));
    return v;
}

__global__ void __launch_bounds__(256) k_rmsnorm(const float* __restrict__ x, const float* __restrict__ g, float* __restrict__ out, int nrows, int ncols) {
    const int row = blockIdx.x * 4 + (threadIdx.x >> 6), lane = threadIdx.x & 63;
    if (row >= nrows) return;
    const float* xr = x + (size_t)row * ncols; float* o = out + (size_t)row * ncols;
    float s = 0.f;
    for (int c = lane * 4; c < ncols; c += 256) { const float4 v = *(const float4*)(xr + c); s += v.x * v.x + v.y * v.y + v.z * v.z + v.w * v.w; }
    s = wave_sum(s);
    const float r = rsqrtf(s / (float)ncols + EPS);
    for (int c = lane * 4; c < ncols; c += 256) { const float4 v = *(const float4*)(xr + c); const float4 gg = *(const float4*)(g + c);
        float4 w; w.x = v.x * r * gg.x; w.y = v.y * r * gg.y; w.z = v.z * r * gg.z; w.w = v.w * r * gg.w; *(float4*)(o + c) = w; }
}

template <int EPI>
__global__ void __launch_bounds__(256) k_gemm(const float* __restrict__ A, int lda, const float* __restrict__ B, int ldb, float* C, int ldc, int K,
                                              const float* R, float alpha, const float* __restrict__ colscale) {
    __shared__ float As[16][132];
    __shared__ float Bs[16][132];
    const int t = threadIdx.x, lane = t & 63, w = t >> 6, wm = w >> 1, wn = w & 1, r32 = lane & 31, hi = lane >> 5;
    const int m0 = blockIdx.y * 128, n0 = blockIdx.x * 128;
    f32x16 acc[2][2];
#pragma unroll
    for (int i = 0; i < 2; ++i)
#pragma unroll
        for (int j = 0; j < 2; ++j)
#pragma unroll
            for (int r = 0; r < 16; ++r) acc[i][j][r] = 0.f;
    for (int k0 = 0; k0 < K; k0 += 16) {
#pragma unroll
        for (int i = 0; i < 2; ++i) {
            const int row = (t >> 2) + 64 * i, kq = (t & 3) * 4;
            const float4 a = *(const float4*)(A + (size_t)(m0 + row) * lda + k0 + kq);
            As[kq + 0][row] = a.x; As[kq + 1][row] = a.y; As[kq + 2][row] = a.z; As[kq + 3][row] = a.w;
            const int kr = (t >> 5) + 8 * i, nq = (t & 31) * 4;
            const float4 b = *(const float4*)(B + (size_t)(k0 + kr) * ldb + n0 + nq);
            *(float4*)&Bs[kr][nq] = b;
        }
        __syncthreads();
#pragma unroll
        for (int kk = 0; kk < 16; kk += 2) {
            float a[2], b[2];
#pragma unroll
            for (int i = 0; i < 2; ++i) { a[i] = As[kk + hi][wm * 64 + i * 32 + r32]; b[i] = Bs[kk + hi][wn * 64 + i * 32 + r32]; }
#pragma unroll
            for (int i = 0; i < 2; ++i)
#pragma unroll
                for (int j = 0; j < 2; ++j) acc[i][j] = __builtin_amdgcn_mfma_f32_32x32x2f32(a[i], b[j], acc[i][j], 0, 0, 0);
        }
        __syncthreads();
    }
#pragma unroll
    for (int i = 0; i < 2; ++i)
#pragma unroll
        for (int j = 0; j < 2; ++j)
#pragma unroll
            for (int r = 0; r < 16; ++r) {
                const int row = m0 + wm * 64 + i * 32 + (r & 3) + 8 * (r >> 2) + 4 * hi, col = n0 + wn * 64 + j * 32 + r32;
                const size_t o = (size_t)row * ldc + col; float v = acc[i][j][r];
                if (EPI == 1) v = R[o] + alpha * v;
                if (EPI == 2) v = v * colscale[col];
                C[o] = v;
            }
}

__global__ void __launch_bounds__(256) k_swiglu(float* g, const float* __restrict__ u, size_t n4) {
    size_t i = (size_t)blockIdx.x * 256 + threadIdx.x;
    const size_t stride = (size_t)gridDim.x * 256;
    for (; i < n4; i += stride) { float4 a = ((float4*)g)[i]; const float4 b = ((const float4*)u)[i];
        a.x = a.x / (1.f + expf(-a.x)) * b.x; a.y = a.y / (1.f + expf(-a.y)) * b.y; a.z = a.z / (1.f + expf(-a.z)) * b.z; a.w = a.w / (1.f + expf(-a.w)) * b.w; ((float4*)g)[i] = a; }
}

__global__ void __launch_bounds__(256) k_pool_diff(const float* __restrict__ a, int lda, float* __restrict__ diff) {
    const int idx = blockIdx.x * 256 + threadIdx.x;
    const int t = idx / MIX, c = idx % MIX, g = c / CG; const int w = 2 << g;
    float s = 0.f; const int j0 = (t - w + 1) < 0 ? 0 : (t - w + 1);
    for (int j = j0; j <= t; ++j) s += a[(size_t)j * lda + c];
    const float cnt = (float)(t + 1 < w ? t + 1 : w);
    diff[(size_t)t * MIX + c] = s / cnt - a[(size_t)t * lda + c];
}

__global__ void __launch_bounds__(256) k_rope(float* x, int ld, int nh, const int* __restrict__ pos) {
    const int idx = blockIdx.x * 256 + threadIdx.x;
    const int i = idx & 31, h = (idx >> 5) % nh, t = (idx >> 5) / nh;
    if (t >= S) return;
    const float inv_freq = 1.0f / powf(10000.0f, (float)i * (2.0f / 64.0f));
    const float ang = (float)pos[t] * inv_freq; float sn, cs; sincosf(ang, &sn, &cs);
    float* p = x + (size_t)t * ld + h * 64;
    const float x1 = p[i], x2 = p[i + 32];
    p[i] = x1 * cs - x2 * sn; p[i + 32] = x2 * cs + x1 * sn;
}

__global__ void __launch_bounds__(256) k_swa(const float* __restrict__ q, int ldq, const float* __restrict__ kv, int ldkv, const float* __restrict__ sinks, float* __restrict__ y, int ldo) {
    __shared__ float ps[4][128];
    const int wv = threadIdx.x >> 6, lane = threadIdx.x & 63;
    const int item = blockIdx.x * 4 + wv; const int t = item / NQH, hq = item % NQH, kh = hq / 8;
    const float* qp = q + (size_t)t * ldq + hq * 64;
    float sc[2];
#pragma unroll
    for (int e = 0; e < 2; ++e) {
        const int j = t - 127 + lane + 64 * e;
        float s = -INFINITY;
        if (j >= 0 && j <= t) { const float* kp = kv + (size_t)j * ldkv + kh * 64; float d = 0.f; for (int c = 0; c < 64; ++c) d += qp[c] * kp[c]; s = d * 0.125f; }
        sc[e] = s;
    }
    const float sink = sinks[hq];
    const float m = fmaxf(wave_max(fmaxf(sc[0], sc[1])), sink);
    const float p0 = expf(sc[0] - m), p1 = expf(sc[1] - m);
    const float den = wave_sum(p0 + p1) + expf(sink - m);
    ps[wv][lane] = p0 / den; ps[wv][lane + 64] = p1 / den;
    __syncthreads();
    float o = 0.f;
    for (int jj = 0; jj < 128; ++jj) { const int j = t - 127 + jj; if (j < 0) continue; o += ps[wv][jj] * kv[(size_t)j * ldkv + 192 + kh * 64 + lane]; }
    y[(size_t)t * ldo + hq * 64 + lane] = o;
}

__global__ void __launch_bounds__(256) k_memattn(const float* __restrict__ a, int ldq, const float* __restrict__ mkv, float* __restrict__ y, int ldo) {
    __shared__ float ps[4][256];
    const int wv = threadIdx.x >> 6, lane = threadIdx.x & 63;
    const int item = blockIdx.x * 4 + wv; const int t = item / MH, h = item % MH;
    const float* qp = a + (size_t)t * ldq + MIX + h * MHD;
    float sc[4]; float mx = -INFINITY;
#pragma unroll
    for (int e = 0; e < 4; ++e) { const int j = lane + 64 * e; const float* kp = mkv + (size_t)j * 1024 + h * MHD; float d = 0.f; for (int c = 0; c < MHD; ++c) d += qp[c] * kp[c];
        sc[e] = d * 0.08838834764831845f; mx = fmaxf(mx, sc[e]); }
    mx = wave_max(mx); float sum = 0.f;
#pragma unroll
    for (int e = 0; e < 4; ++e) { sc[e] = expf(sc[e] - mx); sum += sc[e]; }
    sum = wave_sum(sum);
#pragma unroll
    for (int e = 0; e < 4; ++e) ps[wv][lane + 64 * e] = sc[e] / sum;
    __syncthreads();
    float o0 = 0.f, o1 = 0.f;
    for (int j = 0; j < ML; ++j) { const float p = ps[wv][j]; const float* vp = mkv + (size_t)j * 1024 + 512 + h * MHD; o0 += p * vp[lane]; o1 += p * vp[lane + 64]; }
    float* op = y + (size_t)t * ldo + MIX + h * MHD; op[lane] = o0; op[lane + 64] = o1;
}

template <int EPI>
static void gemm(hipStream_t st, const float* A, int lda, const float* B, int ldb, float* C, int ldc, int M, int N, int K, const float* R = nullptr, float alpha = 1.f, const float* cs = nullptr) {
    hipLaunchKernelGGL(k_gemm<EPI>, dim3(N / 128, M / 128), dim3(256), 0, st, A, lda, B, ldb, C, ldc, K, R, alpha, cs);
}

struct In { const float *x, *mem; const int* pos; const float *norms, *gate, *up, *down, *w_in, *w_out, *pool_w, *pool_scale, *w_kv, *kv_norm, *sinks, *w_mem_kv, *mem_norm, *final_norm; };

static void forward(hipStream_t st, const In& in, float* out, float* ws) {
    float* H = ws; float* XN = H + (size_t)S * D; float* G = XN + (size_t)S * D; float* U = G + (size_t)S * FF; float* A = U + (size_t)S * FF; float* Y = A + (size_t)S * D;
    float* DIFF = Y + (size_t)S * D; float* KV = DIFF + (size_t)S * MIX; float* MEMN = KV + (size_t)S * 384; float* MKV = MEMN + (size_t)ML * D;
    hipLaunchKernelGGL(k_rmsnorm, dim3(ML / 4), dim3(256), 0, st, in.mem, in.mem_norm, MEMN, ML, D);
    const float* hin = in.x;
    for (int l = 0; l < DEPTH; ++l) {
        for (int half = 0; half < 2; ++half) {
            if (half == 1) {
                hipLaunchKernelGGL(k_rmsnorm, dim3(S / 4), dim3(256), 0, st, hin, in.norms + (size_t)(l * 3 + 1) * D, XN, S, D);
                gemm<0>(st, XN, D, in.w_in + (size_t)l * D * D, D, A, D, S, D, D);
                if (l < NA) {
                    hipLaunchKernelGGL(k_pool_diff, dim3(S * MIX / 256), dim3(256), 0, st, A, D, DIFF);
                    for (int g = 0; g < 4; ++g)
                        gemm<2>(st, DIFF + g * CG, MIX, in.pool_w + (size_t)(l * 4 + g) * CG * CG, CG, Y + g * CG, D, S, CG, CG, nullptr, 1.f, in.pool_scale + (size_t)l * MIX + g * CG - 0);
                } else {
                    hipLaunchKernelGGL(k_rope, dim3(S * NQH * 32 / 256), dim3(256), 0, st, A, D, NQH, in.pos);
                    hipLaunchKernelGGL(k_swa, dim3(S * NQH / 4), dim3(256), 0, st, A, D, KV, 384, in.sinks + (size_t)(l - NA) * NQH, Y, D);
                }
                gemm<0>(st, MEMN, D, in.w_mem_kv + (size_t)l * D * 1024, 1024, MKV, 1024, ML, 1024, D);
                hipLaunchKernelGGL(k_memattn, dim3(S * MH / 4), dim3(256), 0, st, A, D, MKV, Y, D);
                gemm<1>(st, Y, D, in.w_out + (size_t)l * D * D, D, H, D, S, D, D, hin, 1.0f);
                hin = H;
            }
            hipLaunchKernelGGL(k_rmsnorm, dim3(S / 4), dim3(256), 0, st, hin, in.norms + (size_t)(l * 3 + (half ? 2 : 0)) * D, XN, S, D);
            const size_t wo = (size_t)(l * 2 + half) * D * FF;
            gemm<0>(st, XN, D, in.gate + wo, FF, G, FF, S, FF, D);
            gemm<0>(st, XN, D, in.up + wo, FF, U, FF, S, FF, D);
            hipLaunchKernelGGL(k_swiglu, dim3(4096), dim3(256), 0, st, G, U, (size_t)S * FF / 4);
            gemm<1>(st, G, FF, in.down + wo, D, H, D, S, D, FF, hin, 0.5f);
            hin = H;
        }
        if (l == NA - 1) {
            hipLaunchKernelGGL(k_rmsnorm, dim3(S / 4), dim3(256), 0, st, H, in.kv_norm, XN, S, D);
            gemm<0>(st, XN, D, in.w_kv, 384, KV, 384, S, 384, D);
            hipLaunchKernelGGL(k_rope, dim3(S * NKVH * 32 / 256), dim3(256), 0, st, KV, 384, NKVH, in.pos);
        }
    }
    hipLaunchKernelGGL(k_rmsnorm, dim3(S / 4), dim3(256), 0, st, H, in.final_norm, out, S, D);
}
constexpr size_t WS_FLOATS = (size_t)S * D * 4 + (size_t)S * FF * 2 + (size_t)S * MIX + (size_t)S * 384 + (size_t)ML * D + (size_t)ML * 1024;
}

extern "C" void kernel_launch(void* const* d_in, const int* in_sizes, int n_in, void* d_out, int out_size, void* d_ws, size_t ws_size, hipStream_t stream) {
    if (n_in != 17 || out_size != ref::S * ref::D || ws_size < ref::WS_FLOATS * 4) { fprintf(stderr, "kernel_launch: unexpected shapes n_in %d out %d ws %zu (need %zu)\n", n_in, out_size, ws_size, ref::WS_FLOATS * 4); return; }
    ref::In in;
    in.x = (const float*)d_in[0]; in.mem = (const float*)d_in[1]; in.pos = (const int*)d_in[2]; in.norms = (const float*)d_in[3];
    in.gate = (const float*)d_in[4]; in.up = (const float*)d_in[5]; in.down = (const float*)d_in[6]; in.w_in = (const float*)d_in[7]; in.w_out = (const float*)d_in[8];
    in.pool_w = (const float*)d_in[9]; in.pool_scale = (const float*)d_in[10]; in.w_kv = (const float*)d_in[11]; in.kv_norm = (const float*)d_in[12]; in.sinks = (const float*)d_in[13];
    in.w_mem_kv = (const float*)d_in[14]; in.mem_norm = (const float*)d_in[15]; in.final_norm = (const float*)d_in[16];
    ref::forward(stream, in, (float*)d_out, (float*)d_ws);
}
```

```cpp
#include <hip/hip_runtime.h>
#include <cstdio>
#include <cstdint>
#ifndef DBG
#define DBG 0
#endif
#ifndef PHMASK
#define PHMASK 0xFFFF
#endif
#define PHON(b) ((PHMASK >> (b)) & 1)
#if DBG
namespace ref {
constexpr int S = 8192, D = 2048, FF = 5632, DEPTH = 4, NA = 2, MIX = 1536, MEMW = 512, CG = 384, NQH = 24, NKVH = 3, HD = 64, WIN = 128, ML = 256, MH = 4, MHD = 128;
constexpr float EPS = 1e-5f;
typedef float f32x16 __attribute__((ext_vector_type(16)));

__device__ __forceinline__ float wave_sum(float v) {
#pragma unroll
    for (int o = 1; o < 64; o <<= 1) v += __shfl_xor(v, o);
    return v;
}
__device__ __forceinline__ float wave_max(float v) {
#pragma unroll
    for (int o = 1; o < 64; o <<= 1) v = fmaxf(v, __shfl_xor(v, o));
    return v;
}

__global__ void __launch_bounds__(256) k_rmsnorm(const float* __restrict__ x, const float* __restrict__ g, float* __restrict__ out, int nrows, int ncols) {
    const int row = blockIdx.x * 4 + (threadIdx.x >> 6), lane = threadIdx.x & 63;
    if (row >= nrows) return;
    const float* xr = x + (size_t)row * ncols; float* o = out + (size_t)row * ncols;
    float s = 0.f;
    for (int c = lane * 4; c < ncols; c += 256) { const float4 v = *(const float4*)(xr + c); s += v.x * v.x + v.y * v.y + v.z * v.z + v.w * v.w; }
    s = wave_sum(s);
    const float r = rsqrtf(s / (float)ncols + EPS);
    for (int c = lane * 4; c < ncols; c += 256) { const float4 v = *(const float4*)(xr + c); const float4 gg = *(const float4*)(g + c);
        float4 w; w.x = v.x * r * gg.x; w.y = v.y * r * gg.y; w.z = v.z * r * gg.z; w.w = v.w * r * gg.w; *(float4*)(o + c) = w; }
}

template <int EPI>
__global__ void __launch_bounds__(256) k_gemm(const float* __restrict__ A, int lda, const float* __restrict__ B, int ldb, float* C, int ldc, int K,
                                              const float* R, float alpha, const float* __restrict__ colscale) {
    __shared__ float As[16][132];
    __shared__ float Bs[16][132];
    const int t = threadIdx.x, lane = t & 63, w = t >> 6, wm = w >> 1, wn = w & 1, r32 = lane & 31, hi = lane >> 5;
    const int m0 = blockIdx.y * 128, n0 = blockIdx.x * 128;
    f32x16 acc[2][2];
#pragma unroll
    for (int i = 0; i < 2; ++i)
#pragma unroll
        for (int j = 0; j < 2; ++j)
#pragma unroll
            for (int r = 0; r < 16; ++r) acc[i][j][r] = 0.f;
    for (int k0 = 0; k0 < K; k0 += 16) {
#pragma unroll
        for (int i = 0; i < 2; ++i) {
            const int row = (t >> 2) + 64 * i, kq = (t & 3) * 4;
            const float4 a = *(const float4*)(A + (size_t)(m0 + row) * lda + k0 + kq);
            As[kq + 0][row] = a.x; As[kq + 1][row] = a.y; As[kq + 2][row] = a.z; As[kq + 3][row] = a.w;
            const int kr = (t >> 5) + 8 * i, nq = (t & 31) * 4;
            const float4 b = *(const float4*)(B + (size_t)(k0 + kr) * ldb + n0 + nq);
            *(float4*)&Bs[kr][nq] = b;
        }
        __syncthreads();
#pragma unroll
        for (int kk = 0; kk < 16; kk += 2) {
            float a[2], b[2];
#pragma unroll
            for (int i = 0; i < 2; ++i) { a[i] = As[kk + hi][wm * 64 + i * 32 + r32]; b[i] = Bs[kk + hi][wn * 64 + i * 32 + r32]; }
#pragma unroll
            for (int i = 0; i < 2; ++i)
#pragma unroll
                for (int j = 0; j < 2; ++j) acc[i][j] = __builtin_amdgcn_mfma_f32_32x32x2f32(a[i], b[j], acc[i][j], 0, 0, 0);
        }
        __syncthreads();
    }
#pragma unroll
    for (int i = 0; i < 2; ++i)
#pragma unroll
        for (int j = 0; j < 2; ++j)
#pragma unroll
            for (int r = 0; r < 16; ++r) {
                const int row = m0 + wm * 64 + i * 32 + (r & 3) + 8 * (r >> 2) + 4 * hi, col = n0 + wn * 64 + j * 32 + r32;
                const size_t o = (size_t)row * ldc + col; float v = acc[i][j][r];
                if (EPI == 1) v = R[o] + alpha * v;
                if (EPI == 2) v = v * colscale[col];
                C[o] = v;
            }
}

__global__ void __launch_bounds__(256) k_swiglu(float* g, const float* __restrict__ u, size_t n4) {
    size_t i = (size_t)blockIdx.x * 256 + threadIdx.x;
    const size_t stride = (size_t)gridDim.x * 256;
    for (; i < n4; i += stride) { float4 a = ((float4*)g)[i]; const float4 b = ((const float4*)u)[i];
        a.x = a.x / (1.f + expf(-a.x)) * b.x; a.y = a.y / (1.f + expf(-a.y)) * b.y; a.z = a.z / (1.f + expf(-a.z)) * b.z; a.w = a.w / (1.f + expf(-a.w)) * b.w; ((float4*)g)[i] = a; }
}

__global__ void __launch_bounds__(256) k_pool_diff(const float* __restrict__ a, int lda, float* __restrict__ diff) {
    const int idx = blockIdx.x * 256 + threadIdx.x;
    const int t = idx / MIX, c = idx % MIX, g = c / CG; const int w = 2 << g;
    float s = 0.f; const int j0 = (t - w + 1) < 0 ? 0 : (t - w + 1);
    for (int j = j0; j <= t; ++j) s += a[(size_t)j * lda + c];
    const float cnt = (float)(t + 1 < w ? t + 1 : w);
    diff[(size_t)t * MIX + c] = s / cnt - a[(size_t)t * lda + c];
}

__global__ void __launch_bounds__(256) k_rope(float* x, int ld, int nh, const int* __restrict__ pos) {
    const int idx = blockIdx.x * 256 + threadIdx.x;
    const int i = idx & 31, h = (idx >> 5) % nh, t = (idx >> 5) / nh;
    if (t >= S) return;
    const float inv_freq = 1.0f / powf(10000.0f, (float)i * (2.0f / 64.0f));
    const float ang = (float)pos[t] * inv_freq; float sn, cs; sincosf(ang, &sn, &cs);
    float* p = x + (size_t)t * ld + h * 64;
    const float x1 = p[i], x2 = p[i + 32];
    p[i] = x1 * cs - x2 * sn; p[i + 32] = x2 * cs + x1 * sn;
}

__global__ void __launch_bounds__(256) k_swa(const float* __restrict__ q, int ldq, const float* __restrict__ kv, int ldkv, const float* __restrict__ sinks, float* __restrict__ y, int ldo) {
    __shared__ float ps[4][128];
    const int wv = threadIdx.x >> 6, lane = threadIdx.x & 63;
    const int item = blockIdx.x * 4 + wv; const int t = item / NQH, hq = item % NQH, kh = hq / 8;
    const float* qp = q + (size_t)t * ldq + hq * 64;
    float sc[2];
#pragma unroll
    for (int e = 0; e < 2; ++e) {
        const int j = t - 127 + lane + 64 * e;
        float s = -INFINITY;
        if (j >= 0 && j <= t) { const float* kp = kv + (size_t)j * ldkv + kh * 64; float d = 0.f; for (int c = 0; c < 64; ++c) d += qp[c] * kp[c]; s = d * 0.125f; }
        sc[e] = s;
    }
    const float sink = sinks[hq];
    const float m = fmaxf(wave_max(fmaxf(sc[0], sc[1])), sink);
    const float p0 = expf(sc[0] - m), p1 = expf(sc[1] - m);
    const float den = wave_sum(p0 + p1) + expf(sink - m);
    ps[wv][lane] = p0 / den; ps[wv][lane + 64] = p1 / den;
    __syncthreads();
    float o = 0.f;
    for (int jj = 0; jj < 128; ++jj) { const int j = t - 127 + jj; if (j < 0) continue; o += ps[wv][jj] * kv[(size_t)j * ldkv + 192 + kh * 64 + lane]; }
    y[(size_t)t * ldo + hq * 64 + lane] = o;
}

__global__ void __launch_bounds__(256) k_memattn(const float* __restrict__ a, int ldq, const float* __restrict__ mkv, float* __restrict__ y, int ldo) {
    __shared__ float ps[4][256];
    const int wv = threadIdx.x >> 6, lane = threadIdx.x & 63;
    const int item = blockIdx.x * 4 + wv; const int t = item / MH, h = item % MH;
    const float* qp = a + (size_t)t * ldq + MIX + h * MHD;
    float sc[4]; float mx = -INFINITY;
#pragma unroll
    for (int e = 0; e < 4; ++e) { const int j = lane + 64 * e; const float* kp = mkv + (size_t)j * 1024 + h * MHD; float d = 0.f; for (int c = 0; c < MHD; ++c) d += qp[c] * kp[c];
        sc[e] = d * 0.08838834764831845f; mx = fmaxf(mx, sc[e]); }
    mx = wave_max(mx); float sum = 0.f;
#pragma unroll
    for (int e = 0; e < 4; ++e) { sc[e] = expf(sc[e] - mx); sum += sc[e]; }
    sum = wave_sum(sum);
#pragma unroll
    for (int e = 0; e < 4; ++e) ps[wv][lane + 64 * e] = sc[e] / sum;
    __syncthreads();
    float o0 = 0.f, o1 = 0.f;
    for (int j = 0; j < ML; ++j) { const float p = ps[wv][j]; const float* vp = mkv + (size_t)j * 1024 + 512 + h * MHD; o0 += p * vp[lane]; o1 += p * vp[lane + 64]; }
    float* op = y + (size_t)t * ldo + MIX + h * MHD; op[lane] = o0; op[lane + 64] = o1;
}

template <int EPI>
static void gemm(hipStream_t st, const float* A, int lda, const float* B, int ldb, float* C, int ldc, int M, int N, int K, const float* R = nullptr, float alpha = 1.f, const float* cs = nullptr) {
    hipLaunchKernelGGL(k_gemm<EPI>, dim3(N / 128, M / 128), dim3(256), 0, st, A, lda, B, ldb, C, ldc, K, R, alpha, cs);
}

struct In { const float *x, *mem; const int* pos; const float *norms, *gate, *up, *down, *w_in, *w_out, *pool_w, *pool_scale, *w_kv, *kv_norm, *sinks, *w_mem_kv, *mem_norm, *final_norm; };

static void forward(hipStream_t st, const In& in, float* out, float* ws) {
    float* H = ws; float* XN = H + (size_t)S * D; float* G = XN + (size_t)S * D; float* U = G + (size_t)S * FF; float* A = U + (size_t)S * FF; float* Y = A + (size_t)S * D;
    float* DIFF = Y + (size_t)S * D; float* KV = DIFF + (size_t)S * MIX; float* MEMN = KV + (size_t)S * 384; float* MKV = MEMN + (size_t)ML * D;
    hipLaunchKernelGGL(k_rmsnorm, dim3(ML / 4), dim3(256), 0, st, in.mem, in.mem_norm, MEMN, ML, D);
    const float* hin = in.x;
    for (int l = 0; l < DEPTH; ++l) {
        for (int half = 0; half < 2; ++half) {
            if (half == 1) {
                hipLaunchKernelGGL(k_rmsnorm, dim3(S / 4), dim3(256), 0, st, hin, in.norms + (size_t)(l * 3 + 1) * D, XN, S, D);
                gemm<0>(st, XN, D, in.w_in + (size_t)l * D * D, D, A, D, S, D, D);
                if (l < NA) {
                    hipLaunchKernelGGL(k_pool_diff, dim3(S * MIX / 256), dim3(256), 0, st, A, D, DIFF);
                    for (int g = 0; g < 4; ++g)
                        gemm<2>(st, DIFF + g * CG, MIX, in.pool_w + (size_t)(l * 4 + g) * CG * CG, CG, Y + g * CG, D, S, CG, CG, nullptr, 1.f, in.pool_scale + (size_t)l * MIX + g * CG - 0);
                } else {
                    hipLaunchKernelGGL(k_rope, dim3(S * NQH * 32 / 256), dim3(256), 0, st, A, D, NQH, in.pos);
                    hipLaunchKernelGGL(k_swa, dim3(S * NQH / 4), dim3(256), 0, st, A, D, KV, 384, in.sinks + (size_t)(l - NA) * NQH, Y, D);
                }
                gemm<0>(st, MEMN, D, in.w_mem_kv + (size_t)l * D * 1024, 1024, MKV, 1024, ML, 1024, D);
                hipLaunchKernelGGL(k_memattn, dim3(S * MH / 4), dim3(256), 0, st, A, D, MKV, Y, D);
                gemm<1>(st, Y, D, in.w_out + (size_t)l * D * D, D, H, D, S, D, D, hin, 1.0f);
                hin = H;
            }
            hipLaunchKernelGGL(k_rmsnorm, dim3(S / 4), dim3(256), 0, st, hin, in.norms + (size_t)(l * 3 + (half ? 2 : 0)) * D, XN, S, D);
            const size_t wo = (size_t)(l * 2 + half) * D * FF;
            gemm<0>(st, XN, D, in.gate + wo, FF, G, FF, S, FF, D);
            gemm<0>(st, XN, D, in.up + wo, FF, U, FF, S, FF, D);
            hipLaunchKernelGGL(k_swiglu, dim3(4096), dim3(256), 0, st, G, U, (size_t)S * FF / 4);
            gemm<1>(st, G, FF, in.down + wo, D, H, D, S, D, FF, hin, 0.5f);
            hin = H;
        }
        if (l == NA - 1) {
            hipLaunchKernelGGL(k_rmsnorm, dim3(S / 4), dim3(256), 0, st, H, in.kv_norm, XN, S, D);
            gemm<0>(st, XN, D, in.w_kv, 384, KV, 384, S, 384, D);
            hipLaunchKernelGGL(k_rope, dim3(S * NKVH * 32 / 256), dim3(256), 0, st, KV, 384, NKVH, in.pos);
        }
    }
    hipLaunchKernelGGL(k_rmsnorm, dim3(S / 4), dim3(256), 0, st, H, in.final_norm, out, S, D);
}
constexpr size_t WS_FLOATS = (size_t)S * D * 4 + (size_t)S * FF * 2 + (size_t)S * MIX + (size_t)S * 384 + (size_t)ML * D + (size_t)ML * 1024;
}
#endif
namespace cfg {
constexpr int S = 8192, D = 2048, FF = 5632, MIX = 1536, NQH = 24, ML = 256;
constexpr int NGU = 2 * FF, NGU_PAD = NGU + 512;
constexpr float EPS = 1e-5f, LOG2E = 1.4426950408889634f;
constexpr float QSCALE = 0.125f * LOG2E;
constexpr float QMSCALE = 0.08838834764831845f * LOG2E;
}
namespace pg8 {
#define PG8_LAS __attribute__((address_space(3)))
typedef unsigned short bf16_t;
typedef short bf16x8 __attribute__((ext_vector_type(8)));
typedef float f32x4 __attribute__((ext_vector_type(4)));
typedef unsigned u32x4 __attribute__((ext_vector_type(4)));
typedef unsigned u32x2 __attribute__((ext_vector_type(2)));
constexpr int BM = 256, BK = 64, HALF = 128, HTB = HALF * BK * 2  , STAGE_BYTES = 8 * HTB, NXCD = 8, WGM = 8;

__host__ __device__ __forceinline__ int lds_byte(int r, int c) { const int st = (r >> 4) * 2 + (c >> 5), rr = r & 15, cc = c & 31, ob = rr * 64 + cc * 2; return st * 1024 + (ob ^ (((ob >> 9) & 1) << 5)); }
__host__ __device__ __forceinline__ void stage_rc(int b, int& R, int& C) { const int st = b / 1024, sb = b % 1024, swz = sb ^ (((sb >> 9) & 1) << 5); R = (st >> 1) * 16 + swz / 64; C = (st & 1) * 32 + (swz % 64) / 2; }
__host__ __device__ __forceinline__ int perm32(int rho) { const int n = rho >> 4, i = rho & 15; return 8 * (i >> 2) + 4 * n + (i & 3); }

struct Unit { int pm, pn, ka; };
struct Gemm { const bf16_t* A; const bf16_t* Bt; int lda, ldb, K; };

struct StaticOrder {
    int nM, nN, nwg, G, c;
    __host__ __device__ void init(int M, int N, int G_, int c_) { nM = M / BM; nN = N / BM; nwg = nM * nN; G = G_; c = c_; }
    __host__ __device__ bool next(int i, Unit& u) const {
        const long L = (long)i * G + c; if (L >= nwg) return false;
        int wgid = (int)L; { const int q = nwg / NXCD, r = nwg % NXCD, xcd = wgid % NXCD, off = wgid / NXCD; wgid = (xcd < r ? xcd * (q + 1) : r * (q + 1) + (xcd - r) * q) + off; }
        const int nig = WGM * nN, gid = wgid / nig, fm = gid * WGM, gsz = (nM - fm) < WGM ? (nM - fm) : WGM;
        u.pm = fm + ((wgid % nig) % gsz); u.pn = (wgid % nig) / gsz; u.ka = 0; return true;
    }
    __device__ __forceinline__ void a_ready(const Unit&) const {}
    __device__ __forceinline__ void done(const Unit&) const {}
};
struct PoolOrder : StaticOrder {
    __host__ __device__ bool next(int i, Unit& u) const { if (!StaticOrder::next(i, u)) return false; u.ka = (u.pn >> 1) * 384; return true; }
};
struct SubsetOrder {
    int c0, n, nN, c;
    __host__ __device__ bool next(int i, Unit& u) const { const int k = c - c0; if (i != 0 || k < 0 || k >= n) return false; u.pm = k / nN; u.pn = k % nN; u.ka = 0; return true; }
    __device__ __forceinline__ void a_ready(const Unit&) const {}
    __device__ __forceinline__ void done(const Unit&) const {}
};

typedef float f32x2_t __attribute__((ext_vector_type(2))); typedef __bf16 bf16x2_t __attribute__((ext_vector_type(2)));
__device__ __forceinline__ unsigned pkbf(float lo, float hi) { f32x2_t v = {lo, hi}; bf16x2_t b = __builtin_convertvector(v, bf16x2_t); return __builtin_bit_cast(unsigned, b); }
__device__ __forceinline__ float rstd_of(const float* ssq, int row) {
    const f32x4 a = *(const f32x4*)(ssq + (size_t)row * 8), b = *(const f32x4*)(ssq + (size_t)row * 8 + 4);
    return __builtin_amdgcn_rsqf((((a[0] + a[1]) + (a[2] + a[3])) + ((b[0] + b[1]) + (b[2] + b[3]))) * (1.0f / 2048.0f) + cfg::EPS);
}
struct EpiSwiGLU {
    static constexpr bool PERM = true, AFTER_DRAIN = false;
    bf16_t* O; const float* ssq;
    __device__ __forceinline__ void operator()(const f32x4 (&acc)[2][2][4][2], const Unit& u, int wr, int wc, int fr, int fq) const {
        const int row0 = u.pm * BM + wr * 64 + fr, col0 = u.pn * 128 + wc * 32 + 8 * fq;
#pragma unroll
        for (int ai = 0; ai < 2; ++ai)
#pragma unroll
            for (int m = 0; m < 4; ++m) { const int row = row0 + ai * HALF + m * 16; const float rs = rstd_of(ssq, row);
                float o[8];
#pragma unroll
                for (int n = 0; n < 2; ++n)
#pragma unroll
                    for (int e = 0; e < 4; ++e) { const float g = acc[ai][0][m][n][e] * rs, up = acc[ai][1][m][n][e] * rs;
                        o[4 * n + e] = g * up * __builtin_amdgcn_rcpf(1.0f + __builtin_amdgcn_exp2f(-cfg::LOG2E * g)); }
                u32x4 w; w.x = pkbf(o[0], o[1]); w.y = pkbf(o[2], o[3]); w.z = pkbf(o[4], o[5]); w.w = pkbf(o[6], o[7]);
                *(u32x4*)(O + (size_t)row * cfg::FF + col0) = w; }
    }
};
struct EpiResid {
    static constexpr bool PERM = false, AFTER_DRAIN = true;
    const float* R; float* H; bf16_t* HB; float* ssq; float alpha;
    __device__ __forceinline__ void fused(f32x4 (&acc)[2][2][4][2], const Unit& u, int wr, int wc, int fr, int fq, PG8_LAS unsigned char* lds, int wid, int lane) const {
        PG8_LAS float* P = (PG8_LAS float*)lds;
        const int col0 = u.pn * BM + wc * 32 + 4 * fq;
#pragma unroll
        for (int ai = 0; ai < 2; ++ai)
#pragma unroll
            for (int m = 0; m < 4; ++m) { const int rl = ai * HALF + wr * 64 + m * 16 + fr; const size_t off = (size_t)(u.pm * BM + rl) * cfg::D + col0; float s = 0.f;
#pragma unroll
                for (int bj = 0; bj < 2; ++bj)
#pragma unroll
                    for (int n = 0; n < 2; ++n) { const size_t o2 = off + bj * HALF + n * 16; const f32x4 v = *(const f32x4*)(R + o2) + acc[ai][bj][m][n] * alpha;
                        *(f32x4*)(H + o2) = v; s += (v[0] * v[0] + v[1] * v[1]) + (v[2] * v[2] + v[3] * v[3]);
                        u32x2 w; w.x = pkbf(v[0], v[1]); w.y = pkbf(v[2], v[3]); *(u32x2*)(HB + o2) = w; }
                s += __shfl_xor(s, 16); s += __shfl_xor(s, 32);
                if (fq == 0) P[rl * 4 + wc] = s; }
        asm volatile("s_waitcnt lgkmcnt(0)" ::: "memory"); __builtin_amdgcn_s_barrier(); asm volatile("" ::: "memory");
        const int t = wid * 64 + lane;
        if (t < 256) { const f32x4 p = *(const PG8_LAS f32x4*)(P + t * 4); ssq[(size_t)(u.pm * BM + t) * 8 + u.pn] = (p[0] + p[1]) + (p[2] + p[3]); }
    }
};
struct EpiWin {
    static constexpr bool PERM = true, AFTER_DRAIN = false;
    bf16_t* AQ; const float* ssq; const float* cs; const float* sn; int swa;
    __device__ __forceinline__ void operator()(const f32x4 (&acc)[2][2][4][2], const Unit& u, int wr, int wc, int fr, int fq) const {
        const int row0 = u.pm * BM + wr * 64 + fr;
#pragma unroll
        for (int ai = 0; ai < 2; ++ai)
#pragma unroll
            for (int m = 0; m < 4; ++m) { const int row = row0 + ai * HALF + m * 16; const float rs = rstd_of(ssq, row);
#pragma unroll
                for (int bj = 0; bj < 2; ++bj) { const int c0 = u.pn * BM + bj * HALF + wc * 32 + 8 * fq; f32x4 v0 = acc[ai][bj][m][0] * rs, v1 = acc[ai][bj][m][1] * rs;
                    if (u.pn >= 6 || !swa) { if (u.pn >= 6) { v0 = v0 * cfg::QMSCALE; v1 = v1 * cfg::QMSCALE; }
                        u32x4 w; w.x = pkbf(v0[0], v0[1]); w.y = pkbf(v0[2], v0[3]); w.z = pkbf(v1[0], v1[1]); w.w = pkbf(v1[2], v1[3]); *(u32x4*)(AQ + (size_t)row * cfg::D + c0) = w; }
                    else { const int hb = c0 & ~63, d = ((c0 & 63) >> 3) * 4; const f32x4 c = *(const f32x4*)(cs + (size_t)row * 32 + d), s = *(const f32x4*)(sn + (size_t)row * 32 + d);
                        const f32x4 o1 = (v0 * c - v1 * s) * cfg::QSCALE, o2 = (v1 * c + v0 * s) * cfg::QSCALE;
                        u32x2 w1, w2; w1.x = pkbf(o1[0], o1[1]); w1.y = pkbf(o1[2], o1[3]); w2.x = pkbf(o2[0], o2[1]); w2.y = pkbf(o2[2], o2[3]);
                        *(u32x2*)(AQ + (size_t)row * cfg::D + hb + d) = w1; *(u32x2*)(AQ + (size_t)row * cfg::D + hb + 32 + d) = w2; } } }
    }
};
struct EpiPool {
    static constexpr bool PERM = false, AFTER_DRAIN = false;
    float* Z;
    __device__ __forceinline__ void operator()(const f32x4 (&acc)[2][2][4][2], const Unit& u, int wr, int wc, int fr, int fq) const {
        const int row0 = u.pm * BM + wr * 64 + fr, g = u.pn >> 1;
#pragma unroll
        for (int ai = 0; ai < 2; ++ai)
#pragma unroll
            for (int m = 0; m < 4; ++m) { float* zp = Z + (size_t)(row0 + ai * HALF + m * 16) * cfg::MIX + g * 384;
#pragma unroll
                for (int bj = 0; bj < 2; ++bj) { if ((u.pn & 1) && bj) continue;
#pragma unroll
                    for (int n = 0; n < 2; ++n) *(f32x4*)(zp + (u.pn & 1) * 256 + bj * HALF + wc * 32 + n * 16 + 4 * fq) = acc[ai][bj][m][n]; } }
    }
};
struct EpiKV {
    static constexpr bool PERM = true, AFTER_DRAIN = false;
    bf16_t* KB; bf16_t* VT; const float* ssq; const float* cs; const float* sn;
    __device__ __forceinline__ void operator()(const f32x4 (&acc)[2][2][4][2], const Unit& u, int wr, int wc, int fr, int fq) const {
        const int row0 = u.pm * BM + wr * 64 + fr;
#pragma unroll
        for (int ai = 0; ai < 2; ++ai)
#pragma unroll
            for (int m = 0; m < 4; ++m) { const int row = row0 + ai * HALF + m * 16; const float rs = rstd_of(ssq, row);
#pragma unroll
                for (int bj = 0; bj < 2; ++bj) { const int cg = u.pn * BM + bj * HALF + wc * 32 + 8 * fq; if (cg >= 384) continue;
                    const f32x4 v0 = acc[ai][bj][m][0] * rs, v1 = acc[ai][bj][m][1] * rs;
                    if (cg < 192) { const int hb = cg & ~63, d = ((cg & 63) >> 3) * 4; const f32x4 c = *(const f32x4*)(cs + (size_t)row * 32 + d), s = *(const f32x4*)(sn + (size_t)row * 32 + d);
                        const f32x4 o1 = v0 * c - v1 * s, o2 = v1 * c + v0 * s;
                        u32x2 w1, w2; w1.x = pkbf(o1[0], o1[1]); w1.y = pkbf(o1[2], o1[3]); w2.x = pkbf(o2[0], o2[1]); w2.y = pkbf(o2[2], o2[3]);
                        *(u32x2*)(KB + (size_t)row * 192 + hb + d) = w1; *(u32x2*)(KB + (size_t)row * 192 + hb + 32 + d) = w2; }
                    else { bf16_t* vp = VT + (size_t)(cg - 192) * cfg::S + row;
#pragma unroll
                        for (int e = 0; e < 4; ++e) { vp[(size_t)e * cfg::S] = (bf16_t)(pkbf(v0[e], 0.f) & 0xffffu); vp[(size_t)(4 + e) * cfg::S] = (bf16_t)(pkbf(v1[e], 0.f) & 0xffffu); } } } }
    }
};
struct EpiMemKV {
    static constexpr bool PERM = true, AFTER_DRAIN = false;
    bf16_t* MK; bf16_t* MVT;
    __device__ __forceinline__ void operator()(const f32x4 (&acc)[2][2][4][2], const Unit& u, int wr, int wc, int fr, int fq) const {
        const int row0 = wr * 64 + fr;
#pragma unroll
        for (int ai = 0; ai < 2; ++ai)
#pragma unroll
            for (int m = 0; m < 4; ++m) { const int row = row0 + ai * HALF + m * 16;
#pragma unroll
                for (int bj = 0; bj < 2; ++bj) { const int cg = u.pn * BM + bj * HALF + wc * 32 + 8 * fq, l = cg >> 10, w = cg & 1023;
                    const f32x4 v0 = acc[ai][bj][m][0], v1 = acc[ai][bj][m][1];
                    if (w < 512) { u32x4 q; q.x = pkbf(v0[0], v0[1]); q.y = pkbf(v0[2], v0[3]); q.z = pkbf(v1[0], v1[1]); q.w = pkbf(v1[2], v1[3]); *(u32x4*)(MK + ((size_t)l * 256 + row) * 512 + w) = q; }
                    else { bf16_t* vp = MVT + ((size_t)l * 512 + (w - 512)) * 256 + row;
#pragma unroll
                        for (int e = 0; e < 4; ++e) { vp[e * 256] = (bf16_t)(pkbf(v0[e], 0.f) & 0xffffu); vp[(4 + e) * 256] = (bf16_t)(pkbf(v1[e], 0.f) & 0xffffu); } } } }
    }
};

template <class Epi, class Sched, bool ALIGN_EPI = false, bool SP2 = false>
__device__ __forceinline__ void gemm_phase(PG8_LAS unsigned char* lds, const Gemm g, const Sched& S, const Epi& E) {
    int tid_ = threadIdx.x; asm volatile("" : "+v"(tid_));
    const int tid = tid_, wid = __builtin_amdgcn_readfirstlane(tid >> 6), lane = tid & 63, wr = wid >> 2, wc = wid & 3, fr = lane & 15, fq = lane >> 4;
    int K_ = g.K; asm volatile("" : "+s"(K_));
    const int K = K_, nt = K / BK;
    unsigned voffA[2], voffB[2];
#pragma unroll
    for (int i = 0; i < 2; ++i) { int R, C; stage_rc(tid * 16 + i * 8192, R, C); const int Rb = Epi::PERM ? ((R & ~31) + perm32(R & 31)) : R;
        voffA[i] = (unsigned)(R * g.lda + C) * 2u; voffB[i] = (unsigned)(Rb * g.ldb + C) * 2u; }
    const size_t kstep = (size_t)(BK * 2);
    const size_t hstepA = (size_t)HALF * g.lda * 2, hstepB = (size_t)HALF * g.ldb * 2;
    const size_t tstepA = 2 * hstepA, tstepB = 2 * hstepB;
    const unsigned ldsw = (unsigned)wid * 1024u;
    const int aoff = lds_byte(wr * 64 + fr, fq * 8), boff = lds_byte(wc * 32 + fr, fq * 8);
#define PG8_SA(b, h) (((b) * 2 + (h)) * HTB)
#define PG8_SB(b, h) ((4 + (b) * 2 + (h)) * HTB)
#define PG8_STAGE(bufoff, gbase, voff) do { _Pragma("unroll") for (int _i = 0; _i < 2; ++_i) \
        __builtin_amdgcn_global_load_lds((const unsigned*)((const char*)(gbase) + (voff)[_i]), (PG8_LAS unsigned*)(lds + (bufoff) + ldsw + _i * 8192), 16, 0, 0); } while (0)
#define PG8_LDA(dst, b, h) do { _Pragma("unroll") for (int m = 0; m < 4; ++m) _Pragma("unroll") for (int k = 0; k < 2; ++k) dst[m][k] = *(const PG8_LAS bf16x8*)(lds + PG8_SA(b, h) + aoff + m * 2048 + k * 1024); } while (0)
#define PG8_LDB(dst, b, h) do { _Pragma("unroll") for (int n = 0; n < 2; ++n) _Pragma("unroll") for (int k = 0; k < 2; ++k) dst[n][k] = *(const PG8_LAS bf16x8*)(lds + PG8_SB(b, h) + boff + n * 2048 + k * 1024); } while (0)
#define PG8_MMA(ai, bj, At, Bt) do { __builtin_amdgcn_s_setprio(1); _Pragma("unroll") for (int m = 0; m < 4; ++m) _Pragma("unroll") for (int n = 0; n < 2; ++n) _Pragma("unroll") for (int k = 0; k < 2; ++k) \
        acc[ai][bj][m][n] = __builtin_amdgcn_mfma_f32_16x16x32_bf16(Bt[n][k], At[m][k], acc[ai][bj][m][n], 0, 0, 0); __builtin_amdgcn_s_setprio(0); } while (0)
#define PG8_WAIT_V(n) asm volatile("s_waitcnt vmcnt(" #n ")" ::: "memory")
#define PG8_WAIT_L(n) asm volatile("s_waitcnt lgkmcnt(" #n ")" ::: "memory")
#define PG8_BAR __builtin_amdgcn_s_barrier()
#define PG8_SCHED __builtin_amdgcn_sched_barrier(0)
    Unit cur, nxt; int ui = 0;
    if (!S.next(0, cur)) return;
    f32x4 acc[2][2][4][2];
#pragma unroll
    for (int a = 0; a < 2; ++a)
#pragma unroll
        for (int b = 0; b < 2; ++b)
#pragma unroll
            for (int m = 0; m < 4; ++m)
#pragma unroll
                for (int n = 0; n < 2; ++n) acc[a][b][m][n] = (f32x4){0.f, 0.f, 0.f, 0.f};
    bf16x8 At[4][2], B0[2][2], B1[2][2];
    const char* cA = (const char*)g.A + (size_t)cur.pm * tstepA + (size_t)cur.ka * 2; const char* cB = (const char*)g.Bt + (size_t)cur.pn * tstepB;
    S.a_ready(cur);
    if constexpr (SP2) {
        PG8_STAGE(PG8_SB(0, 0), cB, voffB); PG8_STAGE(PG8_SB(0, 1), cB + hstepB, voffB); PG8_STAGE(PG8_SA(0, 0), cA, voffA); PG8_STAGE(PG8_SA(0, 1), cA + hstepA, voffA);
        if (wr == 1) PG8_BAR;
        PG8_WAIT_V(2); PG8_BAR;
        PG8_STAGE(PG8_SB(1, 0), cB + kstep, voffB); PG8_STAGE(PG8_SA(1, 0), cA + kstep, voffA); PG8_STAGE(PG8_SB(1, 1), cB + hstepB + kstep, voffB);
        PG8_WAIT_V(6); PG8_BAR;
    } else {
        PG8_STAGE(PG8_SB(0, 0), cB, voffB); PG8_STAGE(PG8_SA(0, 0), cA, voffA); PG8_STAGE(PG8_SB(0, 1), cB + hstepB, voffB); PG8_STAGE(PG8_SA(0, 1), cA + hstepA, voffA);
        if (wr == 1) PG8_BAR;
        PG8_WAIT_V(4); PG8_BAR;
        PG8_STAGE(PG8_SB(1, 0), cB + kstep, voffB); PG8_STAGE(PG8_SA(1, 0), cA + kstep, voffA); PG8_STAGE(PG8_SB(1, 1), cB + hstepB + kstep, voffB);
        PG8_WAIT_V(6); PG8_BAR;
    }
    for (;;) {
        const bool has_next = S.next(ui + 1, nxt);
        const char* nA = has_next ? (const char*)g.A + (size_t)nxt.pm * tstepA + (size_t)nxt.ka * 2 : cA; const char* nB = has_next ? (const char*)g.Bt + (size_t)nxt.pn * tstepB : cB;
        for (int t = 0; t < nt; t += 2) {
            const bool last = (t == nt - 2);
            const char* a1 = cA + (size_t)(t + 1) * kstep;
            const char* a2 = last ? nA : cA + (size_t)(t + 2) * kstep; const char* b2 = last ? nB : cB + (size_t)(t + 2) * kstep;
            const char* a3 = a2 + kstep; const char* b3 = b2 + kstep;
            if (last && has_next) S.a_ready(nxt);
            if constexpr (SP2) {
            PG8_LDB(B0, 0, 0); PG8_LDB(B1, 0, 1); PG8_SCHED; PG8_LDA(At, 0, 0); PG8_STAGE(PG8_SA(1, 1), a1 + hstepA, voffA);
            PG8_WAIT_V(8); PG8_WAIT_L(0); PG8_BAR; PG8_MMA(0, 0, At, B0); PG8_MMA(0, 1, At, B1); PG8_BAR; PG8_SCHED;
            PG8_LDA(At, 0, 1); PG8_STAGE(PG8_SB(0, 0), b2, voffB); PG8_STAGE(PG8_SB(0, 1), b2 + hstepB, voffB); PG8_STAGE(PG8_SA(0, 0), a2, voffA);
            PG8_WAIT_V(8); PG8_WAIT_L(0); PG8_BAR; PG8_MMA(1, 0, At, B0); PG8_MMA(1, 1, At, B1); PG8_BAR; PG8_SCHED;
            PG8_LDB(B0, 1, 0); PG8_LDB(B1, 1, 1); PG8_SCHED; PG8_LDA(At, 1, 0); PG8_STAGE(PG8_SA(0, 1), a2 + hstepA, voffA);
            PG8_WAIT_V(8); PG8_WAIT_L(0); PG8_BAR; PG8_MMA(0, 0, At, B0); PG8_MMA(0, 1, At, B1); PG8_BAR; PG8_SCHED;
            PG8_LDA(At, 1, 1); PG8_STAGE(PG8_SB(1, 0), b3, voffB); PG8_STAGE(PG8_SB(1, 1), b3 + hstepB, voffB); PG8_STAGE(PG8_SA(1, 0), a3, voffA);
            PG8_WAIT_V(8); PG8_WAIT_L(0); PG8_BAR; PG8_MMA(1, 0, At, B0); PG8_MMA(1, 1, At, B1); PG8_BAR; PG8_SCHED;
            } else {
            PG8_LDB(B0, 0, 0); PG8_SCHED; PG8_LDA(At, 0, 0); PG8_STAGE(PG8_SA(1, 1), a1 + hstepA, voffA);
            PG8_WAIT_L(8); PG8_BAR; PG8_WAIT_L(0); PG8_MMA(0, 0, At, B0); PG8_BAR; PG8_SCHED;
            PG8_LDB(B1, 0, 1); PG8_STAGE(PG8_SB(0, 0), b2, voffB);
            PG8_BAR; PG8_WAIT_L(0); PG8_MMA(0, 1, At, B1); PG8_BAR;
            PG8_LDA(At, 0, 1); PG8_STAGE(PG8_SA(0, 0), a2, voffA);
            PG8_BAR; PG8_WAIT_L(0); PG8_MMA(1, 0, At, B0); PG8_BAR; PG8_SCHED;
            PG8_STAGE(PG8_SB(0, 1), b2 + hstepB, voffB);
            PG8_WAIT_V(6); PG8_BAR; PG8_MMA(1, 1, At, B1); PG8_BAR;
            PG8_LDB(B0, 1, 0); PG8_SCHED; PG8_LDA(At, 1, 0); PG8_STAGE(PG8_SA(0, 1), a2 + hstepA, voffA);
            PG8_WAIT_L(8); PG8_BAR; PG8_WAIT_L(0); PG8_MMA(0, 0, At, B0); PG8_BAR; PG8_SCHED;
            PG8_LDB(B1, 1, 1); PG8_STAGE(PG8_SB(1, 0), b3, voffB);
            PG8_BAR; PG8_WAIT_L(0); PG8_MMA(0, 1, At, B1); PG8_BAR;
            PG8_LDA(At, 1, 1); PG8_STAGE(PG8_SA(1, 0), a3, voffA);
            PG8_BAR; PG8_WAIT_L(0); PG8_MMA(1, 0, At, B0); PG8_BAR; PG8_SCHED;
            PG8_STAGE(PG8_SB(1, 1), b3 + hstepB, voffB);
            PG8_WAIT_V(6); PG8_BAR; PG8_MMA(1, 1, At, B1); PG8_BAR;
            }
        }
        if constexpr (ALIGN_EPI) { if (wr == 0) PG8_BAR; }
        if constexpr (!Epi::AFTER_DRAIN) { E(acc, cur, wr, wc, fr, fq); S.done(cur); }
        if (!has_next) break;
#pragma unroll
        for (int a = 0; a < 2; ++a)
#pragma unroll
            for (int b = 0; b < 2; ++b)
#pragma unroll
                for (int m = 0; m < 4; ++m)
#pragma unroll
                    for (int n = 0; n < 2; ++n) acc[a][b][m][n] = (f32x4){0.f, 0.f, 0.f, 0.f};
        cur = nxt; cA = nA; cB = nB; ++ui;
        if constexpr (ALIGN_EPI) { if (wr == 1) PG8_BAR; }
    }
    PG8_WAIT_V(0);
    if constexpr (!ALIGN_EPI) { if (wr == 0) PG8_BAR; }
    PG8_BAR;
    if constexpr (Epi::AFTER_DRAIN) { E.fused(acc, cur, wr, wc, fr, fq, lds, wid, lane); S.done(cur); }
#undef PG8_SA
#undef PG8_SB
#undef PG8_STAGE
#undef PG8_LDA
#undef PG8_LDB
#undef PG8_MMA
#undef PG8_WAIT_V
#undef PG8_WAIT_L
#undef PG8_BAR
#undef PG8_SCHED
}
}
constexpr size_t MiB = 1u << 20;
constexpr size_t WS_CTL = 0, CTL_ZERO_BYTES = 1 * MiB;
constexpr size_t WS_SSQ = 1 * MiB;
constexpr size_t WS_ROPE_C = 2 * MiB, WS_ROPE_S = 3 * MiB;
constexpr size_t WS_MEMN = 4 * MiB;
constexpr size_t WS_MK = 5 * MiB, WS_MVT = 6 * MiB;
constexpr size_t WS_KB = 7 * MiB, WS_VT = 10 * MiB;
constexpr size_t WS_WPOOL = 13 * MiB;
constexpr size_t WS_WMKV = 16 * MiB;
constexpr size_t WS_WIN = 32 * MiB, WS_WOUT = 64 * MiB;
constexpr size_t WS_WD = 96 * MiB, WD_BYTES = (size_t)cfg::D * cfg::FF * 2;
constexpr size_t WS_WGU = 272 * MiB, WGU_BYTES = (size_t)cfg::NGU_PAD * cfg::D * 2;
constexpr size_t WS_HB = 640 * MiB;
constexpr size_t WS_AQ = 672 * MiB;
constexpr size_t WS_Y = 704 * MiB;
constexpr size_t WS_HFF = 736 * MiB;
constexpr size_t WS_Z = WS_HFF;
constexpr size_t WS_END = 824 * MiB;
static_assert(WS_WD + 8 * WD_BYTES == WS_WGU && WS_WGU + 8 * WGU_BYTES == WS_HB && WS_HFF + (size_t)cfg::S * cfg::FF * 2 == WS_END, "d_ws map");
constexpr int CW_BAR = 4096;
constexpr int RING_OFF = 0, RING_BYTES = 131072;
constexpr int LDSCTL_OFF = RING_BYTES, MISC_OFF = LDSCTL_OFF + 320;
constexpr int LDS_BYTES = 147456;
constexpr int NWAVES = 8;

#define GAS __attribute__((address_space(1)))
#define LAS __attribute__((address_space(3)))
typedef unsigned short bf16;
typedef unsigned v4u __attribute__((ext_vector_type(4)));
typedef unsigned v2u __attribute__((ext_vector_type(2)));
typedef float f32x4 __attribute__((ext_vector_type(4)));
typedef float f32x16 __attribute__((ext_vector_type(16)));
typedef short bf16x8 __attribute__((ext_vector_type(8)));
typedef short s16x4 __attribute__((ext_vector_type(4)));
#define LDS_WAIT() asm volatile("s_waitcnt lgkmcnt(0)" ::: "memory")
#define VM_WAIT() asm volatile("s_waitcnt vmcnt(0)" ::: "memory")
using pg8::pkbf;

#define XB_TMO      128
#define XB_XCNT(j)  (256  + 64 * (j))
#define XB_XSUB(j)  (1280 + 64 * (j))
#define XB_XGEN(j)  (2304 + 64 * (j))
#define XB_TOP      3328
#define XB_TOPGEN   3392
#define XCD_BAR_WORDS 3456
#define XB_SPIN_CAP (1u << 18)

__device__ __forceinline__ unsigned xb_ld(unsigned* p)              { return __hip_atomic_load(p, __ATOMIC_RELAXED, __HIP_MEMORY_SCOPE_AGENT); }
__device__ __forceinline__ unsigned xb_add(unsigned* p, unsigned v) { return __hip_atomic_fetch_add(p, v, __ATOMIC_RELAXED, __HIP_MEMORY_SCOPE_AGENT); }
__device__ __forceinline__ unsigned xb_xcc_id() { return (unsigned)__builtin_amdgcn_s_getreg((3 << 11) | 20) & 0xFu; }
#define XB_SPIN(cond, bar) do { unsigned _sp = 0; while (cond) { __builtin_amdgcn_s_sleep(1); \
    if ((++_sp & 255u) == 0u) { if (xb_ld(&(bar)[XB_TMO])) break; if (_sp > XB_SPIN_CAP) { atomicAdd(&(bar)[XB_TMO], 1u); break; } } } } while (0)

struct XcdBarrier {
    unsigned* bar; unsigned x;
    volatile LAS unsigned* st;
};

__device__ __forceinline__ XcdBarrier xcd_barrier_post(unsigned* bar, volatile LAS unsigned* st) {
    XcdBarrier b; b.bar = bar; b.x = xb_xcc_id(); b.st = st;
    if (threadIdx.x == 0) (void)xb_add(&bar[XB_XCNT(b.x)], 1u);
    return b;
}
__device__ __forceinline__ void xcd_barrier_complete(unsigned* bar, unsigned x, unsigned& nloc, unsigned& nx) {
    const unsigned G = gridDim.x * gridDim.y * gridDim.z;
    unsigned sum, cnt, mine, sp = 0u;
    for (;;) {
        sum = 0u; cnt = 0u; mine = 0u;
#pragma unroll
        for (unsigned j = 0; j < 16; ++j) { const unsigned c = xb_ld(&bar[XB_XCNT(j)]); sum += c; cnt += (c > 0u) ? 1u : 0u; mine = (j == x) ? c : mine; }
        if (sum == G) break;
        __builtin_amdgcn_s_sleep(1);
        if ((++sp & 255u) == 0u) { if (xb_ld(&bar[XB_TMO])) break; if (sp > XB_SPIN_CAP) { atomicAdd(&bar[XB_TMO], 1u); break; } }
    }
    nloc = mine > 0u ? mine : 1u; nx = cnt > 0u ? cnt : 1u;
}

__device__ __forceinline__ void xcd_barrier(const XcdBarrier& b) {
    asm volatile("s_waitcnt vmcnt(0)" ::: "memory");
    __syncthreads();
    if (threadIdx.x == 0) {
        unsigned* bar = b.bar;
        __builtin_amdgcn_s_waitcnt(0);
        unsigned nloc = b.st[0], nx = b.st[1];
        if (nloc == 0u) { xcd_barrier_complete(bar, b.x, nloc, nx); b.st[0] = nloc; b.st[1] = nx; }
        const unsigned old = xb_add(&bar[XB_XSUB(b.x)], 1u);
        const unsigned gen = old / nloc;
        if (old + 1u == (gen + 1u) * nloc) {
            __builtin_amdgcn_fence(__ATOMIC_RELEASE, "agent");
            asm volatile("s_waitcnt vmcnt(0)" ::: "memory");
            const unsigned og = xb_add(&bar[XB_TOP], 1u);
            const unsigned tg = og / nx;
            if (og + 1u == (tg + 1u) * nx) xb_add(&bar[XB_TOPGEN], 1u);
            else XB_SPIN(xb_ld(&bar[XB_TOPGEN]) == tg, bar);
            __builtin_amdgcn_fence(__ATOMIC_ACQUIRE, "agent");
            xb_add(&bar[XB_XGEN(b.x)], 1u);
            asm volatile("s_waitcnt vmcnt(0)" ::: "memory");
        } else {
            XB_SPIN(xb_ld(&bar[XB_XGEN(b.x)]) == gen, bar);
            __builtin_amdgcn_fence(__ATOMIC_ACQUIRE, "agent");
            asm volatile("s_waitcnt vmcnt(0)" ::: "memory");
        }
    }
    __syncthreads();
}

struct Frame {
    LAS unsigned char* lds;
    volatile LAS unsigned* MISC;
    int tid, lane, wave, vcu, G;
    const float *x, *mem; const int* pos; const float *norms, *gate, *up, *down, *w_in, *w_out, *pool_w, *pool_scale, *w_kv, *kv_norm, *sinks, *w_mem_kv, *mem_norm, *final_norm;
    float* out; unsigned char* ws;
};
__device__ __forceinline__ float wave_sum(float v) {
#pragma unroll
    for (int o = 1; o < 64; o <<= 1) v += __shfl_xor(v, o);
    return v;
}
__device__ __forceinline__ int rope_slot(int d) { return 8 * ((d & 31) >> 2) + 4 * (d >> 5) + (d & 3); }
__device__ __forceinline__ int map_row(int map, int n) {
    if (map == 1) return (n >> 7) * 256 + (n & 127);
    if (map == 2) return (n >> 7) * 256 + 128 + (n & 127);
    if (map == 3) return n < 1536 ? (n & ~63) + rope_slot(n & 63) : n;
    if (map == 4) return n < 192 ? (n & ~63) + rope_slot(n & 63) : n;
    return n;
}
__device__ __forceinline__ void conv_item(const float* W, int N, int k0, int n0, const float* gain, bf16* dst, int dst_ld, int map, int row_off, LAS float* scr, int lane) {
#pragma unroll
    for (int i = 0; i < 8; ++i) { const int kr = (lane >> 3) + 8 * i; const f32x4 v = __builtin_nontemporal_load((const f32x4*)(W + (size_t)(k0 + kr) * N + n0 + (lane & 7) * 4));
        LAS float* s = scr + kr * 33 + (lane & 7) * 4; s[0] = v[0]; s[1] = v[1]; s[2] = v[2]; s[3] = v[3]; }
    const int c = lane & 7;
    f32x4 g0 = (f32x4){1.f, 1.f, 1.f, 1.f}, g1 = g0;
    if (gain) { g0 = *(const f32x4*)(gain + k0 + 8 * c); g1 = *(const f32x4*)(gain + k0 + 8 * c + 4); }
    LDS_WAIT(); asm volatile("" ::: "memory");
#pragma unroll
    for (int j = 0; j < 4; ++j) { const int n = (lane >> 3) + 8 * j; const LAS float* s = scr + (8 * c) * 33 + n;
        v4u o; o.x = pkbf(s[0 * 33] * g0[0], s[1 * 33] * g0[1]); o.y = pkbf(s[2 * 33] * g0[2], s[3 * 33] * g0[3]); o.z = pkbf(s[4 * 33] * g1[0], s[5 * 33] * g1[1]); o.w = pkbf(s[6 * 33] * g1[2], s[7 * 33] * g1[3]);
        *(v4u*)(dst + (size_t)(map_row(map, n0 + n) + row_off) * dst_ld + k0 + 8 * c) = o; }
    LDS_WAIT(); asm volatile("" ::: "memory");
}
constexpr int CV_FFN = 24 * 5632, CV_IO = 8 * 2048, CV_MKV = 4 * 1024, CV_POOL = 8 * 72, CV_KV = 384, CV_TOTAL = CV_FFN + CV_IO + CV_MKV + CV_POOL + CV_KV;
__device__ __forceinline__ void conv_dispatch(Frame& F, int it, LAS float* scr) {
    using namespace cfg;
    if (it < CV_FFN) { const int mat = it / 5632, r = it % 5632, i8 = mat / 3, kind = mat % 3, l = i8 >> 1, half = i8 & 1;
        if (kind < 2) conv_item((kind ? F.up : F.gate) + (size_t)i8 * D * FF, FF, 64 * (r / 176), 32 * (r % 176), F.norms + (size_t)(l * 3 + (half ? 2 : 0)) * D, (bf16*)(F.ws + WS_WGU + (size_t)i8 * WGU_BYTES), D, 1 + kind, 0, scr, F.lane);
        else conv_item(F.down + (size_t)i8 * FF * D, D, 64 * (r / 64), 32 * (r % 64), nullptr, (bf16*)(F.ws + WS_WD + (size_t)i8 * WD_BYTES), FF, 0, 0, scr, F.lane);
        return; }
    it -= CV_FFN;
    if (it < CV_IO) { const int mat = it / 2048, r = it % 2048, l = mat & 3;
        if (mat < 4) conv_item(F.w_in + (size_t)l * D * D, D, 64 * (r / 64), 32 * (r % 64), F.norms + (size_t)(l * 3 + 1) * D, (bf16*)(F.ws + WS_WIN) + (size_t)l * D * D, D, l >= 2 ? 3 : 0, 0, scr, F.lane);
        else conv_item(F.w_out + (size_t)l * D * D, D, 64 * (r / 64), 32 * (r % 64), nullptr, (bf16*)(F.ws + WS_WOUT) + (size_t)l * D * D, D, 0, 0, scr, F.lane);
        return; }
    it -= CV_IO;
    if (it < CV_MKV) { const int l = it / 1024, r = it % 1024;
        conv_item(F.w_mem_kv + (size_t)l * D * 1024, 1024, 64 * (r / 32), 32 * (r % 32), nullptr, (bf16*)(F.ws + WS_WMKV), D, 0, l * 1024, scr, F.lane); return; }
    it -= CV_MKV;
    if (it < CV_POOL) { const int pg = it / 72, r = it % 72, l = pg >> 2, g = pg & 3;
        conv_item(F.pool_w + (size_t)pg * 384 * 384, 384, 64 * (r / 12), 32 * (r % 12), nullptr, (bf16*)(F.ws + WS_WPOOL) + (size_t)l * 2048 * 384, 384, 0, g * 512, scr, F.lane); return; }
    it -= CV_POOL;
    conv_item(F.w_kv, 384, 64 * (it / 12), 32 * (it % 12), F.kv_norm, (bf16*)(F.ws + WS_WGU + 4 * WGU_BYTES), D, 4, NGU, scr, F.lane);
}
__device__ __forceinline__ void p0_prologue(Frame& F) {
    using namespace cfg;
    LAS float* scr = (LAS float*)(F.lds + RING_OFF + F.wave * 16384);
    const int gw = F.vcu * NWAVES + F.wave, NGW = F.G * NWAVES;
    for (int it = gw; it < CV_TOTAL; it += NGW) conv_dispatch(F, it, scr);
    bf16* HB = (bf16*)(F.ws + WS_HB); float* ssq = (float*)(F.ws + WS_SSQ);
    for (int m = gw; m < S; m += NGW) { const f32x4* xr = (const f32x4*)(F.x + (size_t)m * D) + F.lane; float s = 0.f; v2u* o8 = (v2u*)(HB + (size_t)m * D) + F.lane;
#pragma unroll
        for (int j = 0; j < 8; ++j) { const f32x4 v = xr[64 * j]; s += (v[0] * v[0] + v[1] * v[1]) + (v[2] * v[2] + v[3] * v[3]); v2u w; w.x = pkbf(v[0], v[1]); w.y = pkbf(v[2], v[3]); o8[64 * j] = w; }
        s = wave_sum(s);
        if (F.lane < 8) ssq[(size_t)m * 8 + F.lane] = F.lane == 0 ? s : 0.f; }
    bf16* MEMN = (bf16*)(F.ws + WS_MEMN);
    for (int m = gw; m < ML; m += NGW) { const f32x4* xr = (const f32x4*)(F.mem + (size_t)m * D) + F.lane; const f32x4* gr = (const f32x4*)F.mem_norm + F.lane; float s = 0.f; f32x4 v[8];
#pragma unroll
        for (int j = 0; j < 8; ++j) { v[j] = xr[64 * j]; s += (v[j][0] * v[j][0] + v[j][1] * v[j][1]) + (v[j][2] * v[j][2] + v[j][3] * v[j][3]); }
        const float rs = __builtin_amdgcn_rsqf(wave_sum(s) * (1.0f / D) + EPS); v2u* o8 = (v2u*)(MEMN + (size_t)m * D) + F.lane;
#pragma unroll
        for (int j = 0; j < 8; ++j) { const f32x4 g = gr[64 * j]; v2u w; w.x = pkbf(v[j][0] * rs * g[0], v[j][1] * rs * g[1]); w.y = pkbf(v[j][2] * rs * g[2], v[j][3] * rs * g[3]); o8[64 * j] = w; } }
    float* rc = (float*)(F.ws + WS_ROPE_C); float* rsn = (float*)(F.ws + WS_ROPE_S);
    for (int idx = gw * 64 + F.lane; idx < S * 32; idx += NGW * 64) { const int t = idx >> 5, i = idx & 31;
        const float inv_freq = 1.0f / powf(10000.0f, (float)i * (2.0f / 64.0f)); const float ang = (float)F.pos[t] * inv_freq; float sn, cs; sincosf(ang, &sn, &cs); rc[idx] = cs; rsn[idx] = sn; }
}
#define MFMA32(a, b, c) __builtin_amdgcn_mfma_f32_32x32x16_bf16((a), (b), (c), 0, 0, 0)
__device__ __forceinline__ bf16x8 cat8(s16x4 a, s16x4 b) { return __builtin_shufflevector(a, b, 0, 1, 2, 3, 4, 5, 6, 7); }
template <int ND> __device__ __forceinline__ void softmax_tile(f32x16& p, float& m, float& lsum, f32x16 (&o)[ND], bf16x8 (&pb)[2]) {
    float tm = p[0];
#pragma unroll
    for (int r = 1; r < 16; ++r) tm = fmaxf(tm, p[r]);
    tm = fmaxf(tm, __shfl_xor(tm, 32));
    const float mn = fmaxf(m, tm), f = __builtin_amdgcn_exp2f(m - mn); m = mn;
    float ps = 0.f;
#pragma unroll
    for (int r = 0; r < 16; ++r) { p[r] = __builtin_amdgcn_exp2f(p[r] - mn); ps += p[r]; }
    lsum = lsum * f + ps;
#pragma unroll
    for (int d = 0; d < ND; ++d)
#pragma unroll
        for (int r = 0; r < 16; ++r) o[d][r] *= f;
#pragma unroll
    for (int s = 0; s < 2; ++s) { v4u w; w.x = pkbf(p[8 * s + 0], p[8 * s + 1]); w.y = pkbf(p[8 * s + 2], p[8 * s + 3]); w.z = pkbf(p[8 * s + 4], p[8 * s + 5]); w.w = pkbf(p[8 * s + 6], p[8 * s + 7]); pb[s] = __builtin_bit_cast(bf16x8, w); }
}
__device__ __forceinline__ int opaque_lane() { int t = threadIdx.x; asm volatile("" : "+v"(t)); return t & 63; }
__device__ __forceinline__ void mem_item(Frame& F, int l, int h, int q0) {
    const int lane = opaque_lane(), r32 = lane & 31, hi = lane >> 5;
    const bf16* AQ = (const bf16*)(F.ws + WS_AQ); bf16* Y = (bf16*)(F.ws + WS_Y);
    const bf16* Qp = AQ + (size_t)(q0 + r32) * 2048 + 1536 + h * 128 + 8 * hi;
    const bf16* Kp = (const bf16*)(F.ws + WS_MK) + ((size_t)l * 256 + r32) * 512 + h * 128 + 8 * hi;
    const bf16* Vp = (const bf16*)(F.ws + WS_MVT) + ((size_t)l * 512 + h * 128 + r32) * 256 + 4 * hi;
    bf16x8 qf[8];
#pragma unroll
    for (int j = 0; j < 8; ++j) qf[j] = *(const bf16x8*)(Qp + 16 * j);
    f32x16 o[4];
#pragma unroll
    for (int d = 0; d < 4; ++d)
#pragma unroll
        for (int r = 0; r < 16; ++r) o[d][r] = 0.f;
    float m = -1e30f, lsum = 0.f;
    for (int kt = 0; kt < 8; ++kt) {
        f32x16 p;
#pragma unroll
        for (int r = 0; r < 16; ++r) p[r] = 0.f;
#pragma unroll
        for (int j = 0; j < 8; ++j) { const bf16x8 kf = *(const bf16x8*)(Kp + (size_t)kt * 32 * 512 + 16 * j); p = MFMA32(kf, qf[j], p); }
        bf16x8 pb[2]; softmax_tile<4>(p, m, lsum, o, pb);
#pragma unroll
        for (int d = 0; d < 4; ++d)
#pragma unroll
            for (int s = 0; s < 2; ++s) { const bf16* vp = Vp + (size_t)d * 32 * 256 + kt * 32 + 16 * s; const bf16x8 vf = cat8(*(const s16x4*)vp, *(const s16x4*)(vp + 8)); o[d] = MFMA32(vf, pb[s], o[d]); }
    }
    lsum += __shfl_xor(lsum, 32); const float inv = 1.0f / lsum;
    bf16* yp = Y + (size_t)(q0 + r32) * 2048 + 1536 + h * 128 + 4 * hi;
#pragma unroll
    for (int d = 0; d < 4; ++d)
#pragma unroll
        for (int g = 0; g < 4; ++g) { v2u w; w.x = pkbf(o[d][4 * g] * inv, o[d][4 * g + 1] * inv); w.y = pkbf(o[d][4 * g + 2] * inv, o[d][4 * g + 3] * inv); *(v2u*)(yp + d * 32 + 8 * g) = w; }
}
__device__ __forceinline__ void swa_item(Frame& F, int l, int hq, int qb) {
    const int lane = opaque_lane(), r32 = lane & 31, hi = lane >> 5, kvh = hq >> 3, q0 = qb * 32;
    const bf16* AQ = (const bf16*)(F.ws + WS_AQ); bf16* Y = (bf16*)(F.ws + WS_Y);
    const bf16* Qp = AQ + (size_t)(q0 + r32) * 2048 + hq * 64 + 8 * hi;
    const bf16* Kp = (const bf16*)(F.ws + WS_KB) + (size_t)r32 * 192 + kvh * 64 + 8 * hi;
    const bf16* Vp = (const bf16*)(F.ws + WS_VT) + (size_t)(kvh * 64 + r32) * cfg::S + 4 * hi;
    bf16x8 qf[4];
#pragma unroll
    for (int j = 0; j < 4; ++j) qf[j] = *(const bf16x8*)(Qp + 16 * j);
    f32x16 o[2];
#pragma unroll
    for (int d = 0; d < 2; ++d)
#pragma unroll
        for (int r = 0; r < 16; ++r) o[d][r] = 0.f;
    float m = F.sinks[(l - 2) * cfg::NQH + hq] * cfg::LOG2E, lsum = hi == 0 ? 1.0f : 0.0f;
    for (int i = 0; i < 5; ++i) { const int kt = qb - 4 + i; if (kt < 0) continue; const int key0 = kt * 32;
        f32x16 p;
#pragma unroll
        for (int r = 0; r < 16; ++r) p[r] = 0.f;
#pragma unroll
        for (int j = 0; j < 4; ++j) { const bf16x8 kf = *(const bf16x8*)(Kp + (size_t)key0 * 192 + 16 * j); p = MFMA32(kf, qf[j], p); }
        if (i == 0 || i == 4) {
#pragma unroll
            for (int r = 0; r < 16; ++r) { const int jj = (r & 3) + 8 * (r >> 2) + 4 * hi; const bool ok = (i == 0) ? (jj >= r32 + 1) : (jj <= r32); p[r] = ok ? p[r] : -INFINITY; } }
        bf16x8 pb[2]; softmax_tile<2>(p, m, lsum, o, pb);
#pragma unroll
        for (int d = 0; d < 2; ++d)
#pragma unroll
            for (int s = 0; s < 2; ++s) { const bf16* vp = Vp + (size_t)d * 32 * cfg::S + key0 + 16 * s; const bf16x8 vf = cat8(*(const s16x4*)vp, *(const s16x4*)(vp + 8)); o[d] = MFMA32(vf, pb[s], o[d]); }
    }
    lsum += __shfl_xor(lsum, 32); const float inv = 1.0f / lsum;
    bf16* yp = Y + (size_t)(q0 + r32) * 2048 + hq * 64 + 4 * hi;
#pragma unroll
    for (int d = 0; d < 2; ++d)
#pragma unroll
        for (int g = 0; g < 4; ++g) { v2u w; w.x = pkbf(o[d][4 * g] * inv, o[d][4 * g + 1] * inv); w.y = pkbf(o[d][4 * g + 2] * inv, o[d][4 * g + 3] * inv); *(v2u*)(yp + d * 32 + 8 * g) = w; }
}
__device__ __forceinline__ void poolw_item(Frame& F, int l, int chunk, int rb) {
    const float* Z = (const float*)(F.ws + WS_Z); bf16* Y = (bf16*)(F.ws + WS_Y);
    const int lane = opaque_lane(), w = 2 << (chunk / 3), c = chunk * 128 + (lane & 31) * 4;
    const f32x4 sc = *(const f32x4*)(F.pool_scale + (size_t)l * cfg::MIX + c);
    for (int i = 0; i < 32; ++i) { const int t = rb * 64 + 2 * i + (lane >> 5);
        f32x4 s = (f32x4){0.f, 0.f, 0.f, 0.f};
        for (int jj = 0; jj < w; ++jj) { const int j = t - jj; if (j >= 0) s += *(const f32x4*)(Z + (size_t)j * cfg::MIX + c); }
        const float rc = 1.0f / (float)(t + 1 < w ? t + 1 : w); const f32x4 zt = *(const f32x4*)(Z + (size_t)t * cfg::MIX + c); const f32x4 y = (s * rc - zt) * sc;
        v2u o; o.x = pkbf(y[0], y[1]); o.y = pkbf(y[2], y[3]); *(v2u*)(Y + (size_t)t * 2048 + c) = o; }
}
constexpr int PH_END = 66;
struct Args { const float* in[17]; float* out; unsigned char* ws; int ph_lo, ph_hi; };
__global__ void __launch_bounds__(NWAVES * 64, 2) yoco_fwd(Args args) {
    extern __shared__ __attribute__((aligned(16))) unsigned char lds[];
    using namespace cfg;
    Frame F;
    F.lds = (LAS unsigned char*)lds;
    F.MISC = (volatile LAS unsigned*)(F.lds + MISC_OFF);
    F.tid = threadIdx.x; F.lane = F.tid & 63; F.wave = __builtin_amdgcn_readfirstlane(F.tid >> 6);
    F.G = gridDim.x; { const int bx = blockIdx.x; F.vcu = (F.G % 8 == 0) ? (bx % 8) * (F.G / 8) + bx / 8 : bx; }
    F.x = args.in[0]; F.mem = args.in[1]; F.pos = (const int*)args.in[2]; F.norms = args.in[3]; F.gate = args.in[4]; F.up = args.in[5]; F.down = args.in[6]; F.w_in = args.in[7]; F.w_out = args.in[8];
    F.pool_w = args.in[9]; F.pool_scale = args.in[10]; F.w_kv = args.in[11]; F.kv_norm = args.in[12]; F.sinks = args.in[13]; F.w_mem_kv = args.in[14]; F.mem_norm = args.in[15]; F.final_norm = args.in[16];
    F.out = args.out; F.ws = args.ws;
    for (int u = F.tid; u < (LDS_BYTES - LDSCTL_OFF) / 4; u += NWAVES * 64) ((LAS unsigned*)(F.lds + LDSCTL_OFF))[u] = 0u;
    __syncthreads();
    XcdBarrier bar = xcd_barrier_post((unsigned*)(F.ws + WS_CTL) + CW_BAR, F.MISC + 8);
    const int lo = args.ph_lo, hi = args.ph_hi;
#define IN(k) (lo <= (k) && (k) < hi)
#define SEAM(k) do { if ((k) + 1 < hi) xcd_barrier(bar); } while (0)
    unsigned char* ws = F.ws;
    float* H = F.out; bf16* HB = (bf16*)(ws + WS_HB); float* SSQ = (float*)(ws + WS_SSQ); bf16* HFF = (bf16*)(ws + WS_HFF); bf16* AQ = (bf16*)(ws + WS_AQ); bf16* Y = (bf16*)(ws + WS_Y);
    const float* RC = (const float*)(ws + WS_ROPE_C); const float* RS = (const float*)(ws + WS_ROPE_S);
    const int bx = (int)blockIdx.x;

    if (IN(0)) { if constexpr (PHON(0)) p0_prologue(F); SEAM(0); }

    for (int i = 0; i < 8; ++i) {
        const int l = i >> 1, half = i & 1, base = 1 + 8 * i;
        if (IN(base)) {
            const bf16* WGU = (const bf16*)(ws + WS_WGU + (size_t)i * WGU_BYTES);
            if constexpr (PHON(1)) { pg8::Gemm g{HB, WGU, D, D, D}; pg8::StaticOrder S_; S_.init(S, NGU, F.G, bx); pg8::EpiSwiGLU E{HFF, SSQ};
              pg8::gemm_phase<pg8::EpiSwiGLU, pg8::StaticOrder, true, true>(F.lds + RING_OFF, g, S_, E); }
            if constexpr (PHON(2)) if (i == 0) {
                pg8::Gemm g{(const bf16*)(ws + WS_MEMN), (const bf16*)(ws + WS_WMKV), D, D, D}; pg8::SubsetOrder S_{128, 16, 16, bx}; pg8::EpiMemKV E{(bf16*)(ws + WS_MK), (bf16*)(ws + WS_MVT)};
                pg8::gemm_phase<pg8::EpiMemKV, pg8::SubsetOrder, false, true>(F.lds + RING_OFF, g, S_, E); }
            if constexpr (PHON(3)) if (i == 4) {
                pg8::Gemm g{HB, WGU + (size_t)NGU * D, D, D, D}; pg8::SubsetOrder S_{128, 64, 2, bx}; pg8::EpiKV E{(bf16*)(ws + WS_KB), (bf16*)(ws + WS_VT), SSQ, RC, RS};
                pg8::gemm_phase<pg8::EpiKV, pg8::SubsetOrder, false, true>(F.lds + RING_OFF, g, S_, E); }
            SEAM(base);
        }
        if (IN(base + 1)) {
            pg8::Gemm g{HFF, (const bf16*)(ws + WS_WD + (size_t)i * WD_BYTES), FF, FF, FF}; pg8::StaticOrder S_; S_.init(S, D, F.G, bx);
            pg8::EpiResid E{i == 0 ? F.x : H, H, HB, SSQ, 0.5f};
            if constexpr (PHON(4)) pg8::gemm_phase<pg8::EpiResid, pg8::StaticOrder, false, true>(F.lds + RING_OFF, g, S_, E);
            SEAM(base + 1);
        }
        if (half == 0) {
            if (IN(base + 2)) {
                pg8::Gemm g{HB, (const bf16*)(ws + WS_WIN) + (size_t)l * D * D, D, D, D}; pg8::StaticOrder S_; S_.init(S, D, F.G, bx);
                pg8::EpiWin E{AQ, SSQ, RC, RS, l >= 2 ? 1 : 0};
                if constexpr (PHON(5)) pg8::gemm_phase<pg8::EpiWin, pg8::StaticOrder, false, true>(F.lds + RING_OFF, g, S_, E);
                SEAM(base + 2);
            }
            if (l < 2 && IN(base + 3)) {
                pg8::Gemm g{AQ, (const bf16*)(ws + WS_WPOOL) + (size_t)l * 2048 * 384, D, 384, 384}; pg8::PoolOrder S_; S_.init(S, D, F.G, bx);
                pg8::EpiPool E{(float*)(ws + WS_Z)};
                if constexpr (PHON(6)) pg8::gemm_phase<pg8::EpiPool, pg8::PoolOrder, false, true>(F.lds + RING_OFF, g, S_, E);
                SEAM(base + 3);
            }
            if (IN(base + 4)) {
                if (F.tid == 0) F.MISC[0] = 0u;
                __syncthreads();
                const int nit = l < 2 ? 10 : 28;
                if constexpr (PHON(7)) for (;;) {
                    unsigned idx = 0u;
                    if (F.lane == 0) idx = __hip_atomic_fetch_add((LAS unsigned*)(F.lds + MISC_OFF), 1u, __ATOMIC_RELAXED, __HIP_MEMORY_SCOPE_WORKGROUP);
                    idx = (unsigned)__builtin_amdgcn_readfirstlane((int)idx);
                    if ((int)idx >= nit) break;
                    if (idx < 4u) mem_item(F, l, (int)idx, F.vcu * 32);
                    else if (l < 2) { const int item = 6 * F.vcu + (int)idx - 4; poolw_item(F, l, item % 12, item / 12); }
                    else { const int k = (int)idx - 4, p = 3 * F.vcu + (k >> 3); swa_item(F, l, (p >> 8) * 8 + (k & 7), p & 255); }
                }
                SEAM(base + 4);
            }
            if (IN(base + 5)) {
                pg8::Gemm g{Y, (const bf16*)(ws + WS_WOUT) + (size_t)l * D * D, D, D, D}; pg8::StaticOrder S_; S_.init(S, D, F.G, bx);
                pg8::EpiResid E{H, H, HB, SSQ, 1.0f};
                if constexpr (PHON(8)) pg8::gemm_phase<pg8::EpiResid, pg8::StaticOrder, false, true>(F.lds + RING_OFF, g, S_, E);
                SEAM(base + 5);
            }
        }
    }
    if (IN(65)) {
        const int gw = F.vcu * NWAVES + F.wave, NGW = F.G * NWAVES;
        for (int m = gw; m < S; m += NGW) { const float rs = pg8::rstd_of(SSQ, m); f32x4* hr = (f32x4*)(H + (size_t)m * D) + F.lane; const f32x4* gr = (const f32x4*)F.final_norm + F.lane;
#pragma unroll
            for (int j = 0; j < 8; ++j) hr[64 * j] = hr[64 * j] * rs * gr[64 * j]; }
    }
#undef IN
#undef SEAM
}

static int g_grid = 0;
static bool setup_grid() {
    if (g_grid != 0) return g_grid > 0;
    int dev = 0, cus = 0, per_cu = 0;
    if (hipGetDevice(&dev) != hipSuccess || hipDeviceGetAttribute(&cus, hipDeviceAttributeMultiprocessorCount, dev) != hipSuccess) { fprintf(stderr, "kernel_launch: device query failed\n"); g_grid = -1; return false; }
    if (hipFuncSetAttribute((const void*)yoco_fwd, hipFuncAttributeMaxDynamicSharedMemorySize, LDS_BYTES) != hipSuccess) { fprintf(stderr, "kernel_launch: hipFuncSetAttribute failed\n"); g_grid = -1; return false; }
    if (hipOccupancyMaxActiveBlocksPerMultiprocessor(&per_cu, (const void*)yoco_fwd, NWAVES * 64, LDS_BYTES) != hipSuccess || per_cu < 1) { fprintf(stderr, "kernel_launch: occupancy query reports %d workgroups per CU\n", per_cu); }
    (void)hipGetLastError();
    g_grid = cus;
    return true;
}
static void launch_phases(hipStream_t stream, void* const* d_in, void* d_out, void* d_ws, int lo, int hi) {
    Args a{};
    for (int i = 0; i < 17; ++i) a.in[i] = (const float*)d_in[i];
    a.out = (float*)d_out; a.ws = (unsigned char*)d_ws; a.ph_lo = lo; a.ph_hi = hi;
    hipLaunchKernelGGL(yoco_fwd, dim3(g_grid), dim3(NWAVES * 64), LDS_BYTES, stream, a);
}
static bool phase_exists(int k) {
    if (k == 0 || k == 65) return true;
    if (k < 1 || k > 64) return false;
    const int i = (k - 1) / 8, j = (k - 1) % 8, l = i >> 1;
    if (j <= 1) return true;
    if (i & 1) return false;
    if (j == 3) return l < 2;
    return j <= 5;
}
#if DBG
namespace dbg {
template <int FT  , int TR  >
__global__ void __launch_bounds__(256) k_cmp(const void* fast, long fld, const float* orc, long old, int rows, int cols, float fscale, unsigned* res) {
    float md = 0.f, mr = 0.f;
    const size_t n = (size_t)rows * cols;
    for (size_t idx = (size_t)blockIdx.x * 256 + threadIdx.x; idx < n; idx += (size_t)gridDim.x * 256) {
        const int r = (int)(idx / cols), c = (int)(idx % cols);
        const float o = orc[(size_t)r * old + c] * fscale;
        const size_t fo = TR ? (size_t)c * fld + r : (size_t)r * fld + c;
        float f;
        if (FT) { const unsigned short b = ((const unsigned short*)fast)[fo]; f = __uint_as_float((unsigned)b << 16); } else f = ((const float*)fast)[fo];
        float d = fabsf(f - o); if (!(d == d) || d > 1e30f) d = 1e30f;
        md = fmaxf(md, d); mr = fmaxf(mr, fabsf(o));
    }
#pragma unroll
    for (int o = 1; o < 64; o <<= 1) { md = fmaxf(md, __shfl_xor(md, o)); mr = fmaxf(mr, __shfl_xor(mr, o)); }
    if ((threadIdx.x & 63) == 0) { atomicMax(res, __float_as_uint(md)); atomicMax(res + 1, __float_as_uint(mr)); }
}
__global__ void __launch_bounds__(1024) k_report(const unsigned* res, int n, float tol, float* out) {
    __shared__ int first; __shared__ float ratio;
    if (threadIdx.x == 0) { first = -1; ratio = 0.f;
        for (int i = 1; i < n; ++i) { const float d = __uint_as_float(res[2 * i]), r = fmaxf(__uint_as_float(res[2 * i + 1]), 1e-20f); if (d > tol * r) { first = i; ratio = d / r; break; } } }
    __syncthreads();
    if (first >= 0) { const float V = 100.0f * (float)first; int nbad = (int)(fminf(ratio, 1000.f) * 1000.f); nbad = nbad < 1 ? 1 : nbad;
        for (int j = threadIdx.x; j < nbad; j += 1024) out[j] = V; }
}
struct Ctx { hipStream_t st; unsigned* res; };
template <int FT, int TR> static void cmp(const Ctx& c, int id, const void* fast, long fld, const float* orc, long old, int rows, int cols, float fscale = 1.f) {
    hipLaunchKernelGGL((k_cmp<FT, TR>), dim3(2048), dim3(256), 0, c.st, fast, fld, orc, old, rows, cols, fscale, c.res + 2 * id);
}
static void run(hipStream_t st, void* const* d_in, void* d_out, void* d_ws, const ref::In& in) {
    using namespace ref;
    unsigned char* ws = (unsigned char*)d_ws;
    unsigned* res = (unsigned*)(ws + 512 * 1024);
    Ctx c{st, res};
    float* ob = (float*)(ws + WS_END);
    float* Ho = ob; float* XN = Ho + (size_t)S * D; float* G = XN + (size_t)S * D; float* U = G + (size_t)S * FF; float* A = U; float* Yo = U + (size_t)S * D; float* DIFF = U + (size_t)2 * S * D;
    float* KV = U + (size_t)S * FF; float* MEMN = KV + (size_t)S * 384; float* MKV = MEMN + (size_t)ML * D;
    const unsigned short* HBf = (const unsigned short*)(ws + WS_HB); const unsigned short* HFFf = (const unsigned short*)(ws + WS_HFF); const unsigned short* AQf = (const unsigned short*)(ws + WS_AQ); const unsigned short* Yf = (const unsigned short*)(ws + WS_Y);
    auto fast = [&](int k) { launch_phases(st, d_in, d_out, d_ws, k, k + 1); };
    hipLaunchKernelGGL(k_rmsnorm, dim3(ML / 4), dim3(256), 0, st, in.mem, in.mem_norm, MEMN, ML, D);
    fast(0);
    cmp<1, 0>(c, 1, ws + WS_MEMN, D, MEMN, D, ML, D);
    cmp<1, 0>(c, 2, HBf, D, in.x, D, S, D);
    const float* hin = in.x;
    for (int l = 0; l < DEPTH; ++l) {
        const int idb = 5 + 20 * l;
        for (int half = 0; half < 2; ++half) {
            const int i = 2 * l + half, base = 1 + 8 * i;
            hipLaunchKernelGGL(k_rmsnorm, dim3(S / 4), dim3(256), 0, st, hin, in.norms + (size_t)(l * 3 + (half ? 2 : 0)) * D, XN, S, D);
            const size_t wo = (size_t)i * D * FF;
            gemm<0>(st, XN, D, in.gate + wo, FF, G, FF, S, FF, D);
            gemm<0>(st, XN, D, in.up + wo, FF, U, FF, S, FF, D);
            hipLaunchKernelGGL(k_swiglu, dim3(4096), dim3(256), 0, st, G, U, (size_t)S * FF / 4);
            fast(base);
            cmp<1, 0>(c, idb + (half ? 13 : 1), HFFf, FF, G, FF, S, FF);
            if (i == 4) { cmp<1, 0>(c, idb + 2, ws + WS_KB, 192, KV, 384, S, 192); cmp<1, 1>(c, idb + 3, ws + WS_VT, S, KV + 192, 384, S, 192); }
            gemm<1>(st, G, FF, in.down + wo, D, Ho, D, S, D, FF, hin, 0.5f);
            hin = Ho;
            fast(base + 1);
            cmp<0, 0>(c, idb + (half ? 14 : 4), d_out, D, Ho, D, S, D);
            cmp<1, 0>(c, idb + (half ? 15 : 5), HBf, D, Ho, D, S, D);
            if (half == 1) break;
            hipLaunchKernelGGL(k_rmsnorm, dim3(S / 4), dim3(256), 0, st, Ho, in.norms + (size_t)(l * 3 + 1) * D, XN, S, D);
            gemm<0>(st, XN, D, in.w_in + (size_t)l * D * D, D, A, D, S, D, D);
            fast(base + 2);
            if (l >= NA) hipLaunchKernelGGL(k_rope, dim3(S * NQH * 32 / 256), dim3(256), 0, st, A, D, NQH, in.pos);
            cmp<1, 0>(c, idb + 6, AQf, D, A, D, S, MIX, l >= NA ? cfg::QSCALE : 1.f);
            cmp<1, 0>(c, idb + 7, AQf + MIX, D, A + MIX, D, S, 512, cfg::QMSCALE);
            if (l < NA) {
                hipLaunchKernelGGL(k_pool_diff, dim3(S * MIX / 256), dim3(256), 0, st, A, D, DIFF);
                for (int g = 0; g < 4; ++g) gemm<2>(st, DIFF + g * CG, MIX, in.pool_w + (size_t)(l * 4 + g) * CG * CG, CG, Yo + g * CG, D, S, CG, CG, nullptr, 1.f, in.pool_scale + (size_t)l * MIX + g * CG);
                fast(base + 3);
            } else {
                hipLaunchKernelGGL(k_swa, dim3(S * NQH / 4), dim3(256), 0, st, A, D, KV, 384, in.sinks + (size_t)(l - NA) * NQH, Yo, D);
            }
            gemm<0>(st, MEMN, D, in.w_mem_kv + (size_t)l * D * 1024, 1024, MKV, 1024, ML, 1024, D);
            cmp<1, 0>(c, idb + 8, ws + WS_MK + (size_t)l * 256 * 512 * 2, 512, MKV, 1024, ML, 512);
            cmp<1, 1>(c, idb + 9, ws + WS_MVT + (size_t)l * 512 * 256 * 2, 256, MKV + 512, 1024, ML, 512);
            hipLaunchKernelGGL(k_memattn, dim3(S * MH / 4), dim3(256), 0, st, A, D, MKV, Yo, D);
            fast(base + 4);
            cmp<1, 0>(c, idb + 10, Yf, D, Yo, D, S, MIX);
            cmp<1, 0>(c, idb + 11, Yf + MIX, D, Yo + MIX, D, S, 512);
            gemm<1>(st, Yo, D, in.w_out + (size_t)l * D * D, D, Ho, D, S, D, D, Ho, 1.0f);
            fast(base + 5);
            cmp<0, 0>(c, idb + 12, d_out, D, Ho, D, S, D);
        }
        if (l == NA - 1) {
            hipLaunchKernelGGL(k_rmsnorm, dim3(S / 4), dim3(256), 0, st, Ho, in.kv_norm, XN, S, D);
            gemm<0>(st, XN, D, in.w_kv, 384, KV, 384, S, 384, D);
            hipLaunchKernelGGL(k_rope, dim3(S * NKVH * 32 / 256), dim3(256), 0, st, KV, 384, NKVH, in.pos);
        }
    }
    hipLaunchKernelGGL(k_rmsnorm, dim3(S / 4), dim3(256), 0, st, Ho, in.final_norm, XN, S, D);
    fast(65);
    cmp<0, 0>(c, 90, d_out, D, XN, D, S, D);
    hipLaunchKernelGGL(k_report, dim3(1), dim3(1024), 0, st, res, 100, 0.05f, (float*)d_out);
}
}
#endif

extern "C" void kernel_launch(void* const* d_in, const int* in_sizes, int n_in, void* d_out, int out_size, void* d_ws, size_t ws_size, hipStream_t stream) {
    const size_t need = DBG ? WS_END + (size_t)530 * MiB : WS_END;
    if (n_in != 17 || out_size != cfg::S * cfg::D || ws_size < need) { fprintf(stderr, "kernel_launch: unexpected shapes n_in %d out %d ws %zu (need %zu)\n", n_in, out_size, ws_size, need); return; }
    if (!setup_grid()) return;
    if (hipMemsetAsync((char*)d_ws + WS_CTL, 0, CTL_ZERO_BYTES, stream) != hipSuccess) { fprintf(stderr, "kernel_launch: hipMemsetAsync failed\n"); return; }
#if DBG
    ref::In in;
    in.x = (const float*)d_in[0]; in.mem = (const float*)d_in[1]; in.pos = (const int*)d_in[2]; in.norms = (const float*)d_in[3];
    in.gate = (const float*)d_in[4]; in.up = (const float*)d_in[5]; in.down = (const float*)d_in[6]; in.w_in = (const float*)d_in[7]; in.w_out = (const float*)d_in[8];
    in.pool_w = (const float*)d_in[9]; in.pool_scale = (const float*)d_in[10]; in.w_kv = (const float*)d_in[11]; in.kv_norm = (const float*)d_in[12]; in.sinks = (const float*)d_in[13];
    in.w_mem_kv = (const float*)d_in[14]; in.mem_norm = (const float*)d_in[15]; in.final_norm = (const float*)d_in[16];
    dbg::run(stream, d_in, d_out, d_ws, in);
#elif defined(SPLIT_PHASES)
    for (int k = 0; k < PH_END; ++k) if (phase_exists(k)) launch_phases(stream, d_in, d_out, d_ws, k, k + 1);
#else
    launch_phases(stream, d_in, d_out, d_ws, 0, PH_END);
#endif
}
```

```cpp
#include <hip/hip_runtime.h>
#include <cstdio>
#include <cstdint>
#ifndef DBG
#define DBG 0
#endif
#ifndef PHMASK
#define PHMASK 0xFFFF
#endif
#define PHON(b) ((PHMASK >> (b)) & 1)
#ifndef REPMASK
#define REPMASK 0
#endif
#define NREP(c) (((REPMASK >> (c)) & 1) ? 2 : 1)
#ifndef EXPT
#define EXPT 0
#endif
#ifndef MIXEXP
#define MIXEXP 0
#endif
#ifndef HALFTAIL
#define HALFTAIL 0
#endif
#ifndef WT_STORES
#define WT_STORES 0
#endif
#ifndef CONV_NT
#define CONV_NT 0
#endif
#ifndef H_NT
#define H_NT 0
#endif
#ifndef GEMM_SP2
#define GEMM_SP2 true
#endif
#ifndef EARLY_WB
#define EARLY_WB 0
#endif
#ifndef LOOP_ALIGN
#define LOOP_ALIGN 0
#endif
#ifndef L2WARM
#define L2WARM 0
#endif
#ifndef BAL_DMA
#define BAL_DMA 1
#endif
#ifndef FUSE_SWA_MIX
#define FUSE_SWA_MIX 1
#endif
#ifndef GROUP_BAR
#define GROUP_BAR 1
#endif
#ifndef OWN_KV
#define OWN_KV 0
#endif
#ifndef OWN_POOLMIX
#define OWN_POOLMIX 1
#endif
#ifndef OWN_FINAL
#define OWN_FINAL 0
#endif
#ifndef B_NT_AUX
#define B_NT_AUX 0
#endif
#ifndef EARLY_ACQ
#define EARLY_ACQ 0
#endif
#ifndef SPLITK_TAIL
#define SPLITK_TAIL 0
#endif
#ifndef LDS_KV
#define LDS_KV 1
#endif
#ifndef ONEPASS_LDS
#define ONEPASS_LDS 0
#endif
#ifndef MMA_ORDER
#define MMA_ORDER 0
#endif
#ifndef CONV_REVERSE
#define CONV_REVERSE 1
#endif
#ifndef KSTAGGER
#define KSTAGGER 0
#endif
#ifndef MMA_SETPRIO
#define MMA_SETPRIO 1
#endif
#ifndef MMA_PRIO
#define MMA_PRIO 1
#endif
#ifndef DMA_SPLIT35
#define DMA_SPLIT35 0
#endif
#ifndef STAGE_AFTER_L
#define STAGE_AFTER_L 0
#endif
#ifndef STAGGER_TICKS
#define STAGGER_TICKS 0
#endif
#ifndef RESID_BATCH
#define RESID_BATCH 4
#endif
#ifndef RSTD_LDS
#define RSTD_LDS 1
#endif
#ifndef POOL_FOLD
#define POOL_FOLD 1
#endif
#ifndef STAGE_FIRST
#define STAGE_FIRST 0
#endif
#ifndef PROBE
#define PROBE 0
#endif
#ifndef PROBE_SA
#define PROBE_SA 64.0f
#endif
#ifndef PROBE_SB
#define PROBE_SB 640.0f
#endif
#ifndef PROBE_C
#define PROBE_C 2
#endif
#ifndef PROBE_Q
#define PROBE_Q -1
#endif
#ifndef PROBE_A
#define PROBE_A 1
#endif
#ifndef PROBE_B
#define PROBE_B 2
#endif
#if DBG
namespace ref {
constexpr int S = 8192, D = 2048, FF = 5632, DEPTH = 4, NA = 2, MIX = 1536, MEMW = 512, CG = 384, NQH = 24, NKVH = 3, HD = 64, WIN = 128, ML = 256, MH = 4, MHD = 128;
constexpr float EPS = 1e-5f;
typedef float f32x16 __attribute__((ext_vector_type(16)));

__device__ __forceinline__ float wave_sum(float v) {
#pragma unroll
    for (int o = 1; o < 64; o <<= 1) v += __shfl_xor(v, o);
    return v;
}
__device__ __forceinline__ float wave_max(float v) {
#pragma unroll
    for (int o = 1; o < 64; o <<= 1) v = fmaxf(v, __shfl_xor(v, o));
    return v;
}

__global__ void __launch_bounds__(256) k_rmsnorm(const float* __restrict__ x, const float* __restrict__ g, float* __restrict__ out, int nrows, int ncols) {
    const int row = blockIdx.x * 4 + (threadIdx.x >> 6), lane = threadIdx.x & 63;
    if (row >= nrows) return;
    const float* xr = x + (size_t)row * ncols; float* o = out + (size_t)row * ncols;
    float s = 0.f;
    for (int c = lane * 4; c < ncols; c += 256) { const float4 v = *(const float4*)(xr + c); s += v.x * v.x + v.y * v.y + v.z * v.z + v.w * v.w; }
    s = wave_sum(s);
    const float r = rsqrtf(s / (float)ncols + EPS);
    for (int c = lane * 4; c < ncols; c += 256) { const float4 v = *(const float4*)(xr + c); const float4 gg = *(const float4*)(g + c);
        float4 w; w.x = v.x * r * gg.x; w.y = v.y * r * gg.y; w.z = v.z * r * gg.z; w.w = v.w * r * gg.w; *(float4*)(o + c) = w; }
}

template <int EPI>
__global__ void __launch_bounds__(256) k_gemm(const float* __restrict__ A, int lda, const float* __restrict__ B, int ldb, float* C, int ldc, int K,
                                              const float* R, float alpha, const float* __restrict__ colscale) {
    __shared__ float As[16][132];
    __shared__ float Bs[16][132];
    const int t = threadIdx.x, lane = t & 63, w = t >> 6, wm = w >> 1, wn = w & 1, r32 = lane & 31, hi = lane >> 5;
    const int m0 = blockIdx.y * 128, n0 = blockIdx.x * 128;
    f32x16 acc[2][2];
#pragma unroll
    for (int i = 0; i < 2; ++i)
#pragma unroll
        for (int j = 0; j < 2; ++j)
#pragma unroll
            for (int r = 0; r < 16; ++r) acc[i][j][r] = 0.f;
    for (int k0 = 0; k0 < K; k0 += 16) {
#pragma unroll
        for (int i = 0; i < 2; ++i) {
            const int row = (t >> 2) + 64 * i, kq = (t & 3) * 4;
            const float4 a = *(const float4*)(A + (size_t)(m0 + row) * lda + k0 + kq);
            As[kq + 0][row] = a.x; As[kq + 1][row] = a.y; As[kq + 2][row] = a.z; As[kq + 3][row] = a.w;
            const int kr = (t >> 5) + 8 * i, nq = (t & 31) * 4;
            const float4 b = *(const float4*)(B + (size_t)(k0 + kr) * ldb + n0 + nq);
            *(float4*)&Bs[kr][nq] = b;
        }
        __syncthreads();
#pragma unroll
        for (int kk = 0; kk < 16; kk += 2) {
            float a[2], b[2];
#pragma unroll
            for (int i = 0; i < 2; ++i) { a[i] = As[kk + hi][wm * 64 + i * 32 + r32]; b[i] = Bs[kk + hi][wn * 64 + i * 32 + r32]; }
#pragma unroll
            for (int i = 0; i < 2; ++i)
#pragma unroll
                for (int j = 0; j < 2; ++j) acc[i][j] = __builtin_amdgcn_mfma_f32_32x32x2f32(a[i], b[j], acc[i][j], 0, 0, 0);
        }
        __syncthreads();
    }
#pragma unroll
    for (int i = 0; i < 2; ++i)
#pragma unroll
        for (int j = 0; j < 2; ++j)
#pragma unroll
            for (int r = 0; r < 16; ++r) {
                const int row = m0 + wm * 64 + i * 32 + (r & 3) + 8 * (r >> 2) + 4 * hi, col = n0 + wn * 64 + j * 32 + r32;
                const size_t o = (size_t)row * ldc + col; float v = acc[i][j][r];
                if (EPI == 1) v = R[o] + alpha * v;
                if (EPI == 2) v = v * colscale[col];
                C[o] = v;
            }
}

__global__ void __launch_bounds__(256) k_swiglu(float* g, const float* __restrict__ u, size_t n4) {
    size_t i = (size_t)blockIdx.x * 256 + threadIdx.x;
    const size_t stride = (size_t)gridDim.x * 256;
    for (; i < n4; i += stride) { float4 a = ((float4*)g)[i]; const float4 b = ((const float4*)u)[i];
        a.x = a.x / (1.f + expf(-a.x)) * b.x; a.y = a.y / (1.f + expf(-a.y)) * b.y; a.z = a.z / (1.f + expf(-a.z)) * b.z; a.w = a.w / (1.f + expf(-a.w)) * b.w; ((float4*)g)[i] = a; }
}

__global__ void __launch_bounds__(256) k_pool_diff(const float* __restrict__ a, int lda, float* __restrict__ diff) {
    const int idx = blockIdx.x * 256 + threadIdx.x;
    const int t = idx / MIX, c = idx % MIX, g = c / CG; const int w = 2 << g;
    float s = 0.f; const int j0 = (t - w + 1) < 0 ? 0 : (t - w + 1);
    for (int j = j0; j <= t; ++j) s += a[(size_t)j * lda + c];
    const float cnt = (float)(t + 1 < w ? t + 1 : w);
    diff[(size_t)t * MIX + c] = s / cnt - a[(size_t)t * lda + c];
}

__global__ void __launch_bounds__(256) k_rope(float* x, int ld, int nh, const int* __restrict__ pos) {
    const int idx = blockIdx.x * 256 + threadIdx.x;
    const int i = idx & 31, h = (idx >> 5) % nh, t = (idx >> 5) / nh;
    if (t >= S) return;
    const float inv_freq = 1.0f / powf(10000.0f, (float)i * (2.0f / 64.0f));
    const float ang = (float)pos[t] * inv_freq; float sn, cs; sincosf(ang, &sn, &cs);
    float* p = x + (size_t)t * ld + h * 64;
    const float x1 = p[i], x2 = p[i + 32];
    p[i] = x1 * cs - x2 * sn; p[i + 32] = x2 * cs + x1 * sn;
}

__global__ void __launch_bounds__(256) k_swa(const float* __restrict__ q, int ldq, const float* __restrict__ kv, int ldkv, const float* __restrict__ sinks, float* __restrict__ y, int ldo) {
    __shared__ float ps[4][128];
    const int wv = threadIdx.x >> 6, lane = threadIdx.x & 63;
    const int item = blockIdx.x * 4 + wv; const int t = item / NQH, hq = item % NQH, kh = hq / 8;
    const float* qp = q + (size_t)t * ldq + hq * 64;
    float sc[2];
#pragma unroll
    for (int e = 0; e < 2; ++e) {
        const int j = t - 127 + lane + 64 * e;
        float s = -INFINITY;
        if (j >= 0 && j <= t) { const float* kp = kv + (size_t)j * ldkv + kh * 64; float d = 0.f; for (int c = 0; c < 64; ++c) d += qp[c] * kp[c]; s = d * 0.125f; }
        sc[e] = s;
    }
    const float sink = sinks[hq];
    const float m = fmaxf(wave_max(fmaxf(sc[0], sc[1])), sink);
    const float p0 = expf(sc[0] - m), p1 = expf(sc[1] - m);
    const float den = wave_sum(p0 + p1) + expf(sink - m);
    ps[wv][lane] = p0 / den; ps[wv][lane + 64] = p1 / den;
    __syncthreads();
    float o = 0.f;
    for (int jj = 0; jj < 128; ++jj) { const int j = t - 127 + jj; if (j < 0) continue; o += ps[wv][jj] * kv[(size_t)j * ldkv + 192 + kh * 64 + lane]; }
    y[(size_t)t * ldo + hq * 64 + lane] = o;
}

__global__ void __launch_bounds__(256) k_memattn(const float* __restrict__ a, int ldq, const float* __restrict__ mkv, float* __restrict__ y, int ldo) {
    __shared__ float ps[4][256];
    const int wv = threadIdx.x >> 6, lane = threadIdx.x & 63;
    const int item = blockIdx.x * 4 + wv; const int t = item / MH, h = item % MH;
    const float* qp = a + (size_t)t * ldq + MIX + h * MHD;
    float sc[4]; float mx = -INFINITY;
#pragma unroll
    for (int e = 0; e < 4; ++e) { const int j = lane + 64 * e; const float* kp = mkv + (size_t)j * 1024 + h * MHD; float d = 0.f; for (int c = 0; c < MHD; ++c) d += qp[c] * kp[c];
        sc[e] = d * 0.08838834764831845f; mx = fmaxf(mx, sc[e]); }
    mx = wave_max(mx); float sum = 0.f;
#pragma unroll
    for (int e = 0; e < 4; ++e) { sc[e] = expf(sc[e] - mx); sum += sc[e]; }
    sum = wave_sum(sum);
#pragma unroll
    for (int e = 0; e < 4; ++e) ps[wv][lane + 64 * e] = sc[e] / sum;
    __syncthreads();
    float o0 = 0.f, o1 = 0.f;
    for (int j = 0; j < ML; ++j) { const float p = ps[wv][j]; const float* vp = mkv + (size_t)j * 1024 + 512 + h * MHD; o0 += p * vp[lane]; o1 += p * vp[lane + 64]; }
    float* op = y + (size_t)t * ldo + MIX + h * MHD; op[lane] = o0; op[lane + 64] = o1;
}

template <int EPI>
static void gemm(hipStream_t st, const float* A, int lda, const float* B, int ldb, float* C, int ldc, int M, int N, int K, const float* R = nullptr, float alpha = 1.f, const float* cs = nullptr) {
    hipLaunchKernelGGL(k_gemm<EPI>, dim3(N / 128, M / 128), dim3(256), 0, st, A, lda, B, ldb, C, ldc, K, R, alpha, cs);
}

struct In { const float *x, *mem; const int* pos; const float *norms, *gate, *up, *down, *w_in, *w_out, *pool_w, *pool_scale, *w_kv, *kv_norm, *sinks, *w_mem_kv, *mem_norm, *final_norm; };

static void forward(hipStream_t st, const In& in, float* out, float* ws) {
    float* H = ws; float* XN = H + (size_t)S * D; float* G = XN + (size_t)S * D; float* U = G + (size_t)S * FF; float* A = U + (size_t)S * FF; float* Y = A + (size_t)S * D;
    float* DIFF = Y + (size_t)S * D; float* KV = DIFF + (size_t)S * MIX; float* MEMN = KV + (size_t)S * 384; float* MKV = MEMN + (size_t)ML * D;
    hipLaunchKernelGGL(k_rmsnorm, dim3(ML / 4), dim3(256), 0, st, in.mem, in.mem_norm, MEMN, ML, D);
    const float* hin = in.x;
    for (int l = 0; l < DEPTH; ++l) {
        for (int half = 0; half < 2; ++half) {
            if (half == 1) {
                hipLaunchKernelGGL(k_rmsnorm, dim3(S / 4), dim3(256), 0, st, hin, in.norms + (size_t)(l * 3 + 1) * D, XN, S, D);
                gemm<0>(st, XN, D, in.w_in + (size_t)l * D * D, D, A, D, S, D, D);
                if (l < NA) {
                    hipLaunchKernelGGL(k_pool_diff, dim3(S * MIX / 256), dim3(256), 0, st, A, D, DIFF);
                    for (int g = 0; g < 4; ++g)
                        gemm<2>(st, DIFF + g * CG, MIX, in.pool_w + (size_t)(l * 4 + g) * CG * CG, CG, Y + g * CG, D, S, CG, CG, nullptr, 1.f, in.pool_scale + (size_t)l * MIX + g * CG - 0);
                } else {
                    hipLaunchKernelGGL(k_rope, dim3(S * NQH * 32 / 256), dim3(256), 0, st, A, D, NQH, in.pos);
                    hipLaunchKernelGGL(k_swa, dim3(S * NQH / 4), dim3(256), 0, st, A, D, KV, 384, in.sinks + (size_t)(l - NA) * NQH, Y, D);
                }
                gemm<0>(st, MEMN, D, in.w_mem_kv + (size_t)l * D * 1024, 1024, MKV, 1024, ML, 1024, D);
                hipLaunchKernelGGL(k_memattn, dim3(S * MH / 4), dim3(256), 0, st, A, D, MKV, Y, D);
                gemm<1>(st, Y, D, in.w_out + (size_t)l * D * D, D, H, D, S, D, D, hin, 1.0f);
                hin = H;
            }
            hipLaunchKernelGGL(k_rmsnorm, dim3(S / 4), dim3(256), 0, st, hin, in.norms + (size_t)(l * 3 + (half ? 2 : 0)) * D, XN, S, D);
            const size_t wo = (size_t)(l * 2 + half) * D * FF;
            gemm<0>(st, XN, D, in.gate + wo, FF, G, FF, S, FF, D);
            gemm<0>(st, XN, D, in.up + wo, FF, U, FF, S, FF, D);
            hipLaunchKernelGGL(k_swiglu, dim3(4096), dim3(256), 0, st, G, U, (size_t)S * FF / 4);
            gemm<1>(st, G, FF, in.down + wo, D, H, D, S, D, FF, hin, 0.5f);
            hin = H;
        }
        if (l == NA - 1) {
            hipLaunchKernelGGL(k_rmsnorm, dim3(S / 4), dim3(256), 0, st, H, in.kv_norm, XN, S, D);
            gemm<0>(st, XN, D, in.w_kv, 384, KV, 384, S, 384, D);
            hipLaunchKernelGGL(k_rope, dim3(S * NKVH * 32 / 256), dim3(256), 0, st, KV, 384, NKVH, in.pos);
        }
    }
    hipLaunchKernelGGL(k_rmsnorm, dim3(S / 4), dim3(256), 0, st, H, in.final_norm, out, S, D);
}
constexpr size_t WS_FLOATS = (size_t)S * D * 4 + (size_t)S * FF * 2 + (size_t)S * MIX + (size_t)S * 384 + (size_t)ML * D + (size_t)ML * 1024;
}
#endif
namespace cfg {
constexpr int S = 8192, D = 2048, FF = 5632, MIX = 1536, NQH = 24, ML = 256;
constexpr int NGU = 2 * FF, NGU_PAD = NGU + 512;
#ifndef PITCH_PAD
#define PITCH_PAD 0
#endif
constexpr int PD = D + PITCH_PAD, PF = FF + PITCH_PAD;
constexpr float EPS = 1e-5f, LOG2E = 1.4426950408889634f;
constexpr float QSCALE = 0.125f * LOG2E;
constexpr float QMSCALE = 0.08838834764831845f * LOG2E;
}
namespace pg8 {
#define PG8_LAS __attribute__((address_space(3)))
typedef unsigned short bf16_t;
typedef short bf16x8 __attribute__((ext_vector_type(8)));
typedef float f32x4 __attribute__((ext_vector_type(4)));
typedef unsigned u32x4 __attribute__((ext_vector_type(4)));
typedef unsigned u32x2 __attribute__((ext_vector_type(2)));
constexpr int BM = 256, BK = 64, HALF = 128, HTB = HALF * BK * 2  , STAGE_BYTES = 8 * HTB, NXCD = 8, WGM = 4;

__host__ __device__ __forceinline__ int lds_byte(int r, int c) { const int st = (r >> 4) * 2 + (c >> 5), rr = r & 15, cc = c & 31, ob = rr * 64 + cc * 2; return st * 1024 + (ob ^ (((ob >> 9) & 1) << 5)); }
__host__ __device__ __forceinline__ void stage_rc(int b, int& R, int& C) { const int st = b / 1024, sb = b % 1024, swz = sb ^ (((sb >> 9) & 1) << 5); R = (st >> 1) * 16 + swz / 64; C = (st & 1) * 32 + (swz % 64) / 2; }
__host__ __device__ __forceinline__ int perm32(int rho) { const int n = rho >> 4, i = rho & 15; return 8 * (i >> 2) + 4 * n + (i & 3); }

struct Unit { int pm, pn, ka, hf; };
struct Gemm { const bf16_t* A; const bf16_t* Bt; int lda, ldb, K; int kt0 = 0; };

struct StaticOrder {
    int nM, nN, nwg, G, c, flat, halftail, maxr, r0;
    __host__ __device__ __forceinline__ void init(int M, int N, int G_, int c_) { nM = M / BM; nN = N / BM; nwg = nM * nN; G = G_; c = c_; flat = 0; halftail = 0; maxr = 1 << 30; r0 = 0; }
    __host__ __device__ __forceinline__ bool next(int i, Unit& u) const {
        u.hf = 0;
        if (i >= maxr) return false;
        i += r0;
        long L = (long)i * G + c;
        if (halftail && (long)(i + 1) * G > nwg) { if ((long)i * G >= nwg) return false; const int hc = c % (G / 2); L = (long)i * G + hc; u.hf = 1 + (c >= G / 2); }
        if (L >= nwg) return false;
        int wgid = (int)L; { const int q = nwg / NXCD, r = nwg % NXCD, xcd = wgid % NXCD, off = wgid / NXCD; wgid = (xcd < r ? xcd * (q + 1) : r * (q + 1) + (xcd - r) * q) + off; }
        const int nig = WGM * nN, gid = wgid / nig, fm = gid * WGM, gsz = (nM - fm) < WGM ? (nM - fm) : WGM;
        u.pm = fm + ((wgid % nig) % gsz); u.pn = (wgid % nig) / gsz; u.ka = 0; if (flat) { u.pm = 0; u.pn = 0; } return true;
    }
    __device__ __forceinline__ void a_ready(const Unit&) const {}
    __device__ __forceinline__ void done(const Unit&) const {}
};
struct PoolOrder : StaticOrder {
    __host__ __device__ __forceinline__ bool next(int i, Unit& u) const { if (!StaticOrder::next(i, u)) return false; u.ka = (u.pn >> 1) * 384; return true; }
};
struct SubsetPoolOrder {
    int c0, n, nN, c;
    __host__ __device__ __forceinline__ bool next(int i, Unit& u) const { const int k = c - c0; if (i != 0 || k < 0 || k >= n) return false; u.pm = k / nN; u.pn = k % nN; u.ka = (u.pn >> 1) * 384; u.hf = 0; return true; }
    __device__ __forceinline__ void a_ready(const Unit&) const {}
    __device__ __forceinline__ void done(const Unit&) const {}
};
struct SubsetOrder {
    int c0, n, nN, c;
    __host__ __device__ __forceinline__ bool next(int i, Unit& u) const { const int k = c - c0; if (i != 0 || k < 0 || k >= n) return false; u.pm = k / nN; u.pn = k % nN; u.ka = 0; u.hf = 0; return true; }
    __device__ __forceinline__ void a_ready(const Unit&) const {}
    __device__ __forceinline__ void done(const Unit&) const {}
};

struct OneUnitOrder {
    int pm, pn;
    __host__ __device__ __forceinline__ bool next(int i, Unit& u) const { if (i != 0) return false; u.pm = pm; u.pn = pn; u.ka = 0; u.hf = 0; return true; }
    __device__ __forceinline__ void a_ready(const Unit&) const {}
    __device__ __forceinline__ void done(const Unit&) const {}
};
typedef float f32x2_t __attribute__((ext_vector_type(2))); typedef __bf16 bf16x2_t __attribute__((ext_vector_type(2)));
__device__ __forceinline__ unsigned pkbf(float lo, float hi) { f32x2_t v = {lo, hi}; bf16x2_t b = __builtin_convertvector(v, bf16x2_t); return __builtin_bit_cast(unsigned, b); }
__device__ __forceinline__ float rstd_of(const float* ssq, int row) {
    const f32x4 a = *(const f32x4*)(ssq + (size_t)row * 8), b = *(const f32x4*)(ssq + (size_t)row * 8 + 4);
    return __builtin_amdgcn_rsqf((((a[0] + a[1]) + (a[2] + a[3])) + ((b[0] + b[1]) + (b[2] + b[3]))) * (1.0f / 2048.0f) + cfg::EPS);
}
__device__ __forceinline__ void rstd8(const float* ssq, int rowbase  , int fr, int fq, float (&rs)[2][4]) {
    float loc[2];
#pragma unroll
    for (int k = 0; k < 2; ++k) loc[k] = rstd_of(ssq, rowbase + (fq >> 1) * HALF + (2 * (fq & 1) + k) * 16);
#pragma unroll
    for (int ai = 0; ai < 2; ++ai)
#pragma unroll
        for (int m = 0; m < 4; ++m) rs[ai][m] = __shfl(loc[m & 1], fr + 16 * (ai * 2 + (m >> 1)));
}
struct EpiSwiGLU {
    static constexpr bool PERM = true, AFTER_DRAIN = false;
    bf16_t* O; const float* ssq; int nostore; const PG8_LAS float* rtab = nullptr; int rtab_pm = -1;
    __device__ __forceinline__ void operator()(const f32x4 (&acc)[2][2][4][2], const Unit& u, int wr, int wc, int fr, int fq) const {
        if (nostore) return;
        const int row0 = u.pm * BM + wr * 64 + fr, col0 = u.pn * 128 + wc * 32 + 8 * fq;
        float rs8[2][4];
        if (RSTD_LDS && u.pm == rtab_pm) {
#pragma unroll
            for (int ai = 0; ai < 2; ++ai)
#pragma unroll
                for (int m = 0; m < 4; ++m) rs8[ai][m] = rtab[ai * HALF + wr * 64 + m * 16 + fr]; }
        else rstd8(ssq, row0, fr, fq, rs8);
        const __amdgpu_buffer_rsrc_t rs_o = __builtin_amdgcn_make_buffer_rsrc((void*)O, (short)0, (int)((size_t)cfg::S * cfg::PF * 2), 0x00020000);
#pragma unroll
        for (int ai = 0; ai < 2; ++ai) { if (u.hf == 2 - ai) continue;
#pragma unroll
            for (int m = 0; m < 4; ++m) { const int row = row0 + ai * HALF + m * 16; const float rs = rs8[ai][m];
                const float rsl = -cfg::LOG2E * rs, irs2 = __builtin_amdgcn_rcpf(rs * rs);
                float o[8];
#pragma unroll
                for (int n = 0; n < 2; ++n)
#pragma unroll
                    for (int e = 0; e < 4; ++e) { const float ag = acc[ai][0][m][n][e], au = acc[ai][1][m][n][e];
                        o[4 * n + e] = (ag * au) * __builtin_amdgcn_rcpf(__builtin_fmaf(__builtin_amdgcn_exp2f(ag * rsl), irs2, irs2)); }
                u32x4 w; w.x = pkbf(o[0], o[1]); w.y = pkbf(o[2], o[3]); w.z = pkbf(o[4], o[5]); w.w = pkbf(o[6], o[7]);
                if (WT_STORES) __builtin_amdgcn_raw_buffer_store_b128(w, rs_o, (int)(((size_t)row * cfg::PF + col0) * 2), 0, 16); else *(u32x4*)(O + (size_t)row * cfg::PF + col0) = w; } }
    }
};
struct EpiSwiGLUSplit {
    static constexpr bool PERM = true, AFTER_DRAIN = true;
    bf16_t* O; const float* ssq; float* slab; unsigned* ctr; unsigned* tmo; unsigned epoch; int role; int same_xcd;
    __device__ __forceinline__ void fused(f32x4 (&acc)[2][2][4][2], const Unit& u, int wr, int wc, int fr, int fq, PG8_LAS unsigned char* lds, int wid, int lane) const {
        const int tid = wid * 64 + lane;
        f32x4* sl = (f32x4*)slab + tid;
        if (role == 1) {
#pragma unroll
            for (int ai = 0; ai < 2; ++ai)
#pragma unroll
                for (int bj = 0; bj < 2; ++bj)
#pragma unroll
                    for (int m = 0; m < 4; ++m)
#pragma unroll
                        for (int n = 0; n < 2; ++n) sl[(size_t)((((ai * 2 + bj) * 4 + m) * 2 + n)) * 512] = acc[ai][bj][m][n];
            asm volatile("s_waitcnt vmcnt(0)" ::: "memory"); __builtin_amdgcn_s_barrier(); asm volatile("" ::: "memory");
            if (tid == 0) { if (!same_xcd) { __builtin_amdgcn_fence(__ATOMIC_RELEASE, "agent"); asm volatile("s_waitcnt vmcnt(0)" ::: "memory"); }
                (void)__hip_atomic_fetch_add(ctr, 1u, __ATOMIC_RELAXED, __HIP_MEMORY_SCOPE_AGENT); }
            return;
        }
        if (tid == 0) { unsigned sp = 0u;
            while (__hip_atomic_load(ctr, __ATOMIC_RELAXED, __HIP_MEMORY_SCOPE_AGENT) < epoch) { __builtin_amdgcn_s_sleep(1);
                if ((++sp & 255u) == 0u) { if (__hip_atomic_load(tmo, __ATOMIC_RELAXED, __HIP_MEMORY_SCOPE_AGENT)) break; if (sp > (1u << 18)) { atomicAdd(tmo, 1u); break; } } }
            __builtin_amdgcn_fence(__ATOMIC_ACQUIRE, "agent"); asm volatile("s_waitcnt vmcnt(0)" ::: "memory"); }
        asm volatile("s_waitcnt vmcnt(0) lgkmcnt(0)" ::: "memory"); __builtin_amdgcn_s_barrier(); asm volatile("" ::: "memory");
        const int row0 = u.pm * BM + wr * 64 + fr, col0 = u.pn * 128 + wc * 32 + 8 * fq;
        float rs8[2][4]; rstd8(ssq, row0, fr, fq, rs8);
#pragma unroll
        for (int ai = 0; ai < 2; ++ai)
#pragma unroll
            for (int m = 0; m < 4; ++m) { const int row = row0 + ai * HALF + m * 16; const float rs = rs8[ai][m];
                const float rsl = -cfg::LOG2E * rs, irs2 = __builtin_amdgcn_rcpf(rs * rs);
                f32x4 g[2], up[2];
#pragma unroll
                for (int n = 0; n < 2; ++n) { g[n] = acc[ai][0][m][n] + sl[(size_t)((((ai * 2 + 0) * 4 + m) * 2 + n)) * 512]; up[n] = acc[ai][1][m][n] + sl[(size_t)((((ai * 2 + 1) * 4 + m) * 2 + n)) * 512]; }
                float o[8];
#pragma unroll
                for (int n = 0; n < 2; ++n)
#pragma unroll
                    for (int e = 0; e < 4; ++e) o[4 * n + e] = (g[n][e] * up[n][e]) * __builtin_amdgcn_rcpf(__builtin_fmaf(__builtin_amdgcn_exp2f(g[n][e] * rsl), irs2, irs2));
                u32x4 w; w.x = pkbf(o[0], o[1]); w.y = pkbf(o[2], o[3]); w.z = pkbf(o[4], o[5]); w.w = pkbf(o[6], o[7]);
                *(u32x4*)(O + (size_t)row * cfg::PF + col0) = w; }
    }
};
struct EpiResid {
    static constexpr bool PERM = true, AFTER_DRAIN = true;
    const float* R32; bf16_t* HB; bf16_t* HL; float* ssq; float alpha; int nostore;
    __device__ __forceinline__ void fused(f32x4 (&acc)[2][2][4][2], const Unit& u, int wr, int wc, int fr, int fq, PG8_LAS unsigned char* lds, int wid, int lane) const {
        if (nostore) return;
        PG8_LAS float* P = (PG8_LAS float*)lds;
        const int col0 = u.pn * BM + wc * 32 + 8 * fq;
#if RESID_BATCH
        constexpr int NB = 16 / RESID_BATCH;
        u32x4 X[2][RESID_BATCH], Y[2][RESID_BATCH];
#define RS_OFF(it) ((size_t)(u.pm * BM + ((it) >> 3) * HALF + wr * 64 + (((it) >> 1) & 3) * 16 + fr))
#define RS_LOAD(buf, b) do { _Pragma("unroll") for (int j = 0; j < RESID_BATCH; ++j) { const int it = (b) * RESID_BATCH + j; \
            if (R32) { const float* px = R32 + RS_OFF(it) * cfg::D + col0 + (it & 1) * HALF; X[buf][j] = *(const u32x4*)px; Y[buf][j] = *(const u32x4*)(px + 4); } \
            else { const size_t o2 = RS_OFF(it) * cfg::PD + col0 + (it & 1) * HALF; X[buf][j] = *(const u32x4*)(HB + o2); Y[buf][j] = *(const u32x4*)(HL + o2); } } } while (0)
        RS_LOAD(0, 0);
        float s = 0.f;
#pragma unroll
        for (int b = 0; b < NB; ++b) {
            if (b + 1 < NB) RS_LOAD((b + 1) & 1, b + 1);
#pragma unroll
            for (int j = 0; j < RESID_BATCH; ++j) { const int it = b * RESID_BATCH + j, ai = it >> 3, m = (it >> 1) & 3, bj = it & 1; const int rl = ai * HALF + wr * 64 + m * 16 + fr;
                const size_t o2 = (size_t)(u.pm * BM + rl) * cfg::PD + col0 + bj * HALF; const u32x4 a = X[b & 1][j], bb = Y[b & 1][j]; f32x4 h0, h1;
                if (R32) { h0[0] = __uint_as_float(a.x); h0[1] = __uint_as_float(a.y); h0[2] = __uint_as_float(a.z); h0[3] = __uint_as_float(a.w);
                           h1[0] = __uint_as_float(bb.x); h1[1] = __uint_as_float(bb.y); h1[2] = __uint_as_float(bb.z); h1[3] = __uint_as_float(bb.w); }
                else { h0[0] = __uint_as_float(a.x << 16) + __uint_as_float(bb.x << 16); h0[1] = __uint_as_float(a.x & 0xffff0000u) + __uint_as_float(bb.x & 0xffff0000u);
                    h0[2] = __uint_as_float(a.y << 16) + __uint_as_float(bb.y << 16); h0[3] = __uint_as_float(a.y & 0xffff0000u) + __uint_as_float(bb.y & 0xffff0000u);
                    h1[0] = __uint_as_float(a.z << 16) + __uint_as_float(bb.z << 16); h1[1] = __uint_as_float(a.z & 0xffff0000u) + __uint_as_float(bb.z & 0xffff0000u);
                    h1[2] = __uint_as_float(a.w << 16) + __uint_as_float(bb.w << 16); h1[3] = __uint_as_float(a.w & 0xffff0000u) + __uint_as_float(bb.w & 0xffff0000u); }
                const f32x4 v0 = h0 + acc[ai][bj][m][0] * alpha, v1 = h1 + acc[ai][bj][m][1] * alpha;
                if (bj == 0) s = 0.f;
                s += ((v0[0] * v0[0] + v0[1] * v0[1]) + (v0[2] * v0[2] + v0[3] * v0[3])) + ((v1[0] * v1[0] + v1[1] * v1[1]) + (v1[2] * v1[2] + v1[3] * v1[3]));
                u32x4 w; w.x = pkbf(v0[0], v0[1]); w.y = pkbf(v0[2], v0[3]); w.z = pkbf(v1[0], v1[1]); w.w = pkbf(v1[2], v1[3]);
                u32x4 l; l.x = pkbf(v0[0] - __uint_as_float(w.x << 16), v0[1] - __uint_as_float(w.x & 0xffff0000u)); l.y = pkbf(v0[2] - __uint_as_float(w.y << 16), v0[3] - __uint_as_float(w.y & 0xffff0000u));
                l.z = pkbf(v1[0] - __uint_as_float(w.z << 16), v1[1] - __uint_as_float(w.z & 0xffff0000u)); l.w = pkbf(v1[2] - __uint_as_float(w.w << 16), v1[3] - __uint_as_float(w.w & 0xffff0000u));
                *(u32x4*)(HB + o2) = w; *(u32x4*)(HL + o2) = l;
                if (bj == 1) { float t_ = s; t_ += __shfl_xor(t_, 16); t_ += __shfl_xor(t_, 32); if (fq == 0) P[rl * 4 + wc] = t_; } }
        }
#undef RS_LOAD
#undef RS_OFF
#else
#pragma unroll
        for (int ai = 0; ai < 2; ++ai)
#pragma unroll
            for (int m = 0; m < 4; ++m) { const int rl = ai * HALF + wr * 64 + m * 16 + fr; const size_t off = (size_t)(u.pm * BM + rl) * cfg::PD + col0, offx = (size_t)(u.pm * BM + rl) * cfg::D + col0; float s = 0.f;
#pragma unroll
                for (int bj = 0; bj < 2; ++bj) { const size_t o2 = off + bj * HALF; f32x4 h0, h1;
                    if (R32) { h0 = *(const f32x4*)(R32 + offx + bj * HALF); h1 = *(const f32x4*)(R32 + offx + bj * HALF + 4); }
                    else { const u32x4 a = *(const u32x4*)(HB + o2), b = *(const u32x4*)(HL + o2);
                        h0[0] = __uint_as_float(a.x << 16) + __uint_as_float(b.x << 16); h0[1] = __uint_as_float(a.x & 0xffff0000u) + __uint_as_float(b.x & 0xffff0000u);
                        h0[2] = __uint_as_float(a.y << 16) + __uint_as_float(b.y << 16); h0[3] = __uint_as_float(a.y & 0xffff0000u) + __uint_as_float(b.y & 0xffff0000u);
                        h1[0] = __uint_as_float(a.z << 16) + __uint_as_float(b.z << 16); h1[1] = __uint_as_float(a.z & 0xffff0000u) + __uint_as_float(b.z & 0xffff0000u);
                        h1[2] = __uint_as_float(a.w << 16) + __uint_as_float(b.w << 16); h1[3] = __uint_as_float(a.w & 0xffff0000u) + __uint_as_float(b.w & 0xffff0000u); }
                    const f32x4 v0 = h0 + acc[ai][bj][m][0] * alpha, v1 = h1 + acc[ai][bj][m][1] * alpha;
                    s += ((v0[0] * v0[0] + v0[1] * v0[1]) + (v0[2] * v0[2] + v0[3] * v0[3])) + ((v1[0] * v1[0] + v1[1] * v1[1]) + (v1[2] * v1[2] + v1[3] * v1[3]));
                    u32x4 w; w.x = pkbf(v0[0], v0[1]); w.y = pkbf(v0[2], v0[3]); w.z = pkbf(v1[0], v1[1]); w.w = pkbf(v1[2], v1[3]);
                    u32x4 l; l.x = pkbf(v0[0] - __uint_as_float(w.x << 16), v0[1] - __uint_as_float(w.x & 0xffff0000u)); l.y = pkbf(v0[2] - __uint_as_float(w.y << 16), v0[3] - __uint_as_float(w.y & 0xffff0000u));
                    l.z = pkbf(v1[0] - __uint_as_float(w.z << 16), v1[1] - __uint_as_float(w.z & 0xffff0000u)); l.w = pkbf(v1[2] - __uint_as_float(w.w << 16), v1[3] - __uint_as_float(w.w & 0xffff0000u));
                    *(u32x4*)(HB + o2) = w; *(u32x4*)(HL + o2) = l; }
                s += __shfl_xor(s, 16); s += __shfl_xor(s, 32);
                if (fq == 0) P[rl * 4 + wc] = s; }
#endif
        asm volatile("s_waitcnt lgkmcnt(0)" ::: "memory"); __builtin_amdgcn_s_barrier(); asm volatile("" ::: "memory");
        const int t = wid * 64 + lane;
        if (t < 256) { const f32x4 p = *(const PG8_LAS f32x4*)(P + t * 4); ssq[(size_t)(u.pm * BM + t) * 8 + u.pn] = (p[0] + p[1]) + (p[2] + p[3]); }
    }
};
struct EpiWin {
    static constexpr bool PERM = true, AFTER_DRAIN = false;
    bf16_t* AQ; bf16_t* QMF; const float* ssq; const float* cs; const float* sn; int swa;
    __device__ __forceinline__ void operator()(const f32x4 (&acc)[2][2][4][2], const Unit& u, int wr, int wc, int fr, int fq) const {
        const int row0 = u.pm * BM + wr * 64 + fr;
        float rs8[2][4]; rstd8(ssq, row0, fr, fq, rs8);
#pragma unroll
        for (int ai = 0; ai < 2; ++ai) {
            f32x4 ropc[4], rops[4];
            if (swa && u.pn < 6) { const int dq = (((wc & 1) * 32 + 8 * fq) >> 3) * 4;
#pragma unroll
                for (int m = 0; m < 4; ++m) { const int row = row0 + ai * HALF + m * 16; ropc[m] = *(const f32x4*)(cs + (size_t)row * 32 + dq); rops[m] = *(const f32x4*)(sn + (size_t)row * 32 + dq); } }
            else {
#pragma unroll
                for (int m = 0; m < 4; ++m) { ropc[m] = (f32x4){0.f, 0.f, 0.f, 0.f}; rops[m] = ropc[m]; } }
            asm volatile("" ::: "memory");
#pragma unroll
            for (int m = 0; m < 4; ++m) { const int row = row0 + ai * HALF + m * 16; const float rs = rs8[ai][m]; const int qb = row >> 5, r32 = row & 31;
#pragma unroll
                for (int bj = 0; bj < 2; ++bj) { const int c0 = u.pn * BM + bj * HALF + wc * 32 + 8 * fq; f32x4 v0 = acc[ai][bj][m][0] * rs, v1 = acc[ai][bj][m][1] * rs;
                    if (u.pn >= 6) {
                        v0 = v0 * cfg::QMSCALE; v1 = v1 * cfg::QMSCALE; const int cm = c0 - 1536, h = cm >> 7, dm = cm & 127, j = dm >> 4, hi = (dm >> 3) & 1;
                        u32x4 w; w.x = pkbf(v0[0], v0[1]); w.y = pkbf(v0[2], v0[3]); w.z = pkbf(v1[0], v1[1]); w.w = pkbf(v1[2], v1[3]);
                        *(u32x4*)(QMF + ((size_t)(((h * 256 + qb) * 8 + j) * 64 + hi * 32 + r32)) * 8) = w; }
                    else if (!swa) { u32x4 w; w.x = pkbf(v0[0], v0[1]); w.y = pkbf(v0[2], v0[3]); w.z = pkbf(v1[0], v1[1]); w.w = pkbf(v1[2], v1[3]); *(u32x4*)(AQ + (size_t)row * cfg::PD + c0) = w; }
                    else { const int hq = c0 >> 6, jj = (c0 & 63) >> 3; const f32x4 c = ropc[m], sv = rops[m];
                        const f32x4 o1 = (v0 * c - v1 * sv) * cfg::QSCALE, o2 = (v1 * c + v0 * sv) * cfg::QSCALE;
                        u32x2 w1, w2; w1.x = pkbf(o1[0], o1[1]); w1.y = pkbf(o1[2], o1[3]); w2.x = pkbf(o2[0], o2[1]); w2.y = pkbf(o2[2], o2[3]);
                        bf16_t* qp = AQ + ((size_t)(((hq * 256 + qb) * 4 + (jj >> 2)) * 64 + ((jj >> 1) & 1) * 32 + r32)) * 8 + 4 * (jj & 1);
                        *(u32x2*)qp = w1; *(u32x2*)(qp + 2 * 512) = w2; } } } }
    }
};
struct EpiPool {
    static constexpr bool PERM = false, AFTER_DRAIN = false;
    float* Z;
    __device__ __forceinline__ void operator()(const f32x4 (&acc)[2][2][4][2], const Unit& u, int wr, int wc, int fr, int fq) const {
        const int row0 = u.pm * BM + wr * 64 + fr, g = u.pn >> 1;
#pragma unroll
        for (int ai = 0; ai < 2; ++ai)
#pragma unroll
            for (int m = 0; m < 4; ++m) { float* zp = Z + (size_t)(row0 + ai * HALF + m * 16) * cfg::MIX + g * 384;
#pragma unroll
                for (int bj = 0; bj < 2; ++bj) { if ((u.pn & 1) && bj) continue;
#pragma unroll
                    for (int n = 0; n < 2; ++n) *(f32x4*)(zp + (u.pn & 1) * 256 + bj * HALF + wc * 32 + n * 16 + 4 * fq) = acc[ai][bj][m][n]; } }
    }
};
struct EpiKV {
    static constexpr bool PERM = true, AFTER_DRAIN = false;
    bf16_t* KF; bf16_t* VF; const float* ssq; const float* cs; const float* sn;
    __device__ __forceinline__ void operator()(const f32x4 (&acc)[2][2][4][2], const Unit& u, int wr, int wc, int fr, int fq) const {
        const int row0 = u.pm * BM + wr * 64 + fr;
        float rs8[2][4]; rstd8(ssq, row0, fr, fq, rs8);
#pragma unroll
        for (int ai = 0; ai < 2; ++ai)
#pragma unroll
            for (int m = 0; m < 4; ++m) { const int row = row0 + ai * HALF + m * 16; const float rs = rs8[ai][m]; const int kt = row >> 5, r32 = row & 31;
#pragma unroll
                for (int bj = 0; bj < 2; ++bj) { const int cg = u.pn * BM + bj * HALF + wc * 32 + 8 * fq; if (cg >= 384) continue;
                    const f32x4 v0 = acc[ai][bj][m][0] * rs, v1 = acc[ai][bj][m][1] * rs;
                    if (cg < 192) { const int kvh = cg >> 6, jj = (cg & 63) >> 3, d = jj * 4; const f32x4 c = *(const f32x4*)(cs + (size_t)row * 32 + d), sv = *(const f32x4*)(sn + (size_t)row * 32 + d);
                        const f32x4 o1 = v0 * c - v1 * sv, o2 = v1 * c + v0 * sv;
                        u32x2 w1, w2; w1.x = pkbf(o1[0], o1[1]); w1.y = pkbf(o1[2], o1[3]); w2.x = pkbf(o2[0], o2[1]); w2.y = pkbf(o2[2], o2[3]);
                        bf16_t* kp = KF + ((size_t)(((kvh * 256 + kt) * 4 + (jj >> 2)) * 64 + ((jj >> 1) & 1) * 32 + r32)) * 8 + 4 * (jj & 1);
                        *(u32x2*)kp = w1; *(u32x2*)(kp + 2 * 512) = w2; }
                    else {
                        const int v = cg - 192, kvh = v >> 6, d = v & 63, k16 = r32 & 15, sk = r32 >> 4, hik = (k16 >> 2) & 1, jv = 4 * (k16 >> 3) + (k16 & 3);
                        bf16_t* vp = VF + ((size_t)((((kvh * 256 + kt) * 2 + (d >> 5)) * 2 + sk) * 64 + hik * 32 + (d & 31))) * 8 + jv;
#pragma unroll
                        for (int e = 0; e < 4; ++e) { vp[e * 8] = (bf16_t)(pkbf(v0[e], 0.f) & 0xffffu); vp[(4 + e) * 8] = (bf16_t)(pkbf(v1[e], 0.f) & 0xffffu); } } } }
    }
};
struct EpiFold {
    static constexpr bool PERM = true, AFTER_DRAIN = false;
    bf16_t* W2;
    __device__ __forceinline__ void operator()(const f32x4 (&acc)[2][2][4][2], const Unit& u, int wr, int wc, int fr, int fq) const {
        const int row0 = u.pm * BM + wr * 64 + fr, g = u.pn >> 1;
#pragma unroll
        for (int ai = 0; ai < 2; ++ai)
#pragma unroll
            for (int m = 0; m < 4; ++m) { const int row = row0 + ai * HALF + m * 16;
#pragma unroll
                for (int bj = 0; bj < 2; ++bj) { const int jp = (u.pn & 1) * BM + bj * HALF + wc * 32 + 8 * fq; if (jp >= 384) continue;
                    const f32x4 v0 = acc[ai][bj][m][0], v1 = acc[ai][bj][m][1];
                    u32x4 w; w.x = pkbf(v0[0], v0[1]); w.y = pkbf(v0[2], v0[3]); w.z = pkbf(v1[0], v1[1]); w.w = pkbf(v1[2], v1[3]);
                    *(u32x4*)(W2 + (size_t)row * cfg::PD + g * 384 + jp) = w; } }
    }
};
struct EpiMemKV {
    static constexpr bool PERM = true, AFTER_DRAIN = false;
    bf16_t* MKF; bf16_t* MVF;
    __device__ __forceinline__ void operator()(const f32x4 (&acc)[2][2][4][2], const Unit& u, int wr, int wc, int fr, int fq) const {
        const int row0 = wr * 64 + fr;
#pragma unroll
        for (int ai = 0; ai < 2; ++ai)
#pragma unroll
            for (int m = 0; m < 4; ++m) { const int row = row0 + ai * HALF + m * 16, kt = row >> 5, r32 = row & 31;
#pragma unroll
                for (int bj = 0; bj < 2; ++bj) { const int cg = u.pn * BM + bj * HALF + wc * 32 + 8 * fq, l = cg >> 10, w = cg & 1023;
                    const f32x4 v0 = acc[ai][bj][m][0], v1 = acc[ai][bj][m][1];
                    if (w < 512) { const int h = w >> 7, dm = w & 127; u32x4 q; q.x = pkbf(v0[0], v0[1]); q.y = pkbf(v0[2], v0[3]); q.z = pkbf(v1[0], v1[1]); q.w = pkbf(v1[2], v1[3]);
                        *(u32x4*)(MKF + ((size_t)(((((l * 4 + h) * 8 + kt) * 8 + (dm >> 4)) * 64) + ((dm >> 3) & 1) * 32 + r32)) * 8) = q; }
                    else { const int dv = w - 512, h = dv >> 7, d = dv & 127, k16 = r32 & 15, sk = r32 >> 4, hik = (k16 >> 2) & 1, jv = 4 * (k16 >> 3) + (k16 & 3);
                        bf16_t* vp = MVF + ((size_t)((((((l * 4 + h) * 8 + kt) * 4 + (d >> 5)) * 2 + sk) * 64) + hik * 32 + (d & 31))) * 8 + jv;
#pragma unroll
                        for (int e = 0; e < 4; ++e) { vp[e * 8] = (bf16_t)(pkbf(v0[e], 0.f) & 0xffffu); vp[(4 + e) * 8] = (bf16_t)(pkbf(v1[e], 0.f) & 0xffffu); } } } }
    }
};

template <class Epi, class Sched, bool ALIGN_EPI = false, bool SP2 = false, bool HM = false  , int DIAG = 0  >
__device__ __forceinline__ void gemm_phase(PG8_LAS unsigned char* lds, const Gemm g, const Sched& S, const Epi& E) {
    int tid_ = threadIdx.x; asm volatile("" : "+v"(tid_));
    const int tid = tid_, wid = __builtin_amdgcn_readfirstlane(tid >> 6), lane = tid & 63, wr = wid >> 2, wc = wid & 3, fr = lane & 15, fq = lane >> 4;
    int K_ = g.K; asm volatile("" : "+s"(K_));
    const int K = K_, nt = K / BK;
    int kt0_ = g.kt0; asm volatile("" : "+s"(kt0_));
    const int kt0 = kt0_;
#define PG8_KOFF(tt) ((size_t)(((tt) + kt0) >= nt ? ((tt) + kt0) - nt : ((tt) + kt0)) * kstep)
    unsigned voffA[2], voffB[2];
#pragma unroll
    for (int i = 0; i < 2; ++i) { int R, C; stage_rc(tid * 16 + i * 8192, R, C); const int Rb = Epi::PERM ? ((R & ~31) + perm32(R & 31)) : R;
        voffA[i] = (unsigned)(R * g.lda + C) * 2u; voffB[i] = (unsigned)(Rb * g.ldb + C) * 2u; }
    const size_t kstep = (size_t)(BK * 2);
    const size_t hstepA = (size_t)HALF * g.lda * 2, hstepB = (size_t)HALF * g.ldb * 2;
    const size_t tstepA = 2 * hstepA, tstepB = 2 * hstepB;
    const unsigned ldsw = (unsigned)wid * 1024u;
    const int aoff = lds_byte(wr * 64 + fr, fq * 8), boff = lds_byte(wc * 32 + fr, fq * 8);
#define PG8_SA(b, h) (((b) * 2 + (h)) * HTB)
#define PG8_SB(b, h) ((4 + (b) * 2 + (h)) * HTB)
#define PG8_STAGE(bufoff, gbase, voff) do { if (DIAG == 2) break; _Pragma("unroll") for (int _i = 0; _i < 2; ++_i) \
        __builtin_amdgcn_global_load_lds((const unsigned*)((const char*)(gbase) + (voff)[_i]), (PG8_LAS unsigned*)(lds + (bufoff) + ldsw + _i * 8192), 16, 0, ((const void*)(voff) == (const void*)voffB) ? B_NT_AUX : 0); } while (0)
#define PG8_STAGE1(bufoff, gbase, voff, _i) do { if (DIAG == 2) break; \
        __builtin_amdgcn_global_load_lds((const unsigned*)((const char*)(gbase) + (voff)[_i]), (PG8_LAS unsigned*)(lds + (bufoff) + ldsw + (_i) * 8192), 16, 0, 0); } while (0)
#define PG8_LDA(dst, b, h) do { _Pragma("unroll") for (int m = 0; m < 4; ++m) _Pragma("unroll") for (int k = 0; k < 2; ++k) dst[m][k] = *(const PG8_LAS bf16x8*)(lds + PG8_SA(b, h) + aoff + m * 2048 + k * 1024); } while (0)
#define PG8_LDB(dst, b, h) do { _Pragma("unroll") for (int n = 0; n < 2; ++n) _Pragma("unroll") for (int k = 0; k < 2; ++k) dst[n][k] = *(const PG8_LAS bf16x8*)(lds + PG8_SB(b, h) + boff + n * 2048 + k * 1024); } while (0)
#if MMA_ORDER == 1
#define PG8_MMA(ai, bj, At, Bt) do { if (DIAG == 1) break; if (MMA_SETPRIO) __builtin_amdgcn_s_setprio(MMA_PRIO); _Pragma("unroll") for (int k = 0; k < 2; ++k) _Pragma("unroll") for (int n = 0; n < 2; ++n) _Pragma("unroll") for (int m = 0; m < 4; ++m) \
        acc[ai][bj][m][n] = __builtin_amdgcn_mfma_f32_16x16x32_bf16(Bt[n][k], At[m][k], acc[ai][bj][m][n], 0, 0, 0); if (MMA_SETPRIO) __builtin_amdgcn_s_setprio(0); } while (0)
#elif MMA_ORDER == 2
#define PG8_MMA(ai, bj, At, Bt) do { if (DIAG == 1) break; if (MMA_SETPRIO) __builtin_amdgcn_s_setprio(MMA_PRIO); _Pragma("unroll") for (int k = 0; k < 2; ++k) _Pragma("unroll") for (int m = 0; m < 4; ++m) _Pragma("unroll") for (int n = 0; n < 2; ++n) \
        acc[ai][bj][m][n] = __builtin_amdgcn_mfma_f32_16x16x32_bf16(Bt[n][k], At[m][k], acc[ai][bj][m][n], 0, 0, 0); if (MMA_SETPRIO) __builtin_amdgcn_s_setprio(0); } while (0)
#else
#define PG8_MMA(ai, bj, At, Bt) do { if (DIAG == 1) break; if (MMA_SETPRIO) __builtin_amdgcn_s_setprio(MMA_PRIO); _Pragma("unroll") for (int m = 0; m < 4; ++m) _Pragma("unroll") for (int n = 0; n < 2; ++n) _Pragma("unroll") for (int k = 0; k < 2; ++k) \
        acc[ai][bj][m][n] = __builtin_amdgcn_mfma_f32_16x16x32_bf16(Bt[n][k], At[m][k], acc[ai][bj][m][n], 0, 0, 0); if (MMA_SETPRIO) __builtin_amdgcn_s_setprio(0); } while (0)
#endif
#define PG8_WAIT_V(n) asm volatile("s_waitcnt vmcnt(" #n ")" ::: "memory")
#if L2WARM
    const unsigned wlane = (unsigned)((wid & 3) * 64 + lane);
    const unsigned voffW = (wid < 4) ? wlane * (unsigned)g.lda * 2u : wlane * (unsigned)g.ldb * 2u;
#define PG8_WARM(abase, bbase) __builtin_amdgcn_global_load_lds((const unsigned*)((wid < 4 ? (const char*)(abase) : (const char*)(bbase)) + voffW), (PG8_LAS unsigned*)(lds + STAGE_BYTES + 1024), 4, 0, 0)
#define PG8_WAIT_VL() PG8_WAIT_V(9)
#else
#define PG8_WARM(abase, bbase) do {} while (0)
#define PG8_WAIT_VL() PG8_WAIT_V(8)
#endif
#define PG8_WAIT_L(n) asm volatile("s_waitcnt lgkmcnt(" #n ")" ::: "memory")
#define PG8_BAR __builtin_amdgcn_s_barrier()
#define PG8_SCHED __builtin_amdgcn_sched_barrier(0)
    Unit cur, nxt; int ui = 0;
    if (!S.next(0, cur)) return;
    f32x4 acc[2][2][4][2];
#pragma unroll
    for (int a = 0; a < 2; ++a)
#pragma unroll
        for (int b = 0; b < 2; ++b)
#pragma unroll
            for (int m = 0; m < 4; ++m)
#pragma unroll
                for (int n = 0; n < 2; ++n) acc[a][b][m][n] = (f32x4){0.f, 0.f, 0.f, 0.f};
    bf16x8 At[4][2], B0[2][2], B1[2][2];
    const char* cA = (const char*)g.A + (size_t)cur.pm * tstepA + (size_t)cur.ka * 2; const char* cB = (const char*)g.Bt + (size_t)cur.pn * tstepB;
    S.a_ready(cur);
    if constexpr (SP2) {
        PG8_STAGE(PG8_SB(0, 0), cB + PG8_KOFF(0), voffB); PG8_STAGE(PG8_SB(0, 1), cB + hstepB + PG8_KOFF(0), voffB); PG8_STAGE(PG8_SA(0, 0), cA + PG8_KOFF(0), voffA); PG8_STAGE(PG8_SA(0, 1), cA + hstepA + PG8_KOFF(0), voffA);
        if (wr == 1) PG8_BAR;
        PG8_WAIT_V(2); PG8_BAR;
#if BAL_DMA
        PG8_STAGE(PG8_SB(1, 0), cB + PG8_KOFF(1), voffB); PG8_STAGE(PG8_SB(1, 1), cB + hstepB + PG8_KOFF(1), voffB);
        PG8_WAIT_V(4); PG8_BAR;
#else
        PG8_STAGE(PG8_SB(1, 0), cB + kstep, voffB); PG8_STAGE(PG8_SA(1, 0), cA + kstep, voffA); PG8_STAGE(PG8_SB(1, 1), cB + hstepB + kstep, voffB);
        PG8_WAIT_V(6); PG8_BAR;
#endif
    } else {
        PG8_STAGE(PG8_SB(0, 0), cB, voffB); PG8_STAGE(PG8_SA(0, 0), cA, voffA); PG8_STAGE(PG8_SB(0, 1), cB + hstepB, voffB); PG8_STAGE(PG8_SA(0, 1), cA + hstepA, voffA);
        if (wr == 1) PG8_BAR;
        PG8_WAIT_V(4); PG8_BAR;
        PG8_STAGE(PG8_SB(1, 0), cB + kstep, voffB); PG8_STAGE(PG8_SA(1, 0), cA + kstep, voffA); PG8_STAGE(PG8_SB(1, 1), cB + hstepB + kstep, voffB);
        PG8_WAIT_V(6); PG8_BAR;
    }
    for (;;) {
        const bool has_next = S.next(ui + 1, nxt);
        const char* nA = has_next ? (const char*)g.A + (size_t)nxt.pm * tstepA + (size_t)nxt.ka * 2 : cA; const char* nB = has_next ? (const char*)g.Bt + (size_t)nxt.pn * tstepB : cB;
#if LOOP_ALIGN
        asm volatile(".p2align 8" ::: "memory");
#endif
        for (int t = 0; t < nt; t += 2) {
            const bool last = (t == nt - 2);
            const char* a1 = cA + PG8_KOFF(t + 1);
            const char* a2 = last ? nA + PG8_KOFF(0) : cA + PG8_KOFF(t + 2); const char* b2 = last ? nB + PG8_KOFF(0) : cB + PG8_KOFF(t + 2);
            const char* a3 = last ? nA + PG8_KOFF(1) : cA + PG8_KOFF(t + 3); const char* b3 = last ? nB + PG8_KOFF(1) : cB + PG8_KOFF(t + 3);
            if (last && has_next) S.a_ready(nxt);
            if constexpr (SP2) {
#if BAL_DMA
#if DMA_SPLIT35
            PG8_LDB(B0, 0, 0); PG8_LDB(B1, 0, 1); PG8_SCHED; PG8_LDA(At, 0, 0); PG8_STAGE(PG8_SA(1, 0), a1, voffA); PG8_STAGE1(PG8_SA(1, 1), a1 + hstepA, voffA, 0);
            PG8_WAIT_V(7); PG8_WAIT_L(0); PG8_BAR; if (!HM || cur.hf != 2) { PG8_MMA(0, 0, At, B0); PG8_MMA(0, 1, At, B1); } PG8_BAR; PG8_SCHED;
            PG8_LDA(At, 0, 1); PG8_STAGE1(PG8_SA(1, 1), a1 + hstepA, voffA, 1); PG8_STAGE(PG8_SB(0, 0), b2, voffB); PG8_STAGE(PG8_SB(0, 1), b2 + hstepB, voffB);
            PG8_WAIT_V(6); PG8_WAIT_L(0); PG8_BAR; if (!HM || cur.hf != 1) { PG8_MMA(1, 0, At, B0); PG8_MMA(1, 1, At, B1); } PG8_BAR; PG8_SCHED;
            PG8_LDB(B0, 1, 0); PG8_LDB(B1, 1, 1); PG8_SCHED; PG8_LDA(At, 1, 0); PG8_STAGE(PG8_SA(0, 0), a2, voffA); PG8_STAGE1(PG8_SA(0, 1), a2 + hstepA, voffA, 0);
            PG8_WAIT_V(7); PG8_WAIT_L(0); PG8_BAR; if (!HM || cur.hf != 2) { PG8_MMA(0, 0, At, B0); PG8_MMA(0, 1, At, B1); } PG8_BAR; PG8_SCHED;
            PG8_LDA(At, 1, 1); PG8_STAGE1(PG8_SA(0, 1), a2 + hstepA, voffA, 1); PG8_STAGE(PG8_SB(1, 0), b3, voffB); PG8_STAGE(PG8_SB(1, 1), b3 + hstepB, voffB);
            PG8_WAIT_V(6); PG8_WAIT_L(0); PG8_BAR; if (!HM || cur.hf != 1) { PG8_MMA(1, 0, At, B0); PG8_MMA(1, 1, At, B1); } PG8_BAR; PG8_SCHED;
            (void)a3;
#elif STAGE_AFTER_L
            PG8_LDB(B0, 0, 0); PG8_LDB(B1, 0, 1); PG8_SCHED; PG8_LDA(At, 0, 0); PG8_WAIT_L(0); PG8_SCHED; PG8_STAGE(PG8_SA(1, 0), a1, voffA); PG8_STAGE(PG8_SA(1, 1), a1 + hstepA, voffA);
            PG8_WAIT_V(8); PG8_BAR; if (!HM || cur.hf != 2) { PG8_MMA(0, 0, At, B0); PG8_MMA(0, 1, At, B1); } PG8_BAR; PG8_SCHED;
            PG8_LDA(At, 0, 1); PG8_WAIT_L(0); PG8_SCHED; PG8_STAGE(PG8_SB(0, 0), b2, voffB); PG8_STAGE(PG8_SB(0, 1), b2 + hstepB, voffB);
            PG8_WAIT_V(6); PG8_BAR; if (!HM || cur.hf != 1) { PG8_MMA(1, 0, At, B0); PG8_MMA(1, 1, At, B1); } PG8_BAR; PG8_SCHED;
            PG8_LDB(B0, 1, 0); PG8_LDB(B1, 1, 1); PG8_SCHED; PG8_LDA(At, 1, 0); PG8_WAIT_L(0); PG8_SCHED; PG8_STAGE(PG8_SA(0, 0), a2, voffA); PG8_STAGE(PG8_SA(0, 1), a2 + hstepA, voffA);
            PG8_WAIT_V(8); PG8_BAR; if (!HM || cur.hf != 2) { PG8_MMA(0, 0, At, B0); PG8_MMA(0, 1, At, B1); } PG8_BAR; PG8_SCHED;
            PG8_LDA(At, 1, 1); PG8_WAIT_L(0); PG8_SCHED; PG8_STAGE(PG8_SB(1, 0), b3, voffB); PG8_STAGE(PG8_SB(1, 1), b3 + hstepB, voffB);
            PG8_WAIT_V(6); PG8_BAR; if (!HM || cur.hf != 1) { PG8_MMA(1, 0, At, B0); PG8_MMA(1, 1, At, B1); } PG8_BAR; PG8_SCHED;
            (void)a3;
#elif STAGE_FIRST
            PG8_STAGE(PG8_SA(1, 0), a1, voffA); PG8_STAGE(PG8_SA(1, 1), a1 + hstepA, voffA); PG8_SCHED; PG8_LDB(B0, 0, 0); PG8_LDB(B1, 0, 1); PG8_SCHED; PG8_LDA(At, 0, 0);
            PG8_WAIT_V(8); PG8_WAIT_L(0); PG8_BAR; if (!HM || cur.hf != 2) { PG8_MMA(0, 0, At, B0); PG8_MMA(0, 1, At, B1); } PG8_BAR; PG8_SCHED;
            PG8_STAGE(PG8_SB(0, 0), b2, voffB); PG8_STAGE(PG8_SB(0, 1), b2 + hstepB, voffB); PG8_SCHED; PG8_LDA(At, 0, 1);
            PG8_WAIT_V(6); PG8_WAIT_L(0); PG8_BAR; if (!HM || cur.hf != 1) { PG8_MMA(1, 0, At, B0); PG8_MMA(1, 1, At, B1); } PG8_BAR; PG8_SCHED;
            PG8_STAGE(PG8_SA(0, 0), a2, voffA); PG8_STAGE(PG8_SA(0, 1), a2 + hstepA, voffA); PG8_SCHED; PG8_LDB(B0, 1, 0); PG8_LDB(B1, 1, 1); PG8_SCHED; PG8_LDA(At, 1, 0);
            PG8_WAIT_V(8); PG8_WAIT_L(0); PG8_BAR; if (!HM || cur.hf != 2) { PG8_MMA(0, 0, At, B0); PG8_MMA(0, 1, At, B1); } PG8_BAR; PG8_SCHED;
            PG8_STAGE(PG8_SB(1, 0), b3, voffB); PG8_STAGE(PG8_SB(1, 1), b3 + hstepB, voffB); PG8_SCHED; PG8_LDA(At, 1, 1);
            PG8_WAIT_V(6); PG8_WAIT_L(0); PG8_BAR; if (!HM || cur.hf != 1) { PG8_MMA(1, 0, At, B0); PG8_MMA(1, 1, At, B1); } PG8_BAR; PG8_SCHED;
            (void)a3;
#else
            PG8_LDB(B0, 0, 0); PG8_LDB(B1, 0, 1); PG8_SCHED; PG8_LDA(At, 0, 0); PG8_STAGE(PG8_SA(1, 0), a1, voffA); PG8_STAGE(PG8_SA(1, 1), a1 + hstepA, voffA);
            PG8_WAIT_V(8); PG8_WAIT_L(0); PG8_BAR; if (!HM || cur.hf != 2) { PG8_MMA(0, 0, At, B0); PG8_MMA(0, 1, At, B1); } PG8_BAR; PG8_SCHED;
            PG8_LDA(At, 0, 1); PG8_STAGE(PG8_SB(0, 0), b2, voffB); PG8_STAGE(PG8_SB(0, 1), b2 + hstepB, voffB);
            PG8_WAIT_V(6); PG8_WAIT_L(0); PG8_BAR; if (!HM || cur.hf != 1) { PG8_MMA(1, 0, At, B0); PG8_MMA(1, 1, At, B1); } PG8_BAR; PG8_SCHED;
            PG8_LDB(B0, 1, 0); PG8_LDB(B1, 1, 1); PG8_SCHED; PG8_LDA(At, 1, 0); PG8_STAGE(PG8_SA(0, 0), a2, voffA); PG8_STAGE(PG8_SA(0, 1), a2 + hstepA, voffA);
            PG8_WAIT_V(8); PG8_WAIT_L(0); PG8_BAR; if (!HM || cur.hf != 2) { PG8_MMA(0, 0, At, B0); PG8_MMA(0, 1, At, B1); } PG8_BAR; PG8_SCHED;
            PG8_LDA(At, 1, 1); PG8_STAGE(PG8_SB(1, 0), b3, voffB); PG8_STAGE(PG8_SB(1, 1), b3 + hstepB, voffB);
            PG8_WAIT_V(6); PG8_WAIT_L(0); PG8_BAR; if (!HM || cur.hf != 1) { PG8_MMA(1, 0, At, B0); PG8_MMA(1, 1, At, B1); } PG8_BAR; PG8_SCHED;
            (void)a3;
#endif
#else
            PG8_LDB(B0, 0, 0); PG8_LDB(B1, 0, 1); PG8_SCHED; PG8_LDA(At, 0, 0); PG8_STAGE(PG8_SA(1, 1), a1 + hstepA, voffA);
            PG8_WAIT_VL(); PG8_WAIT_L(0); PG8_BAR; if (!HM || cur.hf != 2) { PG8_MMA(0, 0, At, B0); PG8_MMA(0, 1, At, B1); } PG8_BAR; PG8_SCHED;
            PG8_LDA(At, 0, 1); PG8_STAGE(PG8_SB(0, 0), b2, voffB); PG8_STAGE(PG8_SB(0, 1), b2 + hstepB, voffB); PG8_STAGE(PG8_SA(0, 0), a2, voffA); PG8_WARM(a2 + 2 * kstep, b2 + 2 * kstep);
            PG8_WAIT_VL(); PG8_WAIT_L(0); PG8_BAR; if (!HM || cur.hf != 1) { PG8_MMA(1, 0, At, B0); PG8_MMA(1, 1, At, B1); } PG8_BAR; PG8_SCHED;
            PG8_LDB(B0, 1, 0); PG8_LDB(B1, 1, 1); PG8_SCHED; PG8_LDA(At, 1, 0); PG8_STAGE(PG8_SA(0, 1), a2 + hstepA, voffA);
            PG8_WAIT_VL(); PG8_WAIT_L(0); PG8_BAR; if (!HM || cur.hf != 2) { PG8_MMA(0, 0, At, B0); PG8_MMA(0, 1, At, B1); } PG8_BAR; PG8_SCHED;
            PG8_LDA(At, 1, 1); PG8_STAGE(PG8_SB(1, 0), b3, voffB); PG8_STAGE(PG8_SB(1, 1), b3 + hstepB, voffB); PG8_STAGE(PG8_SA(1, 0), a3, voffA); PG8_WARM(a3 + 2 * kstep, b3 + 2 * kstep);
            PG8_WAIT_VL(); PG8_WAIT_L(0); PG8_BAR; if (!HM || cur.hf != 1) { PG8_MMA(1, 0, At, B0); PG8_MMA(1, 1, At, B1); } PG8_BAR; PG8_SCHED;
#endif
            } else {
            PG8_LDB(B0, 0, 0); PG8_SCHED; PG8_LDA(At, 0, 0); PG8_STAGE(PG8_SA(1, 1), a1 + hstepA, voffA);
            PG8_WAIT_L(8); PG8_BAR; PG8_WAIT_L(0); PG8_MMA(0, 0, At, B0); PG8_BAR; PG8_SCHED;
            PG8_LDB(B1, 0, 1); PG8_STAGE(PG8_SB(0, 0), b2, voffB);
            PG8_BAR; PG8_WAIT_L(0); PG8_MMA(0, 1, At, B1); PG8_BAR;
            PG8_LDA(At, 0, 1); PG8_STAGE(PG8_SA(0, 0), a2, voffA);
            PG8_BAR; PG8_WAIT_L(0); PG8_MMA(1, 0, At, B0); PG8_BAR; PG8_SCHED;
            PG8_STAGE(PG8_SB(0, 1), b2 + hstepB, voffB);
            PG8_WAIT_V(6); PG8_BAR; PG8_MMA(1, 1, At, B1); PG8_BAR;
            PG8_LDB(B0, 1, 0); PG8_SCHED; PG8_LDA(At, 1, 0); PG8_STAGE(PG8_SA(0, 1), a2 + hstepA, voffA);
            PG8_WAIT_L(8); PG8_BAR; PG8_WAIT_L(0); PG8_MMA(0, 0, At, B0); PG8_BAR; PG8_SCHED;
            PG8_LDB(B1, 1, 1); PG8_STAGE(PG8_SB(1, 0), b3, voffB);
            PG8_BAR; PG8_WAIT_L(0); PG8_MMA(0, 1, At, B1); PG8_BAR;
            PG8_LDA(At, 1, 1); PG8_STAGE(PG8_SA(1, 0), a3, voffA);
            PG8_BAR; PG8_WAIT_L(0); PG8_MMA(1, 0, At, B0); PG8_BAR; PG8_SCHED;
            PG8_STAGE(PG8_SB(1, 1), b3 + hstepB, voffB);
            PG8_WAIT_V(6); PG8_BAR; PG8_MMA(1, 1, At, B1); PG8_BAR;
            }
        }
        if constexpr (ALIGN_EPI) { if (wr == 0) PG8_BAR; }
        if constexpr (!Epi::AFTER_DRAIN) { E(acc, cur, wr, wc, fr, fq); S.done(cur); }
        if (!has_next) break;
#pragma unroll
        for (int a = 0; a < 2; ++a)
#pragma unroll
            for (int b = 0; b < 2; ++b)
#pragma unroll
                for (int m = 0; m < 4; ++m)
#pragma unroll
                    for (int n = 0; n < 2; ++n) acc[a][b][m][n] = (f32x4){0.f, 0.f, 0.f, 0.f};
        cur = nxt; cA = nA; cB = nB; ++ui;
        if constexpr (ALIGN_EPI) { if (wr == 1) PG8_BAR; }
    }
    PG8_WAIT_V(0);
    if constexpr (!ALIGN_EPI) { if (wr == 0) PG8_BAR; }
    PG8_BAR;
    if constexpr (Epi::AFTER_DRAIN) { E.fused(acc, cur, wr, wc, fr, fq, lds, wid, lane); S.done(cur); }
#undef PG8_SA
#undef PG8_SB
#undef PG8_STAGE
#undef PG8_LDA
#undef PG8_LDB
#undef PG8_MMA
#undef PG8_WAIT_V
#undef PG8_KOFF
#undef PG8_WARM
#undef PG8_WAIT_VL
#undef PG8_WAIT_L
#undef PG8_BAR
#undef PG8_SCHED
}
}
constexpr size_t MiB = 1u << 20;
constexpr size_t WS_CTL = 0, CTL_ZERO_BYTES = (DBG || PROBE) ? 1 * MiB : 128 * 1024;
constexpr size_t WS_SSQ = 1 * MiB;
constexpr size_t WS_ROPE_C = 2 * MiB, WS_ROPE_S = 3 * MiB;
constexpr size_t WS_MEMN = 16 * MiB;
constexpr size_t WS_MK = 5 * MiB, WS_MVT = 6 * MiB;
constexpr size_t WS_KB = 7 * MiB, WS_VT = 10 * MiB;
constexpr size_t WS_WPOOL = 13 * MiB;
constexpr size_t WS_WMKV = 17 * MiB + (size_t)256 * PITCH_PAD * 2, WMKV_BYTES = (size_t)4096 * cfg::PD * 2;
constexpr size_t WS_WIN = WS_WMKV + WMKV_BYTES, WIO_BYTES = (size_t)cfg::D * cfg::PD * 2;
constexpr size_t WS_WOUT = WS_WIN + 4 * WIO_BYTES;
constexpr size_t WS_WD = WS_WOUT + 4 * WIO_BYTES, WD_BYTES = (size_t)cfg::D * cfg::PF * 2;
constexpr size_t WS_WGU = WS_WD + 8 * WD_BYTES, WGU_BYTES = (size_t)cfg::NGU_PAD * cfg::PD * 2;
constexpr size_t ACT_BYTES = (size_t)cfg::S * cfg::PD * 2;
constexpr size_t WS_HB = WS_WGU + 8 * WGU_BYTES;
constexpr size_t WS_HL = WS_HB + ACT_BYTES;
constexpr size_t WS_AQ = WS_HL + ACT_BYTES;
constexpr size_t WS_Y = WS_AQ + ACT_BYTES;
constexpr size_t WS_HFF = WS_Y + ACT_BYTES;
constexpr size_t WS_Z = ((WS_HFF + (size_t)cfg::S * cfg::PF * 2 + MiB - 1) / MiB) * MiB;
constexpr size_t WS_WOUT2 = WS_Z, WS_WPS = WS_Z + 40 * MiB;
constexpr size_t WS_QMF = WS_Z + 48 * MiB;
constexpr size_t WS_SPL = DBG ? WS_Z : WS_QMF + 8 * MiB;
constexpr size_t WS_END = WS_QMF + 8 * MiB + (DBG ? 0 : 32 * MiB);
constexpr int CW_SPL = 20480;
static_assert(WS_WPOOL + 3 * MiB <= WS_MEMN && WS_MEMN + (size_t)256 * cfg::PD * 2 <= WS_WMKV && WS_QMF + 8 * MiB <= WS_END && (WS_WIN % 256) == 0 && (WS_WD % 256) == 0 && (WS_WGU % 256) == 0 && (WS_HB % 256) == 0 && (WS_HFF % 256) == 0, "d_ws map");
constexpr int CW_BAR = 4096;
constexpr int RING_OFF = 0, RING_BYTES = 131072;
constexpr int LDSCTL_OFF = RING_BYTES, MISC_OFF = LDSCTL_OFF + 320;
constexpr int RSTD_TAB_OFF = RING_BYTES + 8192;
constexpr int LDS_BYTES = 147456;
constexpr int NWAVES = 8;

#define GAS __attribute__((address_space(1)))
#define LAS __attribute__((address_space(3)))
typedef unsigned short bf16;
typedef unsigned v4u __attribute__((ext_vector_type(4)));
typedef unsigned v2u __attribute__((ext_vector_type(2)));
typedef float f32x4 __attribute__((ext_vector_type(4)));
typedef float f32x16 __attribute__((ext_vector_type(16)));
typedef short bf16x8 __attribute__((ext_vector_type(8)));
typedef short s16x4 __attribute__((ext_vector_type(4)));
#define LDS_WAIT() asm volatile("s_waitcnt lgkmcnt(0)" ::: "memory")
#define VM_WAIT() asm volatile("s_waitcnt vmcnt(0)" ::: "memory")
using pg8::pkbf;

#define XB_TMO      128
#define XB_XCNT(j)  (256  + 64 * (j))
#define XB_XSUB(j)  (1280 + 64 * (j))
#define XB_XGEN(j)  (2304 + 64 * (j))
#define XB_TOP      3328
#define XB_TOPGEN   3392
#define XCD_BAR_WORDS 3456
#define XB_SPIN_CAP (1u << 18)

__device__ __forceinline__ unsigned xb_ld(unsigned* p)              { return __hip_atomic_load(p, __ATOMIC_RELAXED, __HIP_MEMORY_SCOPE_AGENT); }
__device__ __forceinline__ unsigned xb_add(unsigned* p, unsigned v) { return __hip_atomic_fetch_add(p, v, __ATOMIC_RELAXED, __HIP_MEMORY_SCOPE_AGENT); }
__device__ __forceinline__ unsigned xb_xcc_id() { return (unsigned)__builtin_amdgcn_s_getreg((3 << 11) | 20) & 0xFu; }
#define XB_SPIN(cond, bar) do { unsigned _sp = 0; while (cond) { __builtin_amdgcn_s_sleep(1); \
    if ((++_sp & 255u) == 0u) { if (xb_ld(&(bar)[XB_TMO])) break; if (_sp > XB_SPIN_CAP) { atomicAdd(&(bar)[XB_TMO], 1u); break; } } } } while (0)

struct XcdBarrier {
    unsigned* bar; unsigned x;
    volatile LAS unsigned* st;
};

__device__ __forceinline__ XcdBarrier xcd_barrier_post(unsigned* bar, volatile LAS unsigned* st) {
    XcdBarrier b; b.bar = bar; b.x = xb_xcc_id(); b.st = st;
    if (threadIdx.x == 0) (void)xb_add(&bar[XB_XCNT(b.x)], 1u);
    return b;
}
__device__ __forceinline__ void xcd_barrier_complete(unsigned* bar, unsigned x, unsigned& nloc, unsigned& nx) {
    const unsigned G = gridDim.x * gridDim.y * gridDim.z;
    unsigned sum, cnt, mine, sp = 0u;
    for (;;) {
        sum = 0u; cnt = 0u; mine = 0u;
#pragma unroll
        for (unsigned j = 0; j < 16; ++j) { const unsigned c = xb_ld(&bar[XB_XCNT(j)]); sum += c; cnt += (c > 0u) ? 1u : 0u; mine = (j == x) ? c : mine; }
        if (sum == G) break;
        __builtin_amdgcn_s_sleep(1);
        if ((++sp & 255u) == 0u) { if (xb_ld(&bar[XB_TMO])) break; if (sp > XB_SPIN_CAP) { atomicAdd(&bar[XB_TMO], 1u); break; } }
    }
    nloc = mine > 0u ? mine : 1u; nx = cnt > 0u ? cnt : 1u;
}

__device__ __forceinline__ void xcd_barrier(const XcdBarrier& b) {
    asm volatile("s_waitcnt vmcnt(0)" ::: "memory");
    __syncthreads();
    if (threadIdx.x == 0) {
        unsigned* bar = b.bar;
        __builtin_amdgcn_s_waitcnt(0);
        unsigned nloc = b.st[0], nx = b.st[1];
        if (nloc == 0u) { xcd_barrier_complete(bar, b.x, nloc, nx); b.st[0] = nloc; b.st[1] = nx; }
        const unsigned old = xb_add(&bar[XB_XSUB(b.x)], 1u);
        const unsigned gen = old / nloc;
        if (old + 1u == (gen + 1u) * nloc) {
            __builtin_amdgcn_fence(__ATOMIC_RELEASE, "agent");
            asm volatile("s_waitcnt vmcnt(0)" ::: "memory");
            const unsigned og = xb_add(&bar[XB_TOP], 1u);
            const unsigned tg = og / nx;
            if (og + 1u == (tg + 1u) * nx) xb_add(&bar[XB_TOPGEN], 1u);
            else XB_SPIN(xb_ld(&bar[XB_TOPGEN]) == tg, bar);
            __builtin_amdgcn_fence(__ATOMIC_ACQUIRE, "agent");
            xb_add(&bar[XB_XGEN(b.x)], 1u);
            asm volatile("s_waitcnt vmcnt(0)" ::: "memory");
        } else {
#if EARLY_WB
            if (old == gen * nloc || old == gen * nloc + nloc / 2) { __builtin_amdgcn_fence(__ATOMIC_RELEASE, "agent"); asm volatile("s_waitcnt vmcnt(0)" ::: "memory"); }
#endif
            XB_SPIN(xb_ld(&bar[XB_XGEN(b.x)]) == gen, bar);
            __builtin_amdgcn_fence(__ATOMIC_ACQUIRE, "agent");
            asm volatile("s_waitcnt vmcnt(0)" ::: "memory");
        }
    }
    __syncthreads();
}

constexpr int CW_GRP = 12288, CW_GRPX = 16384;
__device__ __forceinline__ void grp_barrier(unsigned* ctl, int pm, unsigned target, bool same_xcd) {
    asm volatile("s_waitcnt vmcnt(0)" ::: "memory");
    __syncthreads();
    if (threadIdx.x == 0) {
        unsigned* ctr = ctl + CW_GRP + 64 * pm; unsigned* tmo = ctl + CW_BAR + XB_TMO;
        if (!same_xcd) __builtin_amdgcn_fence(__ATOMIC_RELEASE, "agent");
        asm volatile("s_waitcnt vmcnt(0)" ::: "memory");
        (void)xb_add(ctr, 1u);
#if EARLY_ACQ
        __builtin_amdgcn_fence(__ATOMIC_ACQUIRE, "agent");
#endif
        unsigned sp = 0u;
        while (xb_ld(ctr) < target) { __builtin_amdgcn_s_sleep(1); if ((++sp & 255u) == 0u) { if (xb_ld(tmo)) break; if (sp > XB_SPIN_CAP) { atomicAdd(tmo, 1u); break; } } }
#if !EARLY_ACQ
        __builtin_amdgcn_fence(__ATOMIC_ACQUIRE, "agent");
#endif
        asm volatile("s_waitcnt vmcnt(0)" ::: "memory");
    }
    __syncthreads();
}

struct Frame {
    LAS unsigned char* lds;
    volatile LAS unsigned* MISC;
    int tid, lane, wave, vcu, G;
    const float *x, *mem; const int* pos; const float *norms, *gate, *up, *down, *w_in, *w_out, *pool_w, *pool_scale, *w_kv, *kv_norm, *sinks, *w_mem_kv, *mem_norm, *final_norm;
    float* out; unsigned char* ws;
};
__device__ __forceinline__ float wave_sum(float v) {
#pragma unroll
    for (int o = 1; o < 64; o <<= 1) v += __shfl_xor(v, o);
    return v;
}
__device__ __forceinline__ int rope_slot(int d) { return 8 * ((d & 31) >> 2) + 4 * (d >> 5) + (d & 3); }
__device__ __forceinline__ int map_row(int map, int n) {
    if (map == 1) return (n >> 7) * 256 + (n & 127);
    if (map == 2) return (n >> 7) * 256 + 128 + (n & 127);
    if (map == 3) return n < 1536 ? (n & ~63) + rope_slot(n & 63) : n;
    if (map == 4) return n < 192 ? (n & ~63) + rope_slot(n & 63) : n;
    return n;
}
__device__ __forceinline__ void conv_item(const float* W, int N, int k0, int n0, const float* gain, bf16* dst, int dst_ld, int map, int row_off, LAS float* scr, int lane) {
    f32x4 v8[8];
    const int c = lane & 7;
    f32x4 g0 = (f32x4){1.f, 1.f, 1.f, 1.f}, g1 = g0;
    if (gain) { g0 = *(const f32x4*)(gain + k0 + 8 * c); g1 = *(const f32x4*)(gain + k0 + 8 * c + 4); }
#pragma unroll
    for (int i = 0; i < 8; ++i) { const int kr = (lane >> 3) + 8 * i; v8[i] = __builtin_nontemporal_load((const f32x4*)(W + (size_t)(k0 + kr) * N + n0 + (lane & 7) * 4)); }
    asm volatile("" ::: "memory");
#pragma unroll
    for (int i = 0; i < 8; ++i) { const int kr = (lane >> 3) + 8 * i; const f32x4 v = v8[i];
        LAS float* s = scr + kr * 33 + (lane & 7) * 4; s[0] = v[0]; s[1] = v[1]; s[2] = v[2]; s[3] = v[3]; }
    LDS_WAIT(); asm volatile("" ::: "memory");
#pragma unroll
    for (int j = 0; j < 4; ++j) { const int n = (lane >> 3) + 8 * j; const LAS float* s = scr + (8 * c) * 33 + n;
        v4u o; o.x = pkbf(s[0 * 33] * g0[0], s[1 * 33] * g0[1]); o.y = pkbf(s[2 * 33] * g0[2], s[3 * 33] * g0[3]); o.z = pkbf(s[4 * 33] * g1[0], s[5 * 33] * g1[1]); o.w = pkbf(s[6 * 33] * g1[2], s[7 * 33] * g1[3]);
        if (CONV_NT) __builtin_nontemporal_store(o, (v4u*)(dst + (size_t)(map_row(map, n0 + n) + row_off) * dst_ld + k0 + 8 * c)); else *(v4u*)(dst + (size_t)(map_row(map, n0 + n) + row_off) * dst_ld + k0 + 8 * c) = o; }
    LDS_WAIT(); asm volatile("" ::: "memory");
}
#ifndef CV_TAIL
#define CV_TAIL 0
#endif
#ifndef IO_IN_PRO
#define IO_IN_PRO 1
#endif
constexpr int CV_FFN1 = 3 * 5632, CV_IO1 = 2 * 2048, CV_NIO = IO_IN_PRO ? 4 : 1, CV_MISC = 4 * 1024 + 8 * 72 + 384, CV_REST = CV_FFN1 - CV_TAIL, CV_PRO = CV_FFN1 + 7 * CV_REST + CV_NIO * CV_IO1 + CV_MISC;
__device__ __forceinline__ void conv_ffn(Frame& F, int i8, int r3, LAS float* scr, int lane) {
    using namespace cfg;
    const int kind = r3 / 5632, r = r3 % 5632, l = i8 >> 1, half = i8 & 1;
    if (kind < 2) conv_item((kind ? F.up : F.gate) + (size_t)i8 * D * FF, FF, 64 * (r / 176), 32 * (r % 176), F.norms + (size_t)(l * 3 + (half ? 2 : 0)) * D, (bf16*)(F.ws + WS_WGU + (size_t)i8 * WGU_BYTES), PD, 1 + kind, 0, scr, lane);
    else conv_item(F.down + (size_t)i8 * FF * D, D, 64 * (r / 64), 32 * (r % 64), nullptr, (bf16*)(F.ws + WS_WD + (size_t)i8 * WD_BYTES), PF, 0, 0, scr, lane);
}
__device__ __forceinline__ void conv_io(Frame& F, int l, int r2, LAS float* scr, int lane) {
    using namespace cfg;
    const int r = r2 & 2047;
    if (r2 < 2048) conv_item(F.w_in + (size_t)l * D * D, D, 64 * (r / 64), 32 * (r % 64), F.norms + (size_t)(l * 3 + 1) * D, (bf16*)(F.ws + WS_WIN + (size_t)l * WIO_BYTES), PD, l >= 2 ? 3 : 0, 0, scr, lane);
    else conv_item(F.w_out + (size_t)l * D * D, D, 64 * (r / 64), 32 * (r % 64), nullptr, (bf16*)(F.ws + ((POOL_FOLD && l < 2 && r / 64 >= 24) ? WS_WOUT2 : WS_WOUT) + (size_t)l * WIO_BYTES), PD, 0, 0, scr, lane);
}
__device__ __forceinline__ void conv_misc(Frame& F, int it, LAS float* scr, int lane) {
    using namespace cfg;
    if (it < 4096) { const int l = it / 1024, r = it % 1024;
        conv_item(F.w_mem_kv + (size_t)l * D * 1024, 1024, 64 * (r / 32), 32 * (r % 32), nullptr, (bf16*)(F.ws + WS_WMKV), PD, 0, l * 1024, scr, lane); return; }
    it -= 4096;
    if (it < 576) { const int pg = it / 72, r = it % 72, l = pg >> 2, g = pg & 3;
        conv_item(F.pool_w + (size_t)pg * 384 * 384, 384, 64 * (r / 12), 32 * (r % 12), nullptr, (bf16*)(F.ws + WS_WPOOL) + (size_t)l * 2048 * 384, 384, 0, g * 512, scr, lane); return; }
    it -= 576;
    conv_item(F.w_kv, 384, 64 * (it / 12), 32 * (it % 12), F.kv_norm, (bf16*)(F.ws + WS_WGU + 4 * WGU_BYTES), PD, 4, NGU, scr, lane);
}
constexpr int CW_CONV = 8192;
__device__ __forceinline__ void conv_tail(Frame& F, int i) {
    if (i >= 7) return;
    int lane = threadIdx.x; asm volatile("" : "+v"(lane)); lane &= 63;
    LAS float* scr = (LAS float*)(F.lds + RING_OFF + F.wave * 16384);
    unsigned* head = (unsigned*)(F.ws + WS_CTL) + CW_CONV + 64 * i;
    const int nitems = CV_TAIL + (((i & 1) && !IO_IN_PRO) ? CV_IO1 : 0), nch = nitems / 8;
    if (nitems == 0) return;
    for (;;) {
        unsigned ch = 0u;
        if (lane == 0) ch = __hip_atomic_fetch_add(head, 1u, __ATOMIC_RELAXED, __HIP_MEMORY_SCOPE_AGENT);
        ch = (unsigned)__builtin_amdgcn_readfirstlane((int)ch);
        if ((int)ch >= nch) break;
        for (int k = 0; k < 8; ++k) { const int it = (int)ch * 8 + k; if (it < CV_TAIL) conv_ffn(F, i + 1, it, scr, lane); else conv_io(F, (i + 1) >> 1, it - CV_TAIL, scr, lane); }
    }
}
__device__ __forceinline__ void p0_prologue(Frame& F) {
    using namespace cfg;
    LAS float* scr = (LAS float*)(F.lds + RING_OFF + F.wave * 16384);
    const int gw = F.vcu * NWAVES + F.wave, NGW = F.G * NWAVES;
    for (int it = gw; it < CV_PRO; it += NGW) { int r = CONV_REVERSE ? CV_PRO - 1 - it : it;
        if (r < CV_FFN1) { conv_ffn(F, 0, r, scr, F.lane); continue; } r -= CV_FFN1;
        if (r < 7 * CV_REST) { conv_ffn(F, 1 + r / CV_REST, CV_TAIL + r % CV_REST, scr, F.lane); continue; } r -= 7 * CV_REST;
        if (r < CV_NIO * CV_IO1) { conv_io(F, r / CV_IO1, r % CV_IO1, scr, F.lane); continue; } r -= CV_NIO * CV_IO1;
        conv_misc(F, r, scr, F.lane); }
    bf16* HB = (bf16*)(F.ws + WS_HB); float* ssq = (float*)(F.ws + WS_SSQ);
    { f32x4 xv[8], xn[8];
      if (gw < S) { const f32x4* xr = (const f32x4*)(F.x + (size_t)gw * D) + F.lane;
#pragma unroll
          for (int j = 0; j < 8; ++j) xv[j] = xr[64 * j]; }
      for (int m = gw; m < S; m += NGW) { const int mn = m + NGW < S ? m + NGW : m; const f32x4* xr = (const f32x4*)(F.x + (size_t)mn * D) + F.lane;
#pragma unroll
          for (int j = 0; j < 8; ++j) xn[j] = xr[64 * j];
          asm volatile("" ::: "memory");
          float s = 0.f; v2u* o8 = (v2u*)(HB + (size_t)m * PD) + F.lane;
#pragma unroll
          for (int j = 0; j < 8; ++j) { const f32x4 v = xv[j]; s += (v[0] * v[0] + v[1] * v[1]) + (v[2] * v[2] + v[3] * v[3]); v2u w; w.x = pkbf(v[0], v[1]); w.y = pkbf(v[2], v[3]); o8[64 * j] = w; }
          s = wave_sum(s);
          if (F.lane < 8) ssq[(size_t)m * 8 + F.lane] = F.lane == 0 ? s : 0.f;
#pragma unroll
          for (int j = 0; j < 8; ++j) xv[j] = xn[j]; } }
    bf16* MEMN = (bf16*)(F.ws + WS_MEMN);
    for (int m = gw; m < ML; m += NGW) { const f32x4* xr = (const f32x4*)(F.mem + (size_t)m * D) + F.lane; const f32x4* gr = (const f32x4*)F.mem_norm + F.lane; float s = 0.f; f32x4 v[8];
#pragma unroll
        for (int j = 0; j < 8; ++j) { v[j] = xr[64 * j]; s += (v[j][0] * v[j][0] + v[j][1] * v[j][1]) + (v[j][2] * v[j][2] + v[j][3] * v[j][3]); }
        const float rs = __builtin_amdgcn_rsqf(wave_sum(s) * (1.0f / D) + EPS); v2u* o8 = (v2u*)(MEMN + (size_t)m * PD) + F.lane;
#pragma unroll
        for (int j = 0; j < 8; ++j) { const f32x4 g = gr[64 * j]; v2u w; w.x = pkbf(v[j][0] * rs * g[0], v[j][1] * rs * g[1]); w.y = pkbf(v[j][2] * rs * g[2], v[j][3] * rs * g[3]); o8[64 * j] = w; } }
#if POOL_FOLD
    for (int idx = gw * 64 + F.lane; idx < 8 * 384 * 96; idx += NGW * 64) { const int pg = idx / (384 * 96), rem = idx % (384 * 96), j = rem / 96, m4 = (rem % 96) * 4, l = pg >> 2, g = pg & 3;
        const f32x4 p = *(const f32x4*)(F.pool_w + ((size_t)pg * 384 + j) * 384 + m4), sc = *(const f32x4*)(F.pool_scale + (size_t)l * MIX + g * 384 + m4);
        v2u w; w.x = pkbf(p[0] * sc[0], p[1] * sc[1]); w.y = pkbf(p[2] * sc[2], p[3] * sc[3]);
        *(v2u*)((bf16*)(F.ws + WS_WPS) + ((size_t)l * 2048 + g * 512 + j) * 384 + m4) = w; }
#endif
    float* rc = (float*)(F.ws + WS_ROPE_C); float* rsn = (float*)(F.ws + WS_ROPE_S);
    for (int idx = gw * 64 + F.lane; idx < S * 32; idx += NGW * 64) { const int t = idx >> 5, i = idx & 31;
        const float inv_freq = 1.0f / powf(10000.0f, (float)i * (2.0f / 64.0f)); const float ang = (float)F.pos[t] * inv_freq; float sn, cs; sincosf(ang, &sn, &cs); rc[idx] = cs; rsn[idx] = sn; }
}
#define MFMA32(a, b, c) __builtin_amdgcn_mfma_f32_32x32x16_bf16((a), (b), (c), 0, 0, 0)
__device__ __forceinline__ bf16x8 cat8(s16x4 a, s16x4 b) { return __builtin_shufflevector(a, b, 0, 1, 2, 3, 4, 5, 6, 7); }
template <int ND> __device__ __forceinline__ void softmax_tile(f32x16& p, float& m, float& lsum, f32x16 (&o)[ND], bf16x8 (&pb)[2]) {
    float tm = p[0];
#pragma unroll
    for (int r = 1; r < 16; ++r) tm = fmaxf(tm, p[r]);
    tm = fmaxf(tm, __shfl_xor(tm, 32));
    const float mn = fmaxf(m, tm), f = __builtin_amdgcn_exp2f(m - mn); m = mn;
    float ps = 0.f;
#pragma unroll
    for (int r = 0; r < 16; ++r) { p[r] = __builtin_amdgcn_exp2f(p[r] - mn); ps += p[r]; }
    lsum = lsum * f + ps;
#pragma unroll
    for (int d = 0; d < ND; ++d)
#pragma unroll
        for (int r = 0; r < 16; ++r) o[d][r] *= f;
#pragma unroll
    for (int s = 0; s < 2; ++s) { v4u w; w.x = pkbf(p[8 * s + 0], p[8 * s + 1]); w.y = pkbf(p[8 * s + 2], p[8 * s + 3]); w.z = pkbf(p[8 * s + 4], p[8 * s + 5]); w.w = pkbf(p[8 * s + 6], p[8 * s + 7]); pb[s] = __builtin_bit_cast(bf16x8, w); }
}
__device__ __forceinline__ int opaque_lane() { int t = threadIdx.x; asm volatile("" : "+v"(t)); return t & 63; }
__device__ __forceinline__ void store_o32(bf16* yrow  , const f32x16& o, float inv, int hi) {
#pragma unroll
    for (int g = 0; g < 4; g += 2) {
        unsigned ax = pkbf(o[4 * g] * inv, o[4 * g + 1] * inv), ay = pkbf(o[4 * g + 2] * inv, o[4 * g + 3] * inv);
        unsigned bx = pkbf(o[4 * g + 4] * inv, o[4 * g + 5] * inv), by = pkbf(o[4 * g + 6] * inv, o[4 * g + 7] * inv);
        const auto r0 = __builtin_amdgcn_permlane32_swap(ax, bx, false, false); ax = r0[0]; bx = r0[1];
        const auto r1 = __builtin_amdgcn_permlane32_swap(ay, by, false, false); ay = r1[0]; by = r1[1];
        v4u w; w.x = ax; w.y = ay; w.z = bx; w.w = by;
        *(v4u*)(yrow + 8 * g + 8 * hi) = w; }
}
__device__ __forceinline__ void mem_item(Frame& F, int l, int h, int qb) {
    const int lane = opaque_lane(), r32 = lane & 31, hi = lane >> 5;
    bf16* Y = (bf16*)(F.ws + WS_Y);
    const bf16* Qp = (const bf16*)(F.ws + WS_QMF) + (size_t)((h * 256 + qb) * 8) * 512 + lane * 8;
    const bf16* Kp = (const bf16*)(F.ws + WS_MK) + (size_t)((l * 4 + h) * 8) * 8 * 512 + lane * 8;
    const bf16* Vp = (const bf16*)(F.ws + WS_MVT) + (size_t)((l * 4 + h) * 8) * 8 * 512 + lane * 8;
    bf16x8 qf[8], kf[8], vf[8];
#pragma unroll
    for (int j = 0; j < 8; ++j) { qf[j] = *(const bf16x8*)(Qp + j * 512); kf[j] = *(const bf16x8*)(Kp + j * 512); }
#pragma unroll
    for (int j = 0; j < 8; ++j) vf[j] = *(const bf16x8*)(Vp + j * 512);
    f32x16 o[4];
#pragma unroll
    for (int d = 0; d < 4; ++d)
#pragma unroll
        for (int r = 0; r < 16; ++r) o[d][r] = 0.f;
    float m = -1e30f, lsum = 0.f;
#pragma clang loop unroll(disable)
    for (int kt = 0; kt < 8; ++kt) {
        f32x16 p;
#pragma unroll
        for (int r = 0; r < 16; ++r) p[r] = 0.f;
#pragma unroll
        for (int j = 0; j < 8; ++j) p = MFMA32(kf[j], qf[j], p);
        const int kn = kt < 7 ? kt + 1 : kt;
#pragma unroll
        for (int j = 0; j < 8; ++j) kf[j] = *(const bf16x8*)(Kp + (size_t)(kn * 8 + j) * 512);
        bf16x8 pb[2]; softmax_tile<4>(p, m, lsum, o, pb);
#pragma unroll
        for (int d = 0; d < 4; ++d)
#pragma unroll
            for (int s2 = 0; s2 < 2; ++s2) o[d] = MFMA32(vf[d * 2 + s2], pb[s2], o[d]);
#pragma unroll
        for (int j = 0; j < 8; ++j) vf[j] = *(const bf16x8*)(Vp + (size_t)(kn * 8 + j) * 512);
    }
    lsum += __shfl_xor(lsum, 32); const float inv = 1.0f / lsum;
    bf16* yp = Y + (size_t)(qb * 32 + r32) * cfg::PD + 1536 + h * 128;
#pragma unroll
    for (int d = 0; d < 4; ++d) store_o32(yp + d * 32, o[d], inv, hi);
}
__device__ __forceinline__ void swa_item(Frame& F, int l, int hq, int qb) {
    const int lane = opaque_lane(), r32 = lane & 31, hi = lane >> 5, kvh = hq >> 3;
    bf16* Y = (bf16*)(F.ws + WS_Y);
    const bf16* Qp = (const bf16*)(F.ws + WS_AQ) + (size_t)((hq * 256 + qb) * 4) * 512 + lane * 8;
    const bf16* Kp = (const bf16*)(F.ws + WS_KB) + (size_t)(kvh * 256) * 4 * 512 + lane * 8;
    const bf16* Vp = (const bf16*)(F.ws + WS_VT) + (size_t)(kvh * 256) * 4 * 512 + lane * 8;
    const int i0 = qb < 4 ? 4 - qb : 0;
    bf16x8 qf[4], kf[4], vf[4];
#pragma unroll
    for (int j = 0; j < 4; ++j) { qf[j] = *(const bf16x8*)(Qp + j * 512); kf[j] = *(const bf16x8*)(Kp + (size_t)((qb - 4 + i0) * 4 + j) * 512); }
#pragma unroll
    for (int j = 0; j < 4; ++j) vf[j] = *(const bf16x8*)(Vp + (size_t)((qb - 4 + i0) * 4 + j) * 512);
    f32x16 o[2];
#pragma unroll
    for (int d = 0; d < 2; ++d)
#pragma unroll
        for (int r = 0; r < 16; ++r) o[d][r] = 0.f;
    float m = F.sinks[(l - 2) * cfg::NQH + hq] * cfg::LOG2E, lsum = hi == 0 ? 1.0f : 0.0f;
#pragma clang loop unroll(disable)
    for (int i = i0; i < 5; ++i) { const int kt = qb - 4 + i;
        f32x16 p;
#pragma unroll
        for (int r = 0; r < 16; ++r) p[r] = 0.f;
#pragma unroll
        for (int j = 0; j < 4; ++j) p = MFMA32(kf[j], qf[j], p);
        const int kn = i < 4 ? kt + 1 : kt;
#pragma unroll
        for (int j = 0; j < 4; ++j) kf[j] = *(const bf16x8*)(Kp + (size_t)(kn * 4 + j) * 512);
        if (i == 0 || i == 4) {
#pragma unroll
            for (int r = 0; r < 16; ++r) { const int jj = (r & 3) + 8 * (r >> 2) + 4 * hi; const bool ok = (i == 0) ? (jj >= r32 + 1) : (jj <= r32); p[r] = ok ? p[r] : -INFINITY; } }
        bf16x8 pb[2]; softmax_tile<2>(p, m, lsum, o, pb);
#pragma unroll
        for (int d = 0; d < 2; ++d)
#pragma unroll
            for (int s2 = 0; s2 < 2; ++s2) o[d] = MFMA32(vf[d * 2 + s2], pb[s2], o[d]);
#pragma unroll
        for (int j = 0; j < 4; ++j) vf[j] = *(const bf16x8*)(Vp + (size_t)(kn * 4 + j) * 512);
    }
    lsum += __shfl_xor(lsum, 32); const float inv = 1.0f / lsum;
    bf16* yp = Y + (size_t)(qb * 32 + r32) * cfg::PD + hq * 64;
#pragma unroll
    for (int d = 0; d < 2; ++d) store_o32(yp + d * 32, o[d], inv, hi);
}
__device__ __forceinline__ void stage_lds(Frame& F, const void* src, int lds_off, int bytes) {
    for (int i = 0; i < bytes / 8192; ++i)
        __builtin_amdgcn_global_load_lds((const unsigned*)((const char*)src + (size_t)i * 8192 + F.tid * 16), (LAS unsigned*)(F.lds + lds_off + i * 8192 + F.wave * 1024), 16, 0, 0);
}
__device__ __forceinline__ void mem_item_lds(Frame& F, int h, int qb, const LAS unsigned char* kv) {
    const int lane = opaque_lane(), r32 = lane & 31, hi = lane >> 5;
    bf16* Y = (bf16*)(F.ws + WS_Y);
    const bf16* Qp = (const bf16*)(F.ws + WS_QMF) + (size_t)((h * 256 + qb) * 8) * 512 + lane * 8;
    const LAS unsigned char* Kp = kv + lane * 16; const LAS unsigned char* Vp = kv + 65536 + lane * 16;
    bf16x8 qf[8];
#pragma unroll
    for (int j = 0; j < 8; ++j) qf[j] = *(const bf16x8*)(Qp + j * 512);
    f32x16 o[4];
#pragma unroll
    for (int d = 0; d < 4; ++d)
#pragma unroll
        for (int r = 0; r < 16; ++r) o[d][r] = 0.f;
#if ONEPASS_LDS
    f32x16 sc[8];
#pragma unroll
    for (int kt = 0; kt < 8; ++kt) {
#pragma unroll
        for (int r = 0; r < 16; ++r) sc[kt][r] = 0.f;
#pragma unroll
        for (int j = 0; j < 8; ++j) sc[kt] = MFMA32(*(const LAS bf16x8*)(Kp + (kt * 8 + j) * 1024), qf[j], sc[kt]);
    }
    float m = sc[0][0];
#pragma unroll
    for (int kt = 0; kt < 8; ++kt)
#pragma unroll
        for (int r = 0; r < 16; ++r) m = fmaxf(m, sc[kt][r]);
    m = fmaxf(m, __shfl_xor(m, 32));
    float lsum = 0.f;
#pragma unroll
    for (int kt = 0; kt < 8; ++kt) {
#pragma unroll
        for (int r = 0; r < 16; ++r) { sc[kt][r] = __builtin_amdgcn_exp2f(sc[kt][r] - m); lsum += sc[kt][r]; }
        bf16x8 pb[2];
#pragma unroll
        for (int s2 = 0; s2 < 2; ++s2) { v4u w; w.x = pkbf(sc[kt][8 * s2 + 0], sc[kt][8 * s2 + 1]); w.y = pkbf(sc[kt][8 * s2 + 2], sc[kt][8 * s2 + 3]); w.z = pkbf(sc[kt][8 * s2 + 4], sc[kt][8 * s2 + 5]); w.w = pkbf(sc[kt][8 * s2 + 6], sc[kt][8 * s2 + 7]); pb[s2] = __builtin_bit_cast(bf16x8, w); }
#pragma unroll
        for (int d = 0; d < 4; ++d)
#pragma unroll
            for (int s2 = 0; s2 < 2; ++s2) o[d] = MFMA32(*(const LAS bf16x8*)(Vp + (kt * 8 + d * 2 + s2) * 1024), pb[s2], o[d]);
    }
#else
    float m = -1e30f, lsum = 0.f;
#pragma clang loop unroll(disable)
    for (int kt = 0; kt < 8; ++kt) {
        f32x16 p;
#pragma unroll
        for (int r = 0; r < 16; ++r) p[r] = 0.f;
#pragma unroll
        for (int j = 0; j < 8; ++j) p = MFMA32(*(const LAS bf16x8*)(Kp + (kt * 8 + j) * 1024), qf[j], p);
        bf16x8 pb[2]; softmax_tile<4>(p, m, lsum, o, pb);
#pragma unroll
        for (int d = 0; d < 4; ++d)
#pragma unroll
            for (int s2 = 0; s2 < 2; ++s2) o[d] = MFMA32(*(const LAS bf16x8*)(Vp + (kt * 8 + d * 2 + s2) * 1024), pb[s2], o[d]);
    }
#endif
    lsum += __shfl_xor(lsum, 32); const float inv = 1.0f / lsum;
    bf16* yp = Y + (size_t)(qb * 32 + r32) * cfg::PD + 1536 + h * 128;
#pragma unroll
    for (int d = 0; d < 4; ++d) store_o32(yp + d * 32, o[d], inv, hi);
}
__device__ __forceinline__ void swa_item_lds(Frame& F, int l, int hq, int qb, const LAS unsigned char* kv, int t0c) {
    const int lane = opaque_lane(), r32 = lane & 31, hi = lane >> 5;
    bf16* Y = (bf16*)(F.ws + WS_Y);
    const bf16* Qp = (const bf16*)(F.ws + WS_AQ) + (size_t)((hq * 256 + qb) * 4) * 512 + lane * 8;
    const LAS unsigned char* Kp = kv + lane * 16; const LAS unsigned char* Vp = kv + 49152 + lane * 16;
    const int i0 = qb < 4 ? 4 - qb : 0;
    bf16x8 qf[4];
#pragma unroll
    for (int j = 0; j < 4; ++j) qf[j] = *(const bf16x8*)(Qp + j * 512);
    f32x16 o[2];
#pragma unroll
    for (int d = 0; d < 2; ++d)
#pragma unroll
        for (int r = 0; r < 16; ++r) o[d][r] = 0.f;
    float m = F.sinks[(l - 2) * cfg::NQH + hq] * cfg::LOG2E, lsum = hi == 0 ? 1.0f : 0.0f;
#pragma clang loop unroll(disable)
    for (int i = i0; i < 5; ++i) { const int sl = qb - 4 + i - t0c;
        f32x16 p;
#pragma unroll
        for (int r = 0; r < 16; ++r) p[r] = 0.f;
#pragma unroll
        for (int j = 0; j < 4; ++j) p = MFMA32(*(const LAS bf16x8*)(Kp + (sl * 4 + j) * 1024), qf[j], p);
        if (i == 0 || i == 4) {
#pragma unroll
            for (int r = 0; r < 16; ++r) { const int jj = (r & 3) + 8 * (r >> 2) + 4 * hi; const bool ok = (i == 0) ? (jj >= r32 + 1) : (jj <= r32); p[r] = ok ? p[r] : -INFINITY; } }
        bf16x8 pb[2]; softmax_tile<2>(p, m, lsum, o, pb);
#pragma unroll
        for (int d = 0; d < 2; ++d)
#pragma unroll
            for (int s2 = 0; s2 < 2; ++s2) o[d] = MFMA32(*(const LAS bf16x8*)(Vp + (sl * 4 + d * 2 + s2) * 1024), pb[s2], o[d]);
    }
    lsum += __shfl_xor(lsum, 32); const float inv = 1.0f / lsum;
    bf16* yp = Y + (size_t)(qb * 32 + r32) * cfg::PD + hq * 64;
#pragma unroll
    for (int d = 0; d < 2; ++d) store_o32(yp + d * 32, o[d], inv, hi);
}
template <int W> __device__ __forceinline__ void poolw_run(const float* Z, bf16* Y, const float* scale, int c, int t0) {
    f32x4 z[W + 7];
#pragma unroll
    for (int k = 0; k < W + 7; ++k) { const int j = t0 - (W - 1) + k; z[k] = j >= 0 ? *(const f32x4*)(Z + (size_t)j * cfg::MIX + c) : (f32x4){0.f, 0.f, 0.f, 0.f}; }
    const f32x4 sc = *(const f32x4*)(scale + c);
    f32x4 s = z[0];
#pragma unroll
    for (int k = 1; k < W; ++k) s += z[k];
#pragma unroll
    for (int i = 0; i < 8; ++i) { const int t = t0 + i;
        if (i > 0) s += z[W - 1 + i] - z[i - 1];
        const float rc = 1.0f / (float)(t + 1 < W ? t + 1 : W); const f32x4 y = (s * rc - z[W - 1 + i]) * sc;
        v2u o; o.x = pkbf(y[0], y[1]); o.y = pkbf(y[2], y[3]); *(v2u*)(Y + (size_t)t * cfg::PD + c) = o; }
}
template <int W> __device__ __forceinline__ void poolw_run_u(const bf16* U, bf16* Y, int c, int t0) {
    f32x4 z[W + 7];
#pragma unroll
    for (int k = 0; k < W + 7; ++k) { const int j = t0 - (W - 1) + k; v2u r; r.x = 0u; r.y = 0u; if (j >= 0) r = *(const v2u*)(U + (size_t)j * cfg::PD + c);
        z[k][0] = __uint_as_float(r.x << 16); z[k][1] = __uint_as_float(r.x & 0xffff0000u); z[k][2] = __uint_as_float(r.y << 16); z[k][3] = __uint_as_float(r.y & 0xffff0000u); }
    f32x4 s = z[0];
#pragma unroll
    for (int k = 1; k < W; ++k) s += z[k];
#pragma unroll
    for (int i = 0; i < 8; ++i) { const int t = t0 + i;
        if (i > 0) s += z[W - 1 + i] - z[i - 1];
        const float rc = 1.0f / (float)(t + 1 < W ? t + 1 : W); const f32x4 y = s * rc - z[W - 1 + i];
        v2u o; o.x = pkbf(y[0], y[1]); o.y = pkbf(y[2], y[3]); *(v2u*)(Y + (size_t)t * cfg::PD + c) = o; }
}
__device__ __forceinline__ void poolw_item(Frame& F, int l, int chunk, int rb) {
    const float* Z = (const float*)(F.ws + WS_Z); bf16* Y = (bf16*)(F.ws + WS_Y);
    const int lane = opaque_lane(), g = chunk / 3, c = chunk * 128 + (lane & 31) * 4, t0 = rb * 16 + 8 * (lane >> 5);
    const float* scale = F.pool_scale + (size_t)l * cfg::MIX;
#if POOL_FOLD
    const bf16* U = (const bf16*)(F.ws + WS_AQ); (void)Z; (void)scale;
    if (g == 0) poolw_run_u<2>(U, Y, c, t0); else if (g == 1) poolw_run_u<4>(U, Y, c, t0); else if (g == 2) poolw_run_u<8>(U, Y, c, t0); else poolw_run_u<16>(U, Y, c, t0);
#else
    if (g == 0) poolw_run<2>(Z, Y, scale, c, t0); else if (g == 1) poolw_run<4>(Z, Y, scale, c, t0); else if (g == 2) poolw_run<8>(Z, Y, scale, c, t0); else poolw_run<16>(Z, Y, scale, c, t0);
#endif
}
constexpr int PH_END = 66;
__device__ __forceinline__ int probe_class(int k) { if (k == 0) return 0; if (k >= 65) return 8; const int ii = (k - 1) / 8, j = (k - 1) % 8, ll = ii >> 1; return j == 0 ? 1 : j == 1 ? 2 : j == 2 ? 3 : j == 3 ? 4 : j == 4 ? (ll < 2 ? 5 : 6) : 7; }
struct Args { const float* in[17]; float* out; unsigned char* ws; int ph_lo, ph_hi; };
__global__ void __launch_bounds__(NWAVES * 64, 2) yoco_fwd(Args args) {
    extern __shared__ __attribute__((aligned(16))) unsigned char lds[];
    using namespace cfg;
    Frame F;
    F.lds = (LAS unsigned char*)lds;
    F.MISC = (volatile LAS unsigned*)(F.lds + MISC_OFF);
    F.tid = threadIdx.x; F.lane = F.tid & 63; F.wave = __builtin_amdgcn_readfirstlane(F.tid >> 6);
    F.G = gridDim.x; { const int bx = blockIdx.x; F.vcu = (F.G % 8 == 0) ? (bx % 8) * (F.G / 8) + bx / 8 : bx; }
    F.x = args.in[0]; F.mem = args.in[1]; F.pos = (const int*)args.in[2]; F.norms = args.in[3]; F.gate = args.in[4]; F.up = args.in[5]; F.down = args.in[6]; F.w_in = args.in[7]; F.w_out = args.in[8];
    F.pool_w = args.in[9]; F.pool_scale = args.in[10]; F.w_kv = args.in[11]; F.kv_norm = args.in[12]; F.sinks = args.in[13]; F.w_mem_kv = args.in[14]; F.mem_norm = args.in[15]; F.final_norm = args.in[16];
    F.out = args.out; F.ws = args.ws;
    for (int u = F.tid; u < (LDS_BYTES - LDSCTL_OFF) / 4; u += NWAVES * 64) ((LAS unsigned*)(F.lds + LDSCTL_OFF))[u] = 0u;
    __syncthreads();
    XcdBarrier bar = xcd_barrier_post((unsigned*)(F.ws + WS_CTL) + CW_BAR, F.MISC + 8);
    const int lo = args.ph_lo, hi = args.ph_hi;
#if !PROBE
#define IN(k) (lo <= (k) && (k) < hi)
#else
#define STAMP2(k) ((blockIdx.x == 0 && threadIdx.x == 0) ? (void)__hip_atomic_store((unsigned long long*)(args.ws + 768 * 1024) + 2 * (k), (unsigned long long)__builtin_amdgcn_s_memrealtime(), __ATOMIC_RELAXED, __HIP_MEMORY_SCOPE_AGENT) : (void)0)
#endif
#if PROBE
    unsigned long long* ts = (unsigned long long*)(F.ws + 768 * 1024);
#define STAMP(slot) do { if (blockIdx.x == 0 && F.tid == 0) __hip_atomic_store(ts + (slot), (unsigned long long)__builtin_amdgcn_s_memrealtime(), __ATOMIC_RELAXED, __HIP_MEMORY_SCOPE_AGENT); } while (0)
#define SEAM(k) do { STAMP(2 * (k) + 1); if (PROBE_Q >= 0 && F.tid == 0 && probe_class(k) == PROBE_C) { const unsigned long long t1_ = __builtin_amdgcn_s_memrealtime(); const unsigned long long t0_ = ((unsigned long long)F.MISC[17] << 32) | F.MISC[16]; F.MISC[18] = __float_as_uint(__uint_as_float(F.MISC[18]) + (float)(t1_ - t0_) * 0.01f); } if ((k) + 1 < hi || PROBE) xcd_barrier(bar); } while (0)
#define IN(k) ((lo <= (k) && (k) < hi) && (STAMP2(k), STAMP3(), true))
#define SEAM_G(k) do { STAMP(2 * (k) + 1); if (GROUP_BAR) { ++gcalls; grp_barrier((unsigned*)(F.ws + WS_CTL), mypm, 8u * gcalls, grp_same_xcd); } else xcd_barrier(bar); } while (0)
#define STAMP3() ((PROBE_Q >= 0 && threadIdx.x == 0) ? (void)(tnow_ = __builtin_amdgcn_s_memrealtime(), F.MISC[16] = (unsigned)tnow_, F.MISC[17] = (unsigned)(tnow_ >> 32)) : (void)0)
    unsigned long long tnow_ = 0ull;
#else
#define SEAM_G(k) do { if ((k) + 1 < hi) { if (GROUP_BAR) { ++gcalls; grp_barrier((unsigned*)(F.ws + WS_CTL), mypm, 8u * gcalls, grp_same_xcd); } else xcd_barrier(bar); } } while (0)
#define SEAM(k) do { if ((k) + 1 < hi) { xcd_barrier(bar); if (EXPT == 5) xcd_barrier(bar); if (EXPT == 6) { const unsigned long long t0_ = __builtin_amdgcn_s_memrealtime(); while (__builtin_amdgcn_s_memrealtime() - t0_ < 5000ull) __builtin_amdgcn_s_sleep(32); } } } while (0)
#endif
    unsigned char* ws = F.ws;
    float* H = F.out; bf16* HB = (bf16*)(ws + WS_HB); float* SSQ = (float*)(ws + WS_SSQ); bf16* HFF = (bf16*)(ws + WS_HFF); bf16* AQ = (bf16*)(ws + WS_AQ); bf16* Y = (bf16*)(ws + WS_Y);
    const float* RC = (const float*)(ws + WS_ROPE_C); const float* RS = (const float*)(ws + WS_ROPE_S);
    const int bx = (int)blockIdx.x;
#define KT0(K_) ((KSTAGGER && BAL_DMA && GEMM_SP2) ? ((((bx & 7) * ((K_) / 64)) >> 3) & ~1) : 0)
    int mypm, mypn; { pg8::StaticOrder S0; S0.init(S, D, F.G, bx); pg8::Unit u0; S0.next(0, u0); mypm = u0.pm; mypn = u0.pn; }
    unsigned gcalls = 0u;
    if (GROUP_BAR && F.tid == 0) (void)__hip_atomic_fetch_or((unsigned*)(F.ws + WS_CTL) + CW_GRPX + 64 * mypm, 1u << xb_xcc_id(), __ATOMIC_RELAXED, __HIP_MEMORY_SCOPE_AGENT);
    bool grp_same_xcd = false;

    if (IN(0)) for (int rep = 0; rep < NREP(0); ++rep) { if constexpr (PHON(0)) p0_prologue(F); SEAM(0); }
    if (GROUP_BAR && lo == 0 && hi > 1) {
        const unsigned m = (unsigned)__builtin_amdgcn_readfirstlane((int)__hip_atomic_load((unsigned*)(F.ws + WS_CTL) + CW_GRPX + 64 * mypm, __ATOMIC_RELAXED, __HIP_MEMORY_SCOPE_AGENT));
        grp_same_xcd = (__builtin_popcount(m) == 1) && (GROUP_BAR != 3); }

    for (int i = 0; i < 8; ++i) {
        const int l = i >> 1, half = i & 1, base = 1 + 8 * i;
        if (IN(base)) for (int rep = 0; rep < NREP(1); ++rep) {
            const bf16* WGU = (const bf16*)(ws + WS_WGU + (size_t)i * WGU_BYTES);
            if constexpr (PHON(1)) { pg8::Gemm g{HB, WGU, PD, PD, D}; g.kt0 = KT0(D); pg8::StaticOrder S_; S_.init(S, NGU, F.G, bx); const bool split_tail = (HALFTAIL || SPLITK_TAIL) && i != 0 && i != 4; if (split_tail) S_.maxr = 5; pg8::EpiSwiGLU E{HFF, SSQ, 0};
#if RSTD_LDS
              if (GROUP_BAR) { LAS float* rt_ = (LAS float*)(F.lds + RSTD_TAB_OFF); if (F.tid < 256) rt_[F.tid] = pg8::rstd_of(SSQ, 256 * mypm + F.tid); __syncthreads(); E.rtab = rt_; E.rtab_pm = mypm; }
#endif
#if EXPT
              if (rep) { int ns_ = 1; asm volatile("" : "+s"(ns_)); E.nostore = ns_; S_.flat = (EXPT == 2 || EXPT == 3); if (EXPT == 3) g.A = (const bf16*)(ws + WS_END); }
#endif
#if EXPT == 7 || EXPT == 8
              if (rep) pg8::gemm_phase<pg8::EpiSwiGLU, pg8::StaticOrder, true, GEMM_SP2, false, EXPT - 6>(F.lds + RING_OFF, g, S_, E); else
#endif
#if STAGGER_TICKS
              if (i != 0 && i != 4) { pg8::Unit tu_; if (!S_.next(5, tu_)) { const unsigned long long t0_ = __builtin_amdgcn_s_memrealtime(); while (__builtin_amdgcn_s_memrealtime() - t0_ < (unsigned long long)STAGGER_TICKS) __builtin_amdgcn_s_sleep(16); } }
#endif
              pg8::gemm_phase<pg8::EpiSwiGLU, pg8::StaticOrder, true, GEMM_SP2>(F.lds + RING_OFF, g, S_, E);
#if SPLITK_TAIL
              if (split_tail) {
                  const int j = mypn & 3, role = mypn >> 2, pair = mypm * 4 + j;
                  pg8::Gemm g2{HB + role * 1024, WGU + role * 1024, PD, PD, D / 2}; pg8::OneUnitOrder S2{mypm, 40 + j};
                  pg8::EpiSwiGLUSplit E2{HFF, SSQ, (float*)(ws + WS_SPL + (size_t)pair * 262144), (unsigned*)(ws + WS_CTL) + CW_SPL + 64 * pair, (unsigned*)(ws + WS_CTL) + CW_BAR + XB_TMO, (unsigned)(i < 4 ? i : i - 1), role, grp_same_xcd ? 1 : 0};
                  pg8::gemm_phase<pg8::EpiSwiGLUSplit, pg8::OneUnitOrder, false, GEMM_SP2>(F.lds + RING_OFF, g2, S2, E2); }
#endif
#if HALFTAIL
              if (split_tail) {
                  pg8::StaticOrder S2; S2.init(S, NGU, F.G, bx); S2.halftail = (HALFTAIL == 1); S2.r0 = 5; S2.maxr = 1;
                  pg8::gemm_phase<pg8::EpiSwiGLU, pg8::StaticOrder, false, GEMM_SP2, true>(F.lds + RING_OFF, g, S2, E); }
#endif
              }
            if constexpr (PHON(2)) if (i == 0) {
                pg8::Gemm g{(const bf16*)(ws + WS_MEMN), (const bf16*)(ws + WS_WMKV), PD, PD, D}; g.kt0 = KT0(D); pg8::SubsetOrder S_{128, 16, 16, bx}; pg8::EpiMemKV E{(bf16*)(ws + WS_MK), (bf16*)(ws + WS_MVT)};
                pg8::gemm_phase<pg8::EpiMemKV, pg8::SubsetOrder, false, GEMM_SP2>(F.lds + RING_OFF, g, S_, E); }
            if constexpr (PHON(3)) if (i == 4) {
                pg8::Gemm g{HB, WGU + (size_t)NGU * PD, PD, PD, D}; g.kt0 = KT0(D); pg8::SubsetOrder S_{0, 64, 2, (OWN_KV && (mypn == 4 || mypn == 5)) ? 2 * mypm + (mypn - 4) : (OWN_KV ? -1 : bx - 128)};   pg8::EpiKV E{(bf16*)(ws + WS_KB), (bf16*)(ws + WS_VT), SSQ, RC, RS};
                pg8::gemm_phase<pg8::EpiKV, pg8::SubsetOrder, false, GEMM_SP2>(F.lds + RING_OFF, g, S_, E); }
#if POOL_FOLD
            if (i < 2 && rep == 0) {
                pg8::Gemm g{(const bf16*)(ws + WS_WOUT + (size_t)i * WIO_BYTES), (const bf16*)(ws + WS_WPS) + (size_t)i * 2048 * 384, PD, 384, 384}; g.kt0 = 0;
                pg8::SubsetPoolOrder S_{i == 0 ? 144 : 128, 64, 8, bx}; pg8::EpiFold E{(bf16*)(ws + WS_WOUT2 + (size_t)i * WIO_BYTES)};
                pg8::gemm_phase<pg8::EpiFold, pg8::SubsetPoolOrder, false, GEMM_SP2>(F.lds + RING_OFF, g, S_, E); }
#endif
            if (rep == 0) conv_tail(F, i);
            SEAM_G(base);
        }
        if (IN(base + 1)) for (int rep = 0; rep < NREP(2); ++rep) {
            pg8::Gemm g{HFF, (const bf16*)(ws + WS_WD + (size_t)i * WD_BYTES), PF, PF, FF}; g.kt0 = KT0(FF); pg8::StaticOrder S_; S_.init(S, D, F.G, bx);
            pg8::EpiResid E{(i == 0 && rep == 0) ? F.x : nullptr, HB, (bf16*)(ws + WS_HL), SSQ, rep ? 0.0f : 0.5f, (EXPT == 4 && rep) ? 1 : 0};
            if constexpr (PHON(4)) pg8::gemm_phase<pg8::EpiResid, pg8::StaticOrder, false, GEMM_SP2>(F.lds + RING_OFF, g, S_, E);
            if (i == 4 || (!OWN_KV && i == 3) || (!OWN_FINAL && i == 7)) SEAM(base + 1); else SEAM_G(base + 1);
        }
        if (half == 0) {
            if (IN(base + 2)) for (int rep = 0; rep < NREP(3); ++rep) {
                pg8::Gemm g{HB, (const bf16*)(ws + WS_WIN + (size_t)l * WIO_BYTES), PD, PD, D}; g.kt0 = KT0(D); pg8::StaticOrder S_; S_.init(S, D, F.G, bx);
                pg8::EpiWin E{AQ, (bf16*)(ws + WS_QMF), SSQ, RC, RS, l >= 2 ? 1 : 0};
                if constexpr (PHON(5)) pg8::gemm_phase<pg8::EpiWin, pg8::StaticOrder, false, GEMM_SP2>(F.lds + RING_OFF, g, S_, E);
#if FUSE_SWA_MIX
                if (l >= 2) {
                    pg8::Unit u; S_.next(0, u);
                    asm volatile("s_waitcnt vmcnt(0)" ::: "memory");
#if LDS_KV
                    const LAS unsigned char* kvl = (const LAS unsigned char*)(F.lds + RING_OFF);
                    if (u.pn < 6) {
                        const int kvh = u.pn >> 1, t0c = (8 * u.pm - 4) < 0 ? 0 : 8 * u.pm - 4;
                        stage_lds(F, (const bf16*)(ws + WS_KB) + (size_t)((kvh * 256 + t0c) * 4) * 512, RING_OFF, 49152);
                        stage_lds(F, (const bf16*)(ws + WS_VT) + (size_t)((kvh * 256 + t0c) * 4) * 512, RING_OFF + 49152, 49152);
                        asm volatile("s_waitcnt vmcnt(0)" ::: "memory"); __syncthreads();
                        if constexpr (PHON(7)) for (int hh = 0; hh < 4; ++hh) swa_item_lds(F, l, 4 * u.pn + hh, 8 * u.pm + F.wave, kvl, t0c);
                    } else {
                        for (int hb = 0; hb < 2; ++hb) { const int h = 2 * (u.pn - 6) + hb;
                            if (hb) __syncthreads();
                            stage_lds(F, (const bf16*)(ws + WS_MK) + (size_t)((l * 4 + h) * 64) * 512, RING_OFF, 65536);
                            stage_lds(F, (const bf16*)(ws + WS_MVT) + (size_t)((l * 4 + h) * 64) * 512, RING_OFF + 65536, 65536);
                            asm volatile("s_waitcnt vmcnt(0)" ::: "memory"); __syncthreads();
                            if constexpr (PHON(7)) mem_item_lds(F, h, 8 * u.pm + F.wave, kvl); }
                    }
#else
                    if (F.tid == 0) F.MISC[0] = 0u;
                    __syncthreads();
                    const int nit = u.pn < 6 ? 32 : 16;
                    if constexpr (PHON(7)) for (;;) {
                        unsigned idx = 0u;
                        if (F.lane == 0) idx = __hip_atomic_fetch_add((LAS unsigned*)(F.lds + MISC_OFF), 1u, __ATOMIC_RELAXED, __HIP_MEMORY_SCOPE_WORKGROUP);
                        idx = (unsigned)__builtin_amdgcn_readfirstlane((int)idx);
                        if ((int)idx >= nit) break;
                        if (u.pn < 6) swa_item(F, l, 4 * u.pn + ((int)idx >> 3), 8 * u.pm + ((int)idx & 7));
                        else mem_item(F, l, 2 * (u.pn - 6) + ((int)idx >> 3), 8 * u.pm + ((int)idx & 7));
                    }
#endif
                }
#endif
                if (POOL_FOLD && l < 2) SEAM(base + 2); else SEAM_G(base + 2);
            }
            if (!POOL_FOLD && l < 2 && IN(base + 3)) for (int rep = 0; rep < NREP(4); ++rep) {
                pg8::Gemm g{AQ, (const bf16*)(ws + WS_WPOOL) + (size_t)l * 2048 * 384, PD, 384, 384}; g.kt0 = KT0(384); pg8::PoolOrder S_; S_.init(S, D, F.G, bx);
                pg8::EpiPool E{(float*)(ws + WS_Z)};
                if constexpr (PHON(6)) pg8::gemm_phase<pg8::EpiPool, pg8::PoolOrder, false, GEMM_SP2>(F.lds + RING_OFF, g, S_, E);
                SEAM(base + 3);
            }
            if ((l < 2 || !FUSE_SWA_MIX) && IN(base + 4)) for (int rep = 0; rep < (l < 2 ? NREP(5) : NREP(6)); ++rep) {
                if (F.tid == 0) F.MISC[0] = 0u;
#if LDS_KV
                {
                    const int h = OWN_POOLMIX ? (mypn & 3) : (F.vcu & 3);
                    stage_lds(F, (const bf16*)(ws + WS_MK) + (size_t)((l * 4 + h) * 64) * 512, RING_OFF, 65536);
                    stage_lds(F, (const bf16*)(ws + WS_MVT) + (size_t)((l * 4 + h) * 64) * 512, RING_OFF + 65536, 65536);
                    asm volatile("s_waitcnt vmcnt(0)" ::: "memory"); }
#endif
                __syncthreads();
                const int nit = 28;
                if constexpr (PHON(7)) for (;;) {
                    unsigned idx = 0u;
                    if (F.lane == 0) idx = __hip_atomic_fetch_add((LAS unsigned*)(F.lds + MISC_OFF), 1u, __ATOMIC_RELAXED, __HIP_MEMORY_SCOPE_WORKGROUP);
                    idx = (unsigned)__builtin_amdgcn_readfirstlane((int)idx);
                    if ((int)idx >= nit) break;
#if MIXEXP
                    if (rep && ((MIXEXP == 1) != (idx < 4u))) continue;
#endif
                    if (idx < 4u) { if (LDS_KV) mem_item_lds(F, OWN_POOLMIX ? (mypn & 3) : (F.vcu & 3), (OWN_POOLMIX ? 8 * mypm + 4 * (mypn >> 2) : 4 * (F.vcu >> 2)) + (int)idx, (const LAS unsigned char*)(F.lds + RING_OFF)); else if (OWN_POOLMIX) { const int e = 4 * mypn + (int)idx; mem_item(F, l, e >> 3, 8 * mypm + (e & 7)); } else mem_item(F, l, (int)idx, F.vcu); }
                    else if (l < 2) { if (OWN_POOLMIX) { const int e = 24 * mypn + (int)idx - 4; poolw_item(F, l, e % 12, 16 * mypm + e / 12); } else { const int item = 24 * F.vcu + (int)idx - 4; poolw_item(F, l, item % 12, item / 12); } }
                    else { const int k = (int)idx - 4, p = 3 * F.vcu + (k >> 3); swa_item(F, l, (p >> 8) * 8 + (k & 7), p & 255); }
                }
                if (OWN_POOLMIX) SEAM_G(base + 4); else SEAM(base + 4);
            }
            if (IN(base + 5)) for (int rep = 0; rep < NREP(7); ++rep) {
                pg8::Gemm g{Y, (const bf16*)(ws + ((POOL_FOLD && l < 2) ? WS_WOUT2 : WS_WOUT) + (size_t)l * WIO_BYTES), PD, PD, D}; g.kt0 = KT0(D); pg8::StaticOrder S_; S_.init(S, D, F.G, bx);
                pg8::EpiResid E{nullptr, HB, (bf16*)(ws + WS_HL), SSQ, rep ? 0.0f : 1.0f, 0};
                if constexpr (PHON(8)) pg8::gemm_phase<pg8::EpiResid, pg8::StaticOrder, false, GEMM_SP2>(F.lds + RING_OFF, g, S_, E);
                SEAM_G(base + 5);
            }
        }
    }
    if (IN(65)) {
#if OWN_FINAL
        { const int c = 256 * mypn + 4 * F.lane; const f32x4 gg = *(const f32x4*)(F.final_norm + c);
          for (int r0 = F.wave * 32; r0 < F.wave * 32 + 32; r0 += 8) { v2u ra[8], rb[8]; float rs[8];
#pragma unroll
              for (int j = 0; j < 8; ++j) { const int m = 256 * mypm + r0 + j; ra[j] = *(const v2u*)(HB + (size_t)m * PD + c); rb[j] = *(const v2u*)((const bf16*)(ws + WS_HL) + (size_t)m * PD + c); }
#pragma unroll
              for (int j = 0; j < 8; ++j) rs[j] = pg8::rstd_of(SSQ, 256 * mypm + r0 + j);
              asm volatile("" ::: "memory");
#pragma unroll
              for (int j = 0; j < 8; ++j) { const int m = 256 * mypm + r0 + j; const v2u a = ra[j], b = rb[j]; f32x4 h;
                  h[0] = __uint_as_float(a.x << 16) + __uint_as_float(b.x << 16); h[1] = __uint_as_float(a.x & 0xffff0000u) + __uint_as_float(b.x & 0xffff0000u);
                  h[2] = __uint_as_float(a.y << 16) + __uint_as_float(b.y << 16); h[3] = __uint_as_float(a.y & 0xffff0000u) + __uint_as_float(b.y & 0xffff0000u);
                  *(f32x4*)(H + (size_t)m * D + c) = h * rs[j] * gg; } } }
#else
        const int gw = F.vcu * NWAVES + F.wave, NGW = F.G * NWAVES;
        f32x4 gn[8];
#pragma unroll
        for (int j = 0; j < 8; ++j) gn[j] = ((const f32x4*)F.final_norm + F.lane)[64 * j];
        for (int m = gw; m < S; m += NGW) { const float rs = pg8::rstd_of(SSQ, m); f32x4* hr = (f32x4*)(H + (size_t)m * D) + F.lane;
            const v2u* hb = (const v2u*)(HB + (size_t)m * PD) + F.lane; const v2u* hl = (const v2u*)((const bf16*)(ws + WS_HL) + (size_t)m * PD) + F.lane;
            v2u ra[8], rb[8];
#pragma unroll
            for (int j = 0; j < 8; ++j) { ra[j] = hb[64 * j]; rb[j] = hl[64 * j]; }
            asm volatile("" ::: "memory");
#pragma unroll
            for (int j = 0; j < 8; ++j) { const v2u a = ra[j], b = rb[j]; f32x4 h;
                h[0] = __uint_as_float(a.x << 16) + __uint_as_float(b.x << 16); h[1] = __uint_as_float(a.x & 0xffff0000u) + __uint_as_float(b.x & 0xffff0000u);
                h[2] = __uint_as_float(a.y << 16) + __uint_as_float(b.y << 16); h[3] = __uint_as_float(a.y & 0xffff0000u) + __uint_as_float(b.y & 0xffff0000u);
                hr[64 * j] = h * rs * gn[j]; } }
#endif
#if PROBE
        if (F.tid == 0) __hip_atomic_store((unsigned*)(F.ws + 896 * 1024) + blockIdx.x, (unsigned)F.MISC[18], __ATOMIC_RELAXED, __HIP_MEMORY_SCOPE_AGENT);
        SEAM(65);
        if (blockIdx.x == 0 && F.tid == 0 && PROBE_Q >= 0) {
            float mx = -1.f, mn = 1e30f; int amx = 0, amn = 0;
            for (int b = 0; b < (int)gridDim.x; ++b) { const float v = __uint_as_float(__hip_atomic_load((unsigned*)(F.ws + 896 * 1024) + b, __ATOMIC_RELAXED, __HIP_MEMORY_SCOPE_AGENT)); if (v > mx) { mx = v; amx = b; } if (v < mn) { mn = v; amn = b; } }
            float val = 0.f;
            if (PROBE_Q == 0) val = mx * (1.0f / PROBE_SA); else if (PROBE_Q == 1) val = mn * (1.0f / PROBE_SA); else if (PROBE_Q == 2) val = (float)(amx % 8 + 1); else if (PROBE_Q == 3) val = (float)(amx / 8) * 0.25f + 1.0f; else if (PROBE_Q == 4) val = (float)(amn % 8 + 1); else val = (float)(amn / 8) * 0.25f + 1.0f;
            H[0] += val;
        }
        if (blockIdx.x == 0 && F.tid == 0 && PROBE_Q < 0) {
            float wallA = 0.f, wallB = 0.f;
            unsigned long long prev_start = 0ull; int prev_cls = -1;
            for (int k = 0; k <= 66; ++k) {
                bool ex = (k == 0 || k == 65 || k == 66); int c = (k == 0) ? 0 : 8;
                if (k >= 1 && k <= 64) { const int ii = (k - 1) / 8, j = (k - 1) % 8, ll = ii >> 1; ex = (j <= 1) || (!(ii & 1) && (j == 3 ? ll < 2 : (j == 4 ? (ll < 2 || !FUSE_SWA_MIX) : j <= 5))); c = j == 0 ? 1 : j == 1 ? 2 : j == 2 ? 3 : j == 3 ? 4 : j == 4 ? (ll < 2 ? 5 : 6) : 7; }
                if (!ex) continue;
                const unsigned long long st = (k == 66) ? __hip_atomic_load(ts + 2 * 65 + 1, __ATOMIC_RELAXED, __HIP_MEMORY_SCOPE_AGENT) : __hip_atomic_load(ts + 2 * k, __ATOMIC_RELAXED, __HIP_MEMORY_SCOPE_AGENT);
                if (prev_cls >= 0) { const float us = (float)(st - prev_start) * 0.01f; if (prev_cls == PROBE_A) wallA += us; if (prev_cls == PROBE_B) wallB += us; }
                if (k < 66) { const unsigned long long en = __hip_atomic_load(ts + 2 * k + 1, __ATOMIC_RELAXED, __HIP_MEMORY_SCOPE_AGENT); const float own = (float)(en - st) * 0.01f; if (c + 10 == PROBE_A) wallA += own; if (c + 10 == PROBE_B) wallB += own; }
                prev_start = st; prev_cls = c;
            }
            H[0] += wallA * (1.0f / PROBE_SA);
            const float vb = wallB * (1.0f / PROBE_SB);
            if (vb != 0.f) for (int j = 1; j <= 65536; ++j) H[j] += vb;
        }
#endif
    }
#undef IN
#undef SEAM
}

static int g_grid = 0;
static bool setup_grid() {
    if (g_grid != 0) return g_grid > 0;
    int dev = 0, cus = 0, per_cu = 0;
    if (hipGetDevice(&dev) != hipSuccess || hipDeviceGetAttribute(&cus, hipDeviceAttributeMultiprocessorCount, dev) != hipSuccess) { fprintf(stderr, "kernel_launch: device query failed\n"); g_grid = -1; return false; }
    if (hipFuncSetAttribute((const void*)yoco_fwd, hipFuncAttributeMaxDynamicSharedMemorySize, LDS_BYTES) != hipSuccess) { fprintf(stderr, "kernel_launch: hipFuncSetAttribute failed\n"); g_grid = -1; return false; }
    if (hipOccupancyMaxActiveBlocksPerMultiprocessor(&per_cu, (const void*)yoco_fwd, NWAVES * 64, LDS_BYTES) != hipSuccess || per_cu < 1) { fprintf(stderr, "kernel_launch: occupancy query reports %d workgroups per CU\n", per_cu); }
    (void)hipGetLastError();
    g_grid = cus;
    return true;
}
static void launch_phases(hipStream_t stream, void* const* d_in, void* d_out, void* d_ws, int lo, int hi) {
    Args a{};
    for (int i = 0; i < 17; ++i) a.in[i] = (const float*)d_in[i];
    a.out = (float*)d_out; a.ws = (unsigned char*)d_ws; a.ph_lo = lo; a.ph_hi = hi;
    hipLaunchKernelGGL(yoco_fwd, dim3(g_grid), dim3(NWAVES * 64), LDS_BYTES, stream, a);
}
static bool phase_exists(int k) {
    if (k == 0 || k == 65) return true;
    if (k < 1 || k > 64) return false;
    const int i = (k - 1) / 8, j = (k - 1) % 8, l = i >> 1;
    if (j <= 1) return true;
    if (i & 1) return false;
    if (j == 3) return l < 2;
    if (j == 4) return l < 2 || !FUSE_SWA_MIX;
    return j <= 5;
}
#if DBG
namespace dbg {
template <int FT  , int TR  >
__global__ void __launch_bounds__(256) k_cmp(const void* fast, long fld, const float* orc, long old, int rows, int cols, float fscale, unsigned* res) {
    float md = 0.f, mr = 0.f;
    const size_t n = (size_t)rows * cols;
    for (size_t idx = (size_t)blockIdx.x * 256 + threadIdx.x; idx < n; idx += (size_t)gridDim.x * 256) {
        const int r = (int)(idx / cols), c = (int)(idx % cols);
        const float o = orc[(size_t)r * old + c] * fscale;
        const size_t fo = TR ? (size_t)c * fld + r : (size_t)r * fld + c;
        float f;
        if (FT) { const unsigned short b = ((const unsigned short*)fast)[fo]; f = __uint_as_float((unsigned)b << 16); } else f = ((const float*)fast)[fo];
        float d = fabsf(f - o); if (!(d == d) || d > 1e30f) d = 1e30f;
        md = fmaxf(md, d); mr = fmaxf(mr, fabsf(o));
    }
#pragma unroll
    for (int o = 1; o < 64; o <<= 1) { md = fmaxf(md, __shfl_xor(md, o)); mr = fmaxf(mr, __shfl_xor(mr, o)); }
    if ((threadIdx.x & 63) == 0) { atomicMax(res, __float_as_uint(md)); atomicMax(res + 1, __float_as_uint(mr)); }
}
__global__ void __launch_bounds__(1024) k_report(const unsigned* res, int n, float tol, float* out) {
    __shared__ int first; __shared__ float ratio;
    if (threadIdx.x == 0) { first = -1; ratio = 0.f;
        for (int i = 1; i < n; ++i) { const float d = __uint_as_float(res[2 * i]), r = fmaxf(__uint_as_float(res[2 * i + 1]), 1e-20f); if (d > tol * r) { first = i; ratio = d / r; break; } } }
    __syncthreads();
    if (first >= 0) { const float V = 100.0f * (float)first; int nbad = (int)(fminf(ratio, 1000.f) * 1000.f); nbad = nbad < 1 ? 1 : nbad;
        for (int j = threadIdx.x; j < nbad; j += 1024) out[j] = V; }
}
struct Ctx { hipStream_t st; unsigned* res; };
template <int FT, int TR> static void cmp(const Ctx& c, int id, const void* fast, long fld, const float* orc, long old, int rows, int cols, float fscale = 1.f) {
    hipLaunchKernelGGL((k_cmp<FT, TR>), dim3(2048), dim3(256), 0, c.st, fast, fld, orc, old, rows, cols, fscale, c.res + 2 * id);
}
static void run(hipStream_t st, void* const* d_in, void* d_out, void* d_ws, const ref::In& in) {
    using namespace ref;
    unsigned char* ws = (unsigned char*)d_ws;
    unsigned* res = (unsigned*)(ws + 512 * 1024);
    Ctx c{st, res};
    float* ob = (float*)(ws + WS_END);
    float* Ho = ob; float* XN = Ho + (size_t)S * D; float* G = XN + (size_t)S * D; float* U = G + (size_t)S * FF; float* A = U; float* Yo = U + (size_t)S * D; float* DIFF = U + (size_t)2 * S * D;
    float* KV = U + (size_t)S * FF; float* MEMN = KV + (size_t)S * 384; float* MKV = MEMN + (size_t)ML * D;
    const unsigned short* HBf = (const unsigned short*)(ws + WS_HB); const unsigned short* HFFf = (const unsigned short*)(ws + WS_HFF); const unsigned short* AQf = (const unsigned short*)(ws + WS_AQ); const unsigned short* Yf = (const unsigned short*)(ws + WS_Y);
    auto fast = [&](int k) { launch_phases(st, d_in, d_out, d_ws, k, k + 1); };
    hipLaunchKernelGGL(k_rmsnorm, dim3(ML / 4), dim3(256), 0, st, in.mem, in.mem_norm, MEMN, ML, D);
    fast(0);
    cmp<1, 0>(c, 1, ws + WS_MEMN, cfg::PD, MEMN, D, ML, D);
    cmp<1, 0>(c, 2, HBf, cfg::PD, in.x, D, S, D);
    const float* hin = in.x;
    for (int l = 0; l < DEPTH; ++l) {
        const int idb = 5 + 20 * l;
        for (int half = 0; half < 2; ++half) {
            const int i = 2 * l + half, base = 1 + 8 * i;
            hipLaunchKernelGGL(k_rmsnorm, dim3(S / 4), dim3(256), 0, st, hin, in.norms + (size_t)(l * 3 + (half ? 2 : 0)) * D, XN, S, D);
            const size_t wo = (size_t)i * D * FF;
            gemm<0>(st, XN, D, in.gate + wo, FF, G, FF, S, FF, D);
            gemm<0>(st, XN, D, in.up + wo, FF, U, FF, S, FF, D);
            hipLaunchKernelGGL(k_swiglu, dim3(4096), dim3(256), 0, st, G, U, (size_t)S * FF / 4);
            fast(base);
            cmp<1, 0>(c, idb + (half ? 13 : 1), HFFf, cfg::PF, G, FF, S, FF);
            gemm<1>(st, G, FF, in.down + wo, D, Ho, D, S, D, FF, hin, 0.5f);
            hin = Ho;
            fast(base + 1);
            cmp<1, 0>(c, idb + (half ? 15 : 5), HBf, cfg::PD, Ho, D, S, D);
            if (half == 1) break;
            hipLaunchKernelGGL(k_rmsnorm, dim3(S / 4), dim3(256), 0, st, Ho, in.norms + (size_t)(l * 3 + 1) * D, XN, S, D);
            gemm<0>(st, XN, D, in.w_in + (size_t)l * D * D, D, A, D, S, D, D);
            fast(base + 2);
            if (l >= NA) hipLaunchKernelGGL(k_rope, dim3(S * NQH * 32 / 256), dim3(256), 0, st, A, D, NQH, in.pos);
            if (l < NA) cmp<1, 0>(c, idb + 6, AQf, cfg::PD, A, D, S, MIX, 1.f);
            if (l < NA) {
                hipLaunchKernelGGL(k_pool_diff, dim3(S * MIX / 256), dim3(256), 0, st, A, D, DIFF);
                for (int g = 0; g < 4; ++g) gemm<2>(st, DIFF + g * CG, MIX, in.pool_w + (size_t)(l * 4 + g) * CG * CG, CG, Yo + g * CG, D, S, CG, CG, nullptr, 1.f, in.pool_scale + (size_t)l * MIX + g * CG);
                fast(base + 3);
            } else {
                hipLaunchKernelGGL(k_swa, dim3(S * NQH / 4), dim3(256), 0, st, A, D, KV, 384, in.sinks + (size_t)(l - NA) * NQH, Yo, D);
            }
            gemm<0>(st, MEMN, D, in.w_mem_kv + (size_t)l * D * 1024, 1024, MKV, 1024, ML, 1024, D);
            hipLaunchKernelGGL(k_memattn, dim3(S * MH / 4), dim3(256), 0, st, A, D, MKV, Yo, D);
            fast(base + 4);
            cmp<1, 0>(c, idb + 10, Yf, cfg::PD, Yo, D, S, MIX);
            cmp<1, 0>(c, idb + 11, Yf + MIX, cfg::PD, Yo + MIX, D, S, 512);
            gemm<1>(st, Yo, D, in.w_out + (size_t)l * D * D, D, Ho, D, S, D, D, Ho, 1.0f);
            fast(base + 5);
        }
        if (l == NA - 1) {
            hipLaunchKernelGGL(k_rmsnorm, dim3(S / 4), dim3(256), 0, st, Ho, in.kv_norm, XN, S, D);
            gemm<0>(st, XN, D, in.w_kv, 384, KV, 384, S, 384, D);
            hipLaunchKernelGGL(k_rope, dim3(S * NKVH * 32 / 256), dim3(256), 0, st, KV, 384, NKVH, in.pos);
        }
    }
    hipLaunchKernelGGL(k_rmsnorm, dim3(S / 4), dim3(256), 0, st, Ho, in.final_norm, XN, S, D);
    fast(65);
    cmp<0, 0>(c, 90, d_out, D, XN, D, S, D);
    hipLaunchKernelGGL(k_report, dim3(1), dim3(1024), 0, st, res, 100, 0.05f, (float*)d_out);
}
}
#endif

extern "C" void kernel_launch(void* const* d_in, const int* in_sizes, int n_in, void* d_out, int out_size, void* d_ws, size_t ws_size, hipStream_t stream) {
    const size_t need = DBG ? WS_END + (size_t)495 * MiB : WS_END;
    if (n_in != 17 || out_size != cfg::S * cfg::D || ws_size < need) { fprintf(stderr, "kernel_launch: unexpected shapes n_in %d out %d ws %zu (need %zu)\n", n_in, out_size, ws_size, need); return; }
    if (!setup_grid()) return;
#if EXPT == 3
    (void)hipMemsetAsync((char*)d_ws + WS_END, 0, 2 * MiB, stream);
#endif
    if (hipMemsetAsync((char*)d_ws + WS_CTL, 0, CTL_ZERO_BYTES, stream) != hipSuccess) { fprintf(stderr, "kernel_launch: hipMemsetAsync failed\n"); return; }
#if DBG
    ref::In in;
    in.x = (const float*)d_in[0]; in.mem = (const float*)d_in[1]; in.pos = (const int*)d_in[2]; in.norms = (const float*)d_in[3];
    in.gate = (const float*)d_in[4]; in.up = (const float*)d_in[5]; in.down = (const float*)d_in[6]; in.w_in = (const float*)d_in[7]; in.w_out = (const float*)d_in[8];
    in.pool_w = (const float*)d_in[9]; in.pool_scale = (const float*)d_in[10]; in.w_kv = (const float*)d_in[11]; in.kv_norm = (const float*)d_in[12]; in.sinks = (const float*)d_in[13];
    in.w_mem_kv = (const float*)d_in[14]; in.mem_norm = (const float*)d_in[15]; in.final_norm = (const float*)d_in[16];
    dbg::run(stream, d_in, d_out, d_ws, in);
#elif defined(SPLIT_PHASES)
    for (int k = 0; k < PH_END; ++k) if (phase_exists(k)) launch_phases(stream, d_in, d_out, d_ws, k, k + 1);
#else
    launch_phases(stream, d_in, d_out, d_ws, 0, PH_END);
#endif
}
```

```cpp
#include <hip/hip_runtime.h>
#include <cstdio>
#include <cstdint>
#ifndef DBG
#define DBG 0
#endif
#ifndef PHMASK
#define PHMASK 0xFFFF
#endif
#define PHON(b) ((PHMASK >> (b)) & 1)
#ifndef REPMASK
#define REPMASK 0
#endif
#define NREP(c) (((REPMASK >> (c)) & 1) ? 2 : 1)
#ifndef EXPT
#define EXPT 0
#endif
#ifndef MIXEXP
#define MIXEXP 0
#endif
#ifndef HALFTAIL
#define HALFTAIL 0
#endif
#ifndef WT_STORES
#define WT_STORES 0
#endif
#ifndef CONV_NT
#define CONV_NT 0
#endif
#ifndef H_NT
#define H_NT 0
#endif
#ifndef GEMM_SP2
#define GEMM_SP2 true
#endif
#ifndef EARLY_WB
#define EARLY_WB 0
#endif
#ifndef LOOP_ALIGN
#define LOOP_ALIGN 0
#endif
#ifndef L2WARM
#define L2WARM 0
#endif
#ifndef BAL_DMA
#define BAL_DMA 1
#endif
#ifndef FUSE_SWA_MIX
#define FUSE_SWA_MIX 1
#endif
#ifndef GROUP_BAR
#define GROUP_BAR 1
#endif
#ifndef OWN_KV
#define OWN_KV 1
#endif
#ifndef OWN_POOLMIX
#define OWN_POOLMIX 1
#endif
#ifndef OWN_FINAL
#define OWN_FINAL 0
#endif
#ifndef B_NT_AUX
#define B_NT_AUX 0
#endif
#ifndef EARLY_ACQ
#define EARLY_ACQ 0
#endif
#ifndef SPLITK_TAIL
#define SPLITK_TAIL 0
#endif
#ifndef LDS_KV
#define LDS_KV 1
#endif
#ifndef ONEPASS_LDS
#define ONEPASS_LDS 0
#endif
#ifndef MMA_ORDER
#define MMA_ORDER 0
#endif
#ifndef CONV_REVERSE
#define CONV_REVERSE 1
#endif
#ifndef KSTAGGER
#define KSTAGGER 0
#endif
#ifndef MMA_SETPRIO
#define MMA_SETPRIO 1
#endif
#ifndef MMA_PRIO
#define MMA_PRIO 1
#endif
#ifndef DMA_SPLIT35
#define DMA_SPLIT35 0
#endif
#ifndef STAGE_AFTER_L
#define STAGE_AFTER_L 0
#endif
#ifndef STAGGER_TICKS
#define STAGGER_TICKS 0
#endif
#ifndef RESID_BATCH
#define RESID_BATCH 4
#endif
#ifndef RSTD_LDS
#define RSTD_LDS 0
#endif
#ifndef POOL_FOLD
#define POOL_FOLD 1
#endif
#ifndef STAGE_FIRST
#define STAGE_FIRST 0
#endif
#ifndef PROBE
#define PROBE 0
#endif
#ifndef PROBE_SA
#define PROBE_SA 64.0f
#endif
#ifndef PROBE_SB
#define PROBE_SB 640.0f
#endif
#ifndef PROBE_C
#define PROBE_C 2
#endif
#ifndef PROBE_Q
#define PROBE_Q -1
#endif
#ifndef PROBE_A
#define PROBE_A 1
#endif
#ifndef PROBE_B
#define PROBE_B 2
#endif
#if DBG
namespace ref {
constexpr int S = 8192, D = 2048, FF = 5632, DEPTH = 4, NA = 2, MIX = 1536, MEMW = 512, CG = 384, NQH = 24, NKVH = 3, HD = 64, WIN = 128, ML = 256, MH = 4, MHD = 128;
constexpr float EPS = 1e-5f;
typedef float f32x16 __attribute__((ext_vector_type(16)));

__device__ __forceinline__ float wave_sum(float v) {
#pragma unroll
    for (int o = 1; o < 64; o <<= 1) v += __shfl_xor(v, o);
    return v;
}
__device__ __forceinline__ float wave_max(float v) {
#pragma unroll
    for (int o = 1; o < 64; o <<= 1) v = fmaxf(v, __shfl_xor(v, o));
    return v;
}

__global__ void __launch_bounds__(256) k_rmsnorm(const float* __restrict__ x, const float* __restrict__ g, float* __restrict__ out, int nrows, int ncols) {
    const int row = blockIdx.x * 4 + (threadIdx.x >> 6), lane = threadIdx.x & 63;
    if (row >= nrows) return;
    const float* xr = x + (size_t)row * ncols; float* o = out + (size_t)row * ncols;
    float s = 0.f;
    for (int c = lane * 4; c < ncols; c += 256) { const float4 v = *(const float4*)(xr + c); s += v.x * v.x + v.y * v.y + v.z * v.z + v.w * v.w; }
    s = wave_sum(s);
    const float r = rsqrtf(s / (float)ncols + EPS);
    for (int c = lane * 4; c < ncols; c += 256) { const float4 v = *(const float4*)(xr + c); const float4 gg = *(const float4*)(g + c);
        float4 w; w.x = v.x * r * gg.x; w.y = v.y * r * gg.y; w.z = v.z * r * gg.z; w.w = v.w * r * gg.w; *(float4*)(o + c) = w; }
}

template <int EPI>
__global__ void __launch_bounds__(256) k_gemm(const float* __restrict__ A, int lda, const float* __restrict__ B, int ldb, float* C, int ldc, int K,
                                              const float* R, float alpha, const float* __restrict__ colscale) {
    __shared__ float As[16][132];
    __shared__ float Bs[16][132];
    const int t = threadIdx.x, lane = t & 63, w = t >> 6, wm = w >> 1, wn = w & 1, r32 = lane & 31, hi = lane >> 5;
    const int m0 = blockIdx.y * 128, n0 = blockIdx.x * 128;
    f32x16 acc[2][2];
#pragma unroll
    for (int i = 0; i < 2; ++i)
#pragma unroll
        for (int j = 0; j < 2; ++j)
#pragma unroll
            for (int r = 0; r < 16; ++r) acc[i][j][r] = 0.f;
    for (int k0 = 0; k0 < K; k0 += 16) {
#pragma unroll
        for (int i = 0; i < 2; ++i) {
            const int row = (t >> 2) + 64 * i, kq = (t & 3) * 4;
            const float4 a = *(const float4*)(A + (size_t)(m0 + row) * lda + k0 + kq);
            As[kq + 0][row] = a.x; As[kq + 1][row] = a.y; As[kq + 2][row] = a.z; As[kq + 3][row] = a.w;
            const int kr = (t >> 5) + 8 * i, nq = (t & 31) * 4;
            const float4 b = *(const float4*)(B + (size_t)(k0 + kr) * ldb + n0 + nq);
            *(float4*)&Bs[kr][nq] = b;
        }
        __syncthreads();
#pragma unroll
        for (int kk = 0; kk < 16; kk += 2) {
            float a[2], b[2];
#pragma unroll
            for (int i = 0; i < 2; ++i) { a[i] = As[kk + hi][wm * 64 + i * 32 + r32]; b[i] = Bs[kk + hi][wn * 64 + i * 32 + r32]; }
#pragma unroll
            for (int i = 0; i < 2; ++i)
#pragma unroll
                for (int j = 0; j < 2; ++j) acc[i][j] = __builtin_amdgcn_mfma_f32_32x32x2f32(a[i], b[j], acc[i][j], 0, 0, 0);
        }
        __syncthreads();
    }
#pragma unroll
    for (int i = 0; i < 2; ++i)
#pragma unroll
        for (int j = 0; j < 2; ++j)
#pragma unroll
            for (int r = 0; r < 16; ++r) {
                const int row = m0 + wm * 64 + i * 32 + (r & 3) + 8 * (r >> 2) + 4 * hi, col = n0 + wn * 64 + j * 32 + r32;
                const size_t o = (size_t)row * ldc + col; float v = acc[i][j][r];
                if (EPI == 1) v = R[o] + alpha * v;
                if (EPI == 2) v = v * colscale[col];
                C[o] = v;
            }
}

__global__ void __launch_bounds__(256) k_swiglu(float* g, const float* __restrict__ u, size_t n4) {
    size_t i = (size_t)blockIdx.x * 256 + threadIdx.x;
    const size_t stride = (size_t)gridDim.x * 256;
    for (; i < n4; i += stride) { float4 a = ((float4*)g)[i]; const float4 b = ((const float4*)u)[i];
        a.x = a.x / (1.f + expf(-a.x)) * b.x; a.y = a.y / (1.f + expf(-a.y)) * b.y; a.z = a.z / (1.f + expf(-a.z)) * b.z; a.w = a.w / (1.f + expf(-a.w)) * b.w; ((float4*)g)[i] = a; }
}

__global__ void __launch_bounds__(256) k_pool_diff(const float* __restrict__ a, int lda, float* __restrict__ diff) {
    const int idx = blockIdx.x * 256 + threadIdx.x;
    const int t = idx / MIX, c = idx % MIX, g = c / CG; const int w = 2 << g;
    float s = 0.f; const int j0 = (t - w + 1) < 0 ? 0 : (t - w + 1);
    for (int j = j0; j <= t; ++j) s += a[(size_t)j * lda + c];
    const float cnt = (float)(t + 1 < w ? t + 1 : w);
    diff[(size_t)t * MIX + c] = s / cnt - a[(size_t)t * lda + c];
}

__global__ void __launch_bounds__(256) k_rope(float* x, int ld, int nh, const int* __restrict__ pos) {
    const int idx = blockIdx.x * 256 + threadIdx.x;
    const int i = idx & 31, h = (idx >> 5) % nh, t = (idx >> 5) / nh;
    if (t >= S) return;
    const float inv_freq = 1.0f / powf(10000.0f, (float)i * (2.0f / 64.0f));
    const float ang = (float)pos[t] * inv_freq; float sn, cs; sincosf(ang, &sn, &cs);
    float* p = x + (size_t)t * ld + h * 64;
    const float x1 = p[i], x2 = p[i + 32];
    p[i] = x1 * cs - x2 * sn; p[i + 32] = x2 * cs + x1 * sn;
}

__global__ void __launch_bounds__(256) k_swa(const float* __restrict__ q, int ldq, const float* __restrict__ kv, int ldkv, const float* __restrict__ sinks, float* __restrict__ y, int ldo) {
    __shared__ float ps[4][128];
    const int wv = threadIdx.x >> 6, lane = threadIdx.x & 63;
    const int item = blockIdx.x * 4 + wv; const int t = item / NQH, hq = item % NQH, kh = hq / 8;
    const float* qp = q + (size_t)t * ldq + hq * 64;
    float sc[2];
#pragma unroll
    for (int e = 0; e < 2; ++e) {
        const int j = t - 127 + lane + 64 * e;
        float s = -INFINITY;
        if (j >= 0 && j <= t) { const float* kp = kv + (size_t)j * ldkv + kh * 64; float d = 0.f; for (int c = 0; c < 64; ++c) d += qp[c] * kp[c]; s = d * 0.125f; }
        sc[e] = s;
    }
    const float sink = sinks[hq];
    const float m = fmaxf(wave_max(fmaxf(sc[0], sc[1])), sink);
    const float p0 = expf(sc[0] - m), p1 = expf(sc[1] - m);
    const float den = wave_sum(p0 + p1) + expf(sink - m);
    ps[wv][lane] = p0 / den; ps[wv][lane + 64] = p1 / den;
    __syncthreads();
    float o = 0.f;
    for (int jj = 0; jj < 128; ++jj) { const int j = t - 127 + jj; if (j < 0) continue; o += ps[wv][jj] * kv[(size_t)j * ldkv + 192 + kh * 64 + lane]; }
    y[(size_t)t * ldo + hq * 64 + lane] = o;
}

__global__ void __launch_bounds__(256) k_memattn(const float* __restrict__ a, int ldq, const float* __restrict__ mkv, float* __restrict__ y, int ldo) {
    __shared__ float ps[4][256];
    const int wv = threadIdx.x >> 6, lane = threadIdx.x & 63;
    const int item = blockIdx.x * 4 + wv; const int t = item / MH, h = item % MH;
    const float* qp = a + (size_t)t * ldq + MIX + h * MHD;
    float sc[4]; float mx = -INFINITY;
#pragma unroll
    for (int e = 0; e < 4; ++e) { const int j = lane + 64 * e; const float* kp = mkv + (size_t)j * 1024 + h * MHD; float d = 0.f; for (int c = 0; c < MHD; ++c) d += qp[c] * kp[c];
        sc[e] = d * 0.08838834764831845f; mx = fmaxf(mx, sc[e]); }
    mx = wave_max(mx); float sum = 0.f;
#pragma unroll
    for (int e = 0; e < 4; ++e) { sc[e] = expf(sc[e] - mx); sum += sc[e]; }
    sum = wave_sum(sum);
#pragma unroll
    for (int e = 0; e < 4; ++e) ps[wv][lane + 64 * e] = sc[e] / sum;
    __syncthreads();
    float o0 = 0.f, o1 = 0.f;
    for (int j = 0; j < ML; ++j) { const float p = ps[wv][j]; const float* vp = mkv + (size_t)j * 1024 + 512 + h * MHD; o0 += p * vp[lane]; o1 += p * vp[lane + 64]; }
    float* op = y + (size_t)t * ldo + MIX + h * MHD; op[lane] = o0; op[lane + 64] = o1;
}

template <int EPI>
static void gemm(hipStream_t st, const float* A, int lda, const float* B, int ldb, float* C, int ldc, int M, int N, int K, const float* R = nullptr, float alpha = 1.f, const float* cs = nullptr) {
    hipLaunchKernelGGL(k_gemm<EPI>, dim3(N / 128, M / 128), dim3(256), 0, st, A, lda, B, ldb, C, ldc, K, R, alpha, cs);
}

struct In { const float *x, *mem; const int* pos; const float *norms, *gate, *up, *down, *w_in, *w_out, *pool_w, *pool_scale, *w_kv, *kv_norm, *sinks, *w_mem_kv, *mem_norm, *final_norm; };

static void forward(hipStream_t st, const In& in, float* out, float* ws) {
    float* H = ws; float* XN = H + (size_t)S * D; float* G = XN + (size_t)S * D; float* U = G + (size_t)S * FF; float* A = U + (size_t)S * FF; float* Y = A + (size_t)S * D;
    float* DIFF = Y + (size_t)S * D; float* KV = DIFF + (size_t)S * MIX; float* MEMN = KV + (size_t)S * 384; float* MKV = MEMN + (size_t)ML * D;
    hipLaunchKernelGGL(k_rmsnorm, dim3(ML / 4), dim3(256), 0, st, in.mem, in.mem_norm, MEMN, ML, D);
    const float* hin = in.x;
    for (int l = 0; l < DEPTH; ++l) {
        for (int half = 0; half < 2; ++half) {
            if (half == 1) {
                hipLaunchKernelGGL(k_rmsnorm, dim3(S / 4), dim3(256), 0, st, hin, in.norms + (size_t)(l * 3 + 1) * D, XN, S, D);
                gemm<0>(st, XN, D, in.w_in + (size_t)l * D * D, D, A, D, S, D, D);
                if (l < NA) {
                    hipLaunchKernelGGL(k_pool_diff, dim3(S * MIX / 256), dim3(256), 0, st, A, D, DIFF);
                    for (int g = 0; g < 4; ++g)
                        gemm<2>(st, DIFF + g * CG, MIX, in.pool_w + (size_t)(l * 4 + g) * CG * CG, CG, Y + g * CG, D, S, CG, CG, nullptr, 1.f, in.pool_scale + (size_t)l * MIX + g * CG - 0);
                } else {
                    hipLaunchKernelGGL(k_rope, dim3(S * NQH * 32 / 256), dim3(256), 0, st, A, D, NQH, in.pos);
                    hipLaunchKernelGGL(k_swa, dim3(S * NQH / 4), dim3(256), 0, st, A, D, KV, 384, in.sinks + (size_t)(l - NA) * NQH, Y, D);
                }
                gemm<0>(st, MEMN, D, in.w_mem_kv + (size_t)l * D * 1024, 1024, MKV, 1024, ML, 1024, D);
                hipLaunchKernelGGL(k_memattn, dim3(S * MH / 4), dim3(256), 0, st, A, D, MKV, Y, D);
                gemm<1>(st, Y, D, in.w_out + (size_t)l * D * D, D, H, D, S, D, D, hin, 1.0f);
                hin = H;
            }
            hipLaunchKernelGGL(k_rmsnorm, dim3(S / 4), dim3(256), 0, st, hin, in.norms + (size_t)(l * 3 + (half ? 2 : 0)) * D, XN, S, D);
            const size_t wo = (size_t)(l * 2 + half) * D * FF;
            gemm<0>(st, XN, D, in.gate + wo, FF, G, FF, S, FF, D);
            gemm<0>(st, XN, D, in.up + wo, FF, U, FF, S, FF, D);
            hipLaunchKernelGGL(k_swiglu, dim3(4096), dim3(256), 0, st, G, U, (size_t)S * FF / 4);
            gemm<1>(st, G, FF, in.down + wo, D, H, D, S, D, FF, hin, 0.5f);
            hin = H;
        }
        if (l == NA - 1) {
            hipLaunchKernelGGL(k_rmsnorm, dim3(S / 4), dim3(256), 0, st, H, in.kv_norm, XN, S, D);
            gemm<0>(st, XN, D, in.w_kv, 384, KV, 384, S, 384, D);
            hipLaunchKernelGGL(k_rope, dim3(S * NKVH * 32 / 256), dim3(256), 0, st, KV, 384, NKVH, in.pos);
        }
    }
    hipLaunchKernelGGL(k_rmsnorm, dim3(S / 4), dim3(256), 0, st, H, in.final_norm, out, S, D);
}
constexpr size_t WS_FLOATS = (size_t)S * D * 4 + (size_t)S * FF * 2 + (size_t)S * MIX + (size_t)S * 384 + (size_t)ML * D + (size_t)ML * 1024;
}
#endif
namespace cfg {
constexpr int S = 8192, D = 2048, FF = 5632, MIX = 1536, NQH = 24, ML = 256;
constexpr int NGU = 2 * FF, NGU_PAD = NGU + 512;
#ifndef PITCH_PAD
#define PITCH_PAD 0
#endif
constexpr int PD = D + PITCH_PAD, PF = FF + PITCH_PAD;
constexpr float EPS = 1e-5f, LOG2E = 1.4426950408889634f;
constexpr float QSCALE = 0.125f * LOG2E;
constexpr float QMSCALE = 0.08838834764831845f * LOG2E;
}
namespace pg8 {
#define PG8_LAS __attribute__((address_space(3)))
typedef unsigned short bf16_t;
typedef short bf16x8 __attribute__((ext_vector_type(8)));
typedef float f32x4 __attribute__((ext_vector_type(4)));
typedef unsigned u32x4 __attribute__((ext_vector_type(4)));
typedef unsigned u32x2 __attribute__((ext_vector_type(2)));
constexpr int BM = 256, BK = 64, HALF = 128, HTB = HALF * BK * 2  , STAGE_BYTES = 8 * HTB, NXCD = 8, WGM = 4;

__host__ __device__ __forceinline__ int lds_byte(int r, int c) { const int st = (r >> 4) * 2 + (c >> 5), rr = r & 15, cc = c & 31, ob = rr * 64 + cc * 2; return st * 1024 + (ob ^ (((ob >> 9) & 1) << 5)); }
__host__ __device__ __forceinline__ void stage_rc(int b, int& R, int& C) { const int st = b / 1024, sb = b % 1024, swz = sb ^ (((sb >> 9) & 1) << 5); R = (st >> 1) * 16 + swz / 64; C = (st & 1) * 32 + (swz % 64) / 2; }
__host__ __device__ __forceinline__ int perm32(int rho) { const int n = rho >> 4, i = rho & 15; return 8 * (i >> 2) + 4 * n + (i & 3); }

struct Unit { int pm, pn, ka, hf; };
struct Gemm { const bf16_t* A; const bf16_t* Bt; int lda, ldb, K; int kt0 = 0; };

struct StaticOrder {
    int nM, nN, nwg, G, c, flat, halftail, maxr, r0;
    __host__ __device__ __forceinline__ void init(int M, int N, int G_, int c_) { nM = M / BM; nN = N / BM; nwg = nM * nN; G = G_; c = c_; flat = 0; halftail = 0; maxr = 1 << 30; r0 = 0; }
    __host__ __device__ __forceinline__ bool next(int i, Unit& u) const {
        u.hf = 0;
        if (i >= maxr) return false;
        i += r0;
        long L = (long)i * G + c;
        if (halftail && (long)(i + 1) * G > nwg) { if ((long)i * G >= nwg) return false; const int hc = c % (G / 2); L = (long)i * G + hc; u.hf = 1 + (c >= G / 2); }
        if (L >= nwg) return false;
        int wgid = (int)L; { const int q = nwg / NXCD, r = nwg % NXCD, xcd = wgid % NXCD, off = wgid / NXCD; wgid = (xcd < r ? xcd * (q + 1) : r * (q + 1) + (xcd - r) * q) + off; }
        const int nig = WGM * nN, gid = wgid / nig, fm = gid * WGM, gsz = (nM - fm) < WGM ? (nM - fm) : WGM;
        u.pm = fm + ((wgid % nig) % gsz); u.pn = (wgid % nig) / gsz; u.ka = 0; if (flat) { u.pm = 0; u.pn = 0; } return true;
    }
    __device__ __forceinline__ void a_ready(const Unit&) const {}
    __device__ __forceinline__ void done(const Unit&) const {}
};
struct PoolOrder : StaticOrder {
    __host__ __device__ __forceinline__ bool next(int i, Unit& u) const { if (!StaticOrder::next(i, u)) return false; u.ka = (u.pn >> 1) * 384; return true; }
};
struct SubsetPoolOrder {
    int c0, n, nN, c;
    __host__ __device__ __forceinline__ bool next(int i, Unit& u) const { const int k = c - c0; if (i != 0 || k < 0 || k >= n) return false; u.pm = k / nN; u.pn = k % nN; u.ka = (u.pn >> 1) * 384; u.hf = 0; return true; }
    __device__ __forceinline__ void a_ready(const Unit&) const {}
    __device__ __forceinline__ void done(const Unit&) const {}
};
struct SubsetOrder {
    int c0, n, nN, c;
    __host__ __device__ __forceinline__ bool next(int i, Unit& u) const { const int k = c - c0; if (i != 0 || k < 0 || k >= n) return false; u.pm = k / nN; u.pn = k % nN; u.ka = 0; u.hf = 0; return true; }
    __device__ __forceinline__ void a_ready(const Unit&) const {}
    __device__ __forceinline__ void done(const Unit&) const {}
};

struct OneUnitOrder {
    int pm, pn;
    __host__ __device__ __forceinline__ bool next(int i, Unit& u) const { if (i != 0) return false; u.pm = pm; u.pn = pn; u.ka = 0; u.hf = 0; return true; }
    __device__ __forceinline__ void a_ready(const Unit&) const {}
    __device__ __forceinline__ void done(const Unit&) const {}
};
typedef float f32x2_t __attribute__((ext_vector_type(2))); typedef __bf16 bf16x2_t __attribute__((ext_vector_type(2)));
__device__ __forceinline__ unsigned pkbf(float lo, float hi) { f32x2_t v = {lo, hi}; bf16x2_t b = __builtin_convertvector(v, bf16x2_t); return __builtin_bit_cast(unsigned, b); }
__device__ __forceinline__ float rstd_of(const float* ssq, int row) {
    const f32x4 a = *(const f32x4*)(ssq + (size_t)row * 8), b = *(const f32x4*)(ssq + (size_t)row * 8 + 4);
    return __builtin_amdgcn_rsqf((((a[0] + a[1]) + (a[2] + a[3])) + ((b[0] + b[1]) + (b[2] + b[3]))) * (1.0f / 2048.0f) + cfg::EPS);
}
__device__ __forceinline__ void rstd8(const float* ssq, int rowbase  , int fr, int fq, float (&rs)[2][4]) {
    float loc[2];
#pragma unroll
    for (int k = 0; k < 2; ++k) loc[k] = rstd_of(ssq, rowbase + (fq >> 1) * HALF + (2 * (fq & 1) + k) * 16);
#pragma unroll
    for (int ai = 0; ai < 2; ++ai)
#pragma unroll
        for (int m = 0; m < 4; ++m) rs[ai][m] = __shfl(loc[m & 1], fr + 16 * (ai * 2 + (m >> 1)));
}
struct EpiSwiGLU {
    static constexpr bool PERM = true, AFTER_DRAIN = false;
    bf16_t* O; const float* ssq; int nostore; const PG8_LAS float* rtab = nullptr; int rtab_pm = -1;
    __device__ __forceinline__ void operator()(const f32x4 (&acc)[2][2][4][2], const Unit& u, int wr, int wc, int fr, int fq) const {
        if (nostore) return;
        const int row0 = u.pm * BM + wr * 64 + fr, col0 = u.pn * 128 + wc * 32 + 8 * fq;
        float rs8[2][4];
        if (RSTD_LDS && u.pm == rtab_pm) {
#pragma unroll
            for (int ai = 0; ai < 2; ++ai)
#pragma unroll
                for (int m = 0; m < 4; ++m) rs8[ai][m] = rtab[ai * HALF + wr * 64 + m * 16 + fr]; }
        else rstd8(ssq, row0, fr, fq, rs8);
        const __amdgpu_buffer_rsrc_t rs_o = __builtin_amdgcn_make_buffer_rsrc((void*)O, (short)0, (int)((size_t)cfg::S * cfg::PF * 2), 0x00020000);
#pragma unroll
        for (int ai = 0; ai < 2; ++ai) { if (u.hf == 2 - ai) continue;
#pragma unroll
            for (int m = 0; m < 4; ++m) { const int row = row0 + ai * HALF + m * 16; const float rs = rs8[ai][m];
                const float rsl = -cfg::LOG2E * rs, irs2 = __builtin_amdgcn_rcpf(rs * rs);
                float o[8];
#pragma unroll
                for (int n = 0; n < 2; ++n)
#pragma unroll
                    for (int e = 0; e < 4; ++e) { const float ag = acc[ai][0][m][n][e], au = acc[ai][1][m][n][e];
                        o[4 * n + e] = (ag * au) * __builtin_amdgcn_rcpf(__builtin_fmaf(__builtin_amdgcn_exp2f(ag * rsl), irs2, irs2)); }
                u32x4 w; w.x = pkbf(o[0], o[1]); w.y = pkbf(o[2], o[3]); w.z = pkbf(o[4], o[5]); w.w = pkbf(o[6], o[7]);
                if (WT_STORES) __builtin_amdgcn_raw_buffer_store_b128(w, rs_o, (int)(((size_t)row * cfg::PF + col0) * 2), 0, 16); else *(u32x4*)(O + (size_t)row * cfg::PF + col0) = w; } }
    }
};
struct EpiSwiGLUSplit {
    static constexpr bool PERM = true, AFTER_DRAIN = true;
    bf16_t* O; const float* ssq; float* slab; unsigned* ctr; unsigned* tmo; unsigned epoch; int role; int same_xcd;
    __device__ __forceinline__ void fused(f32x4 (&acc)[2][2][4][2], const Unit& u, int wr, int wc, int fr, int fq, PG8_LAS unsigned char* lds, int wid, int lane) const {
        const int tid = wid * 64 + lane;
        f32x4* sl = (f32x4*)slab + tid;
        if (role == 1) {
#pragma unroll
            for (int ai = 0; ai < 2; ++ai)
#pragma unroll
                for (int bj = 0; bj < 2; ++bj)
#pragma unroll
                    for (int m = 0; m < 4; ++m)
#pragma unroll
                        for (int n = 0; n < 2; ++n) sl[(size_t)((((ai * 2 + bj) * 4 + m) * 2 + n)) * 512] = acc[ai][bj][m][n];
            asm volatile("s_waitcnt vmcnt(0)" ::: "memory"); __builtin_amdgcn_s_barrier(); asm volatile("" ::: "memory");
            if (tid == 0) { if (!same_xcd) { __builtin_amdgcn_fence(__ATOMIC_RELEASE, "agent"); asm volatile("s_waitcnt vmcnt(0)" ::: "memory"); }
                (void)__hip_atomic_fetch_add(ctr, 1u, __ATOMIC_RELAXED, __HIP_MEMORY_SCOPE_AGENT); }
            return;
        }
        if (tid == 0) { unsigned sp = 0u;
            while (__hip_atomic_load(ctr, __ATOMIC_RELAXED, __HIP_MEMORY_SCOPE_AGENT) < epoch) { __builtin_amdgcn_s_sleep(1);
                if ((++sp & 255u) == 0u) { if (__hip_atomic_load(tmo, __ATOMIC_RELAXED, __HIP_MEMORY_SCOPE_AGENT)) break; if (sp > (1u << 18)) { atomicAdd(tmo, 1u); break; } } }
            __builtin_amdgcn_fence(__ATOMIC_ACQUIRE, "agent"); asm volatile("s_waitcnt vmcnt(0)" ::: "memory"); }
        asm volatile("s_waitcnt vmcnt(0) lgkmcnt(0)" ::: "memory"); __builtin_amdgcn_s_barrier(); asm volatile("" ::: "memory");
        const int row0 = u.pm * BM + wr * 64 + fr, col0 = u.pn * 128 + wc * 32 + 8 * fq;
        float rs8[2][4]; rstd8(ssq, row0, fr, fq, rs8);
#pragma unroll
        for (int ai = 0; ai < 2; ++ai)
#pragma unroll
            for (int m = 0; m < 4; ++m) { const int row = row0 + ai * HALF + m * 16; const float rs = rs8[ai][m];
                const float rsl = -cfg::LOG2E * rs, irs2 = __builtin_amdgcn_rcpf(rs * rs);
                f32x4 g[2], up[2];
#pragma unroll
                for (int n = 0; n < 2; ++n) { g[n] = acc[ai][0][m][n] + sl[(size_t)((((ai * 2 + 0) * 4 + m) * 2 + n)) * 512]; up[n] = acc[ai][1][m][n] + sl[(size_t)((((ai * 2 + 1) * 4 + m) * 2 + n)) * 512]; }
                float o[8];
#pragma unroll
                for (int n = 0; n < 2; ++n)
#pragma unroll
                    for (int e = 0; e < 4; ++e) o[4 * n + e] = (g[n][e] * up[n][e]) * __builtin_amdgcn_rcpf(__builtin_fmaf(__builtin_amdgcn_exp2f(g[n][e] * rsl), irs2, irs2));
                u32x4 w; w.x = pkbf(o[0], o[1]); w.y = pkbf(o[2], o[3]); w.z = pkbf(o[4], o[5]); w.w = pkbf(o[6], o[7]);
                *(u32x4*)(O + (size_t)row * cfg::PF + col0) = w; }
    }
};
struct EpiResid {
    static constexpr bool PERM = true, AFTER_DRAIN = true;
    const float* R32; bf16_t* HB; bf16_t* HL; float* ssq; float alpha; int nostore;
    __device__ __forceinline__ void fused(f32x4 (&acc)[2][2][4][2], const Unit& u, int wr, int wc, int fr, int fq, PG8_LAS unsigned char* lds, int wid, int lane) const {
        if (nostore) return;
        PG8_LAS float* P = (PG8_LAS float*)lds;
        const int col0 = u.pn * BM + wc * 32 + 8 * fq;
#if RESID_BATCH
        constexpr int NB = 16 / RESID_BATCH;
        u32x4 X[2][RESID_BATCH], Y[2][RESID_BATCH];
#define RS_OFF(it) ((size_t)(u.pm * BM + ((it) >> 3) * HALF + wr * 64 + (((it) >> 1) & 3) * 16 + fr))
#define RS_LOAD(buf, b) do { _Pragma("unroll") for (int j = 0; j < RESID_BATCH; ++j) { const int it = (b) * RESID_BATCH + j; \
            if (R32) { const float* px = R32 + RS_OFF(it) * cfg::D + col0 + (it & 1) * HALF; X[buf][j] = *(const u32x4*)px; Y[buf][j] = *(const u32x4*)(px + 4); } \
            else { const size_t o2 = RS_OFF(it) * cfg::PD + col0 + (it & 1) * HALF; X[buf][j] = *(const u32x4*)(HB + o2); Y[buf][j] = *(const u32x4*)(HL + o2); } } } while (0)
        RS_LOAD(0, 0);
        float s = 0.f;
#pragma unroll
        for (int b = 0; b < NB; ++b) {
            if (b + 1 < NB) RS_LOAD((b + 1) & 1, b + 1);
#pragma unroll
            for (int j = 0; j < RESID_BATCH; ++j) { const int it = b * RESID_BATCH + j, ai = it >> 3, m = (it >> 1) & 3, bj = it & 1; const int rl = ai * HALF + wr * 64 + m * 16 + fr;
                const size_t o2 = (size_t)(u.pm * BM + rl) * cfg::PD + col0 + bj * HALF; const u32x4 a = X[b & 1][j], bb = Y[b & 1][j]; f32x4 h0, h1;
                if (R32) { h0[0] = __uint_as_float(a.x); h0[1] = __uint_as_float(a.y); h0[2] = __uint_as_float(a.z); h0[3] = __uint_as_float(a.w);
                           h1[0] = __uint_as_float(bb.x); h1[1] = __uint_as_float(bb.y); h1[2] = __uint_as_float(bb.z); h1[3] = __uint_as_float(bb.w); }
                else { h0[0] = __uint_as_float(a.x << 16) + __uint_as_float(bb.x << 16); h0[1] = __uint_as_float(a.x & 0xffff0000u) + __uint_as_float(bb.x & 0xffff0000u);
                    h0[2] = __uint_as_float(a.y << 16) + __uint_as_float(bb.y << 16); h0[3] = __uint_as_float(a.y & 0xffff0000u) + __uint_as_float(bb.y & 0xffff0000u);
                    h1[0] = __uint_as_float(a.z << 16) + __uint_as_float(bb.z << 16); h1[1] = __uint_as_float(a.z & 0xffff0000u) + __uint_as_float(bb.z & 0xffff0000u);
                    h1[2] = __uint_as_float(a.w << 16) + __uint_as_float(bb.w << 16); h1[3] = __uint_as_float(a.w & 0xffff0000u) + __uint_as_float(bb.w & 0xffff0000u); }
                const f32x4 v0 = h0 + acc[ai][bj][m][0] * alpha, v1 = h1 + acc[ai][bj][m][1] * alpha;
                if (bj == 0) s = 0.f;
                s += ((v0[0] * v0[0] + v0[1] * v0[1]) + (v0[2] * v0[2] + v0[3] * v0[3])) + ((v1[0] * v1[0] + v1[1] * v1[1]) + (v1[2] * v1[2] + v1[3] * v1[3]));
                u32x4 w; w.x = pkbf(v0[0], v0[1]); w.y = pkbf(v0[2], v0[3]); w.z = pkbf(v1[0], v1[1]); w.w = pkbf(v1[2], v1[3]);
                u32x4 l; l.x = pkbf(v0[0] - __uint_as_float(w.x << 16), v0[1] - __uint_as_float(w.x & 0xffff0000u)); l.y = pkbf(v0[2] - __uint_as_float(w.y << 16), v0[3] - __uint_as_float(w.y & 0xffff0000u));
                l.z = pkbf(v1[0] - __uint_as_float(w.z << 16), v1[1] - __uint_as_float(w.z & 0xffff0000u)); l.w = pkbf(v1[2] - __uint_as_float(w.w << 16), v1[3] - __uint_as_float(w.w & 0xffff0000u));
                *(u32x4*)(HB + o2) = w; *(u32x4*)(HL + o2) = l;
                if (bj == 1) { float t_ = s; t_ += __shfl_xor(t_, 16); t_ += __shfl_xor(t_, 32); if (fq == 0) P[rl * 4 + wc] = t_; } }
        }
#undef RS_LOAD
#undef RS_OFF
#else
#pragma unroll
        for (int ai = 0; ai < 2; ++ai)
#pragma unroll
            for (int m = 0; m < 4; ++m) { const int rl = ai * HALF + wr * 64 + m * 16 + fr; const size_t off = (size_t)(u.pm * BM + rl) * cfg::PD + col0, offx = (size_t)(u.pm * BM + rl) * cfg::D + col0; float s = 0.f;
#pragma unroll
                for (int bj = 0; bj < 2; ++bj) { const size_t o2 = off + bj * HALF; f32x4 h0, h1;
                    if (R32) { h0 = *(const f32x4*)(R32 + offx + bj * HALF); h1 = *(const f32x4*)(R32 + offx + bj * HALF + 4); }
                    else { const u32x4 a = *(const u32x4*)(HB + o2), b = *(const u32x4*)(HL + o2);
                        h0[0] = __uint_as_float(a.x << 16) + __uint_as_float(b.x << 16); h0[1] = __uint_as_float(a.x & 0xffff0000u) + __uint_as_float(b.x & 0xffff0000u);
                        h0[2] = __uint_as_float(a.y << 16) + __uint_as_float(b.y << 16); h0[3] = __uint_as_float(a.y & 0xffff0000u) + __uint_as_float(b.y & 0xffff0000u);
                        h1[0] = __uint_as_float(a.z << 16) + __uint_as_float(b.z << 16); h1[1] = __uint_as_float(a.z & 0xffff0000u) + __uint_as_float(b.z & 0xffff0000u);
                        h1[2] = __uint_as_float(a.w << 16) + __uint_as_float(b.w << 16); h1[3] = __uint_as_float(a.w & 0xffff0000u) + __uint_as_float(b.w & 0xffff0000u); }
                    const f32x4 v0 = h0 + acc[ai][bj][m][0] * alpha, v1 = h1 + acc[ai][bj][m][1] * alpha;
                    s += ((v0[0] * v0[0] + v0[1] * v0[1]) + (v0[2] * v0[2] + v0[3] * v0[3])) + ((v1[0] * v1[0] + v1[1] * v1[1]) + (v1[2] * v1[2] + v1[3] * v1[3]));
                    u32x4 w; w.x = pkbf(v0[0], v0[1]); w.y = pkbf(v0[2], v0[3]); w.z = pkbf(v1[0], v1[1]); w.w = pkbf(v1[2], v1[3]);
                    u32x4 l; l.x = pkbf(v0[0] - __uint_as_float(w.x << 16), v0[1] - __uint_as_float(w.x & 0xffff0000u)); l.y = pkbf(v0[2] - __uint_as_float(w.y << 16), v0[3] - __uint_as_float(w.y & 0xffff0000u));
                    l.z = pkbf(v1[0] - __uint_as_float(w.z << 16), v1[1] - __uint_as_float(w.z & 0xffff0000u)); l.w = pkbf(v1[2] - __uint_as_float(w.w << 16), v1[3] - __uint_as_float(w.w & 0xffff0000u));
                    *(u32x4*)(HB + o2) = w; *(u32x4*)(HL + o2) = l; }
                s += __shfl_xor(s, 16); s += __shfl_xor(s, 32);
                if (fq == 0) P[rl * 4 + wc] = s; }
#endif
        asm volatile("s_waitcnt lgkmcnt(0)" ::: "memory"); __builtin_amdgcn_s_barrier(); asm volatile("" ::: "memory");
        const int t = wid * 64 + lane;
        if (t < 256) { const f32x4 p = *(const PG8_LAS f32x4*)(P + t * 4); ssq[(size_t)(u.pm * BM + t) * 8 + u.pn] = (p[0] + p[1]) + (p[2] + p[3]); }
    }
};
struct EpiWin {
    static constexpr bool PERM = true, AFTER_DRAIN = false;
    bf16_t* AQ; bf16_t* QMF; const float* ssq; const float* cs; const float* sn; int swa;
    __device__ __forceinline__ void operator()(const f32x4 (&acc)[2][2][4][2], const Unit& u, int wr, int wc, int fr, int fq) const {
        const int row0 = u.pm * BM + wr * 64 + fr;
        float rs8[2][4]; rstd8(ssq, row0, fr, fq, rs8);
#pragma unroll
        for (int ai = 0; ai < 2; ++ai) {
            f32x4 ropc[4], rops[4];
            if (swa && u.pn < 6) { const int dq = (((wc & 1) * 32 + 8 * fq) >> 3) * 4;
#pragma unroll
                for (int m = 0; m < 4; ++m) { const int row = row0 + ai * HALF + m * 16; ropc[m] = *(const f32x4*)(cs + (size_t)row * 32 + dq); rops[m] = *(const f32x4*)(sn + (size_t)row * 32 + dq); } }
            else {
#pragma unroll
                for (int m = 0; m < 4; ++m) { ropc[m] = (f32x4){0.f, 0.f, 0.f, 0.f}; rops[m] = ropc[m]; } }
            asm volatile("" ::: "memory");
#pragma unroll
            for (int m = 0; m < 4; ++m) { const int row = row0 + ai * HALF + m * 16; const float rs = rs8[ai][m]; const int qb = row >> 5, r32 = row & 31;
#pragma unroll
                for (int bj = 0; bj < 2; ++bj) { const int c0 = u.pn * BM + bj * HALF + wc * 32 + 8 * fq; f32x4 v0 = acc[ai][bj][m][0] * rs, v1 = acc[ai][bj][m][1] * rs;
                    if (u.pn >= 6) {
                        v0 = v0 * cfg::QMSCALE; v1 = v1 * cfg::QMSCALE; const int cm = c0 - 1536, h = cm >> 7, dm = cm & 127, j = dm >> 4, hi = (dm >> 3) & 1;
                        u32x4 w; w.x = pkbf(v0[0], v0[1]); w.y = pkbf(v0[2], v0[3]); w.z = pkbf(v1[0], v1[1]); w.w = pkbf(v1[2], v1[3]);
                        *(u32x4*)(QMF + ((size_t)(((h * 256 + qb) * 8 + j) * 64 + hi * 32 + r32)) * 8) = w; }
                    else if (!swa) { u32x4 w; w.x = pkbf(v0[0], v0[1]); w.y = pkbf(v0[2], v0[3]); w.z = pkbf(v1[0], v1[1]); w.w = pkbf(v1[2], v1[3]); *(u32x4*)(AQ + (size_t)row * cfg::PD + c0) = w; }
                    else { const int hq = c0 >> 6, jj = (c0 & 63) >> 3; const f32x4 c = ropc[m], sv = rops[m];
                        const f32x4 o1 = (v0 * c - v1 * sv) * cfg::QSCALE, o2 = (v1 * c + v0 * sv) * cfg::QSCALE;
                        u32x2 w1, w2; w1.x = pkbf(o1[0], o1[1]); w1.y = pkbf(o1[2], o1[3]); w2.x = pkbf(o2[0], o2[1]); w2.y = pkbf(o2[2], o2[3]);
                        bf16_t* qp = AQ + ((size_t)(((hq * 256 + qb) * 4 + (jj >> 2)) * 64 + ((jj >> 1) & 1) * 32 + r32)) * 8 + 4 * (jj & 1);
                        *(u32x2*)qp = w1; *(u32x2*)(qp + 2 * 512) = w2; } } } }
    }
};
struct EpiPool {
    static constexpr bool PERM = false, AFTER_DRAIN = false;
    float* Z;
    __device__ __forceinline__ void operator()(const f32x4 (&acc)[2][2][4][2], const Unit& u, int wr, int wc, int fr, int fq) const {
        const int row0 = u.pm * BM + wr * 64 + fr, g = u.pn >> 1;
#pragma unroll
        for (int ai = 0; ai < 2; ++ai)
#pragma unroll
            for (int m = 0; m < 4; ++m) { float* zp = Z + (size_t)(row0 + ai * HALF + m * 16) * cfg::MIX + g * 384;
#pragma unroll
                for (int bj = 0; bj < 2; ++bj) { if ((u.pn & 1) && bj) continue;
#pragma unroll
                    for (int n = 0; n < 2; ++n) *(f32x4*)(zp + (u.pn & 1) * 256 + bj * HALF + wc * 32 + n * 16 + 4 * fq) = acc[ai][bj][m][n]; } }
    }
};
struct EpiKV {
    static constexpr bool PERM = true, AFTER_DRAIN = false;
    bf16_t* KF; bf16_t* VF; const float* ssq; const float* cs; const float* sn;
    __device__ __forceinline__ void operator()(const f32x4 (&acc)[2][2][4][2], const Unit& u, int wr, int wc, int fr, int fq) const {
        const int row0 = u.pm * BM + wr * 64 + fr;
        float rs8[2][4]; rstd8(ssq, row0, fr, fq, rs8);
#pragma unroll
        for (int ai = 0; ai < 2; ++ai)
#pragma unroll
            for (int m = 0; m < 4; ++m) { const int row = row0 + ai * HALF + m * 16; const float rs = rs8[ai][m]; const int kt = row >> 5, r32 = row & 31;
#pragma unroll
                for (int bj = 0; bj < 2; ++bj) { const int cg = u.pn * BM + bj * HALF + wc * 32 + 8 * fq; if (cg >= 384) continue;
                    const f32x4 v0 = acc[ai][bj][m][0] * rs, v1 = acc[ai][bj][m][1] * rs;
                    if (cg < 192) { const int kvh = cg >> 6, jj = (cg & 63) >> 3, d = jj * 4; const f32x4 c = *(const f32x4*)(cs + (size_t)row * 32 + d), sv = *(const f32x4*)(sn + (size_t)row * 32 + d);
                        const f32x4 o1 = v0 * c - v1 * sv, o2 = v1 * c + v0 * sv;
                        u32x2 w1, w2; w1.x = pkbf(o1[0], o1[1]); w1.y = pkbf(o1[2], o1[3]); w2.x = pkbf(o2[0], o2[1]); w2.y = pkbf(o2[2], o2[3]);
                        bf16_t* kp = KF + ((size_t)(((kvh * 256 + kt) * 4 + (jj >> 2)) * 64 + ((jj >> 1) & 1) * 32 + r32)) * 8 + 4 * (jj & 1);
                        *(u32x2*)kp = w1; *(u32x2*)(kp + 2 * 512) = w2; }
                    else {
                        const int v = cg - 192, kvh = v >> 6, d = v & 63, k16 = r32 & 15, sk = r32 >> 4, hik = (k16 >> 2) & 1, jv = 4 * (k16 >> 3) + (k16 & 3);
                        bf16_t* vp = VF + ((size_t)((((kvh * 256 + kt) * 2 + (d >> 5)) * 2 + sk) * 64 + hik * 32 + (d & 31))) * 8 + jv;
#pragma unroll
                        for (int e = 0; e < 4; ++e) { vp[e * 8] = (bf16_t)(pkbf(v0[e], 0.f) & 0xffffu); vp[(4 + e) * 8] = (bf16_t)(pkbf(v1[e], 0.f) & 0xffffu); } } } }
    }
};
struct EpiFold {
    static constexpr bool PERM = true, AFTER_DRAIN = false;
    bf16_t* W2;
    __device__ __forceinline__ void operator()(const f32x4 (&acc)[2][2][4][2], const Unit& u, int wr, int wc, int fr, int fq) const {
        const int row0 = u.pm * BM + wr * 64 + fr, g = u.pn >> 1;
#pragma unroll
        for (int ai = 0; ai < 2; ++ai)
#pragma unroll
            for (int m = 0; m < 4; ++m) { const int row = row0 + ai * HALF + m * 16;
#pragma unroll
                for (int bj = 0; bj < 2; ++bj) { const int jp = (u.pn & 1) * BM + bj * HALF + wc * 32 + 8 * fq; if (jp >= 384) continue;
                    const f32x4 v0 = acc[ai][bj][m][0], v1 = acc[ai][bj][m][1];
                    u32x4 w; w.x = pkbf(v0[0], v0[1]); w.y = pkbf(v0[2], v0[3]); w.z = pkbf(v1[0], v1[1]); w.w = pkbf(v1[2], v1[3]);
                    *(u32x4*)(W2 + (size_t)row * cfg::PD + g * 384 + jp) = w; } }
    }
};
struct EpiMemKV {
    static constexpr bool PERM = true, AFTER_DRAIN = false;
    bf16_t* MKF; bf16_t* MVF;
    __device__ __forceinline__ void operator()(const f32x4 (&acc)[2][2][4][2], const Unit& u, int wr, int wc, int fr, int fq) const {
        const int row0 = wr * 64 + fr;
#pragma unroll
        for (int ai = 0; ai < 2; ++ai)
#pragma unroll
            for (int m = 0; m < 4; ++m) { const int row = row0 + ai * HALF + m * 16, kt = row >> 5, r32 = row & 31;
#pragma unroll
                for (int bj = 0; bj < 2; ++bj) { const int cg = u.pn * BM + bj * HALF + wc * 32 + 8 * fq, l = cg >> 10, w = cg & 1023;
                    const f32x4 v0 = acc[ai][bj][m][0], v1 = acc[ai][bj][m][1];
                    if (w < 512) { const int h = w >> 7, dm = w & 127; u32x4 q; q.x = pkbf(v0[0], v0[1]); q.y = pkbf(v0[2], v0[3]); q.z = pkbf(v1[0], v1[1]); q.w = pkbf(v1[2], v1[3]);
                        *(u32x4*)(MKF + ((size_t)(((((l * 4 + h) * 8 + kt) * 8 + (dm >> 4)) * 64) + ((dm >> 3) & 1) * 32 + r32)) * 8) = q; }
                    else { const int dv = w - 512, h = dv >> 7, d = dv & 127, k16 = r32 & 15, sk = r32 >> 4, hik = (k16 >> 2) & 1, jv = 4 * (k16 >> 3) + (k16 & 3);
                        bf16_t* vp = MVF + ((size_t)((((((l * 4 + h) * 8 + kt) * 4 + (d >> 5)) * 2 + sk) * 64) + hik * 32 + (d & 31))) * 8 + jv;
#pragma unroll
                        for (int e = 0; e < 4; ++e) { vp[e * 8] = (bf16_t)(pkbf(v0[e], 0.f) & 0xffffu); vp[(4 + e) * 8] = (bf16_t)(pkbf(v1[e], 0.f) & 0xffffu); } } } }
    }
};

template <class Epi, class Sched, bool ALIGN_EPI = false, bool SP2 = false, bool HM = false  , int DIAG = 0  >
__device__ __forceinline__ void gemm_phase(PG8_LAS unsigned char* lds, const Gemm g, const Sched& S, const Epi& E) {
    int tid_ = threadIdx.x; asm volatile("" : "+v"(tid_));
    const int tid = tid_, wid = __builtin_amdgcn_readfirstlane(tid >> 6), lane = tid & 63, wr = wid >> 2, wc = wid & 3, fr = lane & 15, fq = lane >> 4;
    int K_ = g.K; asm volatile("" : "+s"(K_));
    const int K = K_, nt = K / BK;
    int kt0_ = g.kt0; asm volatile("" : "+s"(kt0_));
    const int kt0 = kt0_;
#define PG8_KOFF(tt) ((size_t)(((tt) + kt0) >= nt ? ((tt) + kt0) - nt : ((tt) + kt0)) * kstep)
    unsigned voffA[2], voffB[2];
#pragma unroll
    for (int i = 0; i < 2; ++i) { int R, C; stage_rc(tid * 16 + i * 8192, R, C); const int Rb = Epi::PERM ? ((R & ~31) + perm32(R & 31)) : R;
        voffA[i] = (unsigned)(R * g.lda + C) * 2u; voffB[i] = (unsigned)(Rb * g.ldb + C) * 2u; }
    const size_t kstep = (size_t)(BK * 2);
    const size_t hstepA = (size_t)HALF * g.lda * 2, hstepB = (size_t)HALF * g.ldb * 2;
    const size_t tstepA = 2 * hstepA, tstepB = 2 * hstepB;
    const unsigned ldsw = (unsigned)wid * 1024u;
    const int aoff = lds_byte(wr * 64 + fr, fq * 8), boff = lds_byte(wc * 32 + fr, fq * 8);
#define PG8_SA(b, h) (((b) * 2 + (h)) * HTB)
#define PG8_SB(b, h) ((4 + (b) * 2 + (h)) * HTB)
#define PG8_STAGE(bufoff, gbase, voff) do { if (DIAG == 2) break; _Pragma("unroll") for (int _i = 0; _i < 2; ++_i) \
        __builtin_amdgcn_global_load_lds((const unsigned*)((const char*)(gbase) + (voff)[_i]), (PG8_LAS unsigned*)(lds + (bufoff) + ldsw + _i * 8192), 16, 0, ((const void*)(voff) == (const void*)voffB) ? B_NT_AUX : 0); } while (0)
#define PG8_STAGE1(bufoff, gbase, voff, _i) do { if (DIAG == 2) break; \
        __builtin_amdgcn_global_load_lds((const unsigned*)((const char*)(gbase) + (voff)[_i]), (PG8_LAS unsigned*)(lds + (bufoff) + ldsw + (_i) * 8192), 16, 0, 0); } while (0)
#define PG8_LDA(dst, b, h) do { _Pragma("unroll") for (int m = 0; m < 4; ++m) _Pragma("unroll") for (int k = 0; k < 2; ++k) dst[m][k] = *(const PG8_LAS bf16x8*)(lds + PG8_SA(b, h) + aoff + m * 2048 + k * 1024); } while (0)
#define PG8_LDB(dst, b, h) do { _Pragma("unroll") for (int n = 0; n < 2; ++n) _Pragma("unroll") for (int k = 0; k < 2; ++k) dst[n][k] = *(const PG8_LAS bf16x8*)(lds + PG8_SB(b, h) + boff + n * 2048 + k * 1024); } while (0)
#if MMA_ORDER == 1
#define PG8_MMA(ai, bj, At, Bt) do { if (DIAG == 1) break; if (MMA_SETPRIO) __builtin_amdgcn_s_setprio(MMA_PRIO); _Pragma("unroll") for (int k = 0; k < 2; ++k) _Pragma("unroll") for (int n = 0; n < 2; ++n) _Pragma("unroll") for (int m = 0; m < 4; ++m) \
        acc[ai][bj][m][n] = __builtin_amdgcn_mfma_f32_16x16x32_bf16(Bt[n][k], At[m][k], acc[ai][bj][m][n], 0, 0, 0); if (MMA_SETPRIO) __builtin_amdgcn_s_setprio(0); } while (0)
#elif MMA_ORDER == 2
#define PG8_MMA(ai, bj, At, Bt) do { if (DIAG == 1) break; if (MMA_SETPRIO) __builtin_amdgcn_s_setprio(MMA_PRIO); _Pragma("unroll") for (int k = 0; k < 2; ++k) _Pragma("unroll") for (int m = 0; m < 4; ++m) _Pragma("unroll") for (int n = 0; n < 2; ++n) \
        acc[ai][bj][m][n] = __builtin_amdgcn_mfma_f32_16x16x32_bf16(Bt[n][k], At[m][k], acc[ai][bj][m][n], 0, 0, 0); if (MMA_SETPRIO) __builtin_amdgcn_s_setprio(0); } while (0)
#else
#define PG8_MMA(ai, bj, At, Bt) do { if (DIAG == 1) break; if (MMA_SETPRIO) __builtin_amdgcn_s_setprio(MMA_PRIO); _Pragma("unroll") for (int m = 0; m < 4; ++m) _Pragma("unroll") for (int n = 0; n < 2; ++n) _Pragma("unroll") for (int k = 0; k < 2; ++k) \
        acc[ai][bj][m][n] = __builtin_amdgcn_mfma_f32_16x16x32_bf16(Bt[n][k], At[m][k], acc[ai][bj][m][n], 0, 0, 0); if (MMA_SETPRIO) __builtin_amdgcn_s_setprio(0); } while (0)
#endif
#define PG8_WAIT_V(n) asm volatile("s_waitcnt vmcnt(" #n ")" ::: "memory")
#if L2WARM
    const unsigned wlane = (unsigned)((wid & 3) * 64 + lane);
    const unsigned voffW = (wid < 4) ? wlane * (unsigned)g.lda * 2u : wlane * (unsigned)g.ldb * 2u;
#define PG8_WARM(abase, bbase) __builtin_amdgcn_global_load_lds((const unsigned*)((wid < 4 ? (const char*)(abase) : (const char*)(bbase)) + voffW), (PG8_LAS unsigned*)(lds + STAGE_BYTES + 1024), 4, 0, 0)
#define PG8_WAIT_VL() PG8_WAIT_V(9)
#else
#define PG8_WARM(abase, bbase) do {} while (0)
#define PG8_WAIT_VL() PG8_WAIT_V(8)
#endif
#define PG8_WAIT_L(n) asm volatile("s_waitcnt lgkmcnt(" #n ")" ::: "memory")
#define PG8_BAR __builtin_amdgcn_s_barrier()
#define PG8_SCHED __builtin_amdgcn_sched_barrier(0)
    Unit cur, nxt; int ui = 0;
    if (!S.next(0, cur)) return;
    f32x4 acc[2][2][4][2];
#pragma unroll
    for (int a = 0; a < 2; ++a)
#pragma unroll
        for (int b = 0; b < 2; ++b)
#pragma unroll
            for (int m = 0; m < 4; ++m)
#pragma unroll
                for (int n = 0; n < 2; ++n) acc[a][b][m][n] = (f32x4){0.f, 0.f, 0.f, 0.f};
    bf16x8 At[4][2], B0[2][2], B1[2][2];
    const char* cA = (const char*)g.A + (size_t)cur.pm * tstepA + (size_t)cur.ka * 2; const char* cB = (const char*)g.Bt + (size_t)cur.pn * tstepB;
    S.a_ready(cur);
    if constexpr (SP2) {
        PG8_STAGE(PG8_SB(0, 0), cB + PG8_KOFF(0), voffB); PG8_STAGE(PG8_SB(0, 1), cB + hstepB + PG8_KOFF(0), voffB); PG8_STAGE(PG8_SA(0, 0), cA + PG8_KOFF(0), voffA); PG8_STAGE(PG8_SA(0, 1), cA + hstepA + PG8_KOFF(0), voffA);
        if (wr == 1) PG8_BAR;
        PG8_WAIT_V(2); PG8_BAR;
#if BAL_DMA
        PG8_STAGE(PG8_SB(1, 0), cB + PG8_KOFF(1), voffB); PG8_STAGE(PG8_SB(1, 1), cB + hstepB + PG8_KOFF(1), voffB);
        PG8_WAIT_V(4); PG8_BAR;
#else
        PG8_STAGE(PG8_SB(1, 0), cB + kstep, voffB); PG8_STAGE(PG8_SA(1, 0), cA + kstep, voffA); PG8_STAGE(PG8_SB(1, 1), cB + hstepB + kstep, voffB);
        PG8_WAIT_V(6); PG8_BAR;
#endif
    } else {
        PG8_STAGE(PG8_SB(0, 0), cB, voffB); PG8_STAGE(PG8_SA(0, 0), cA, voffA); PG8_STAGE(PG8_SB(0, 1), cB + hstepB, voffB); PG8_STAGE(PG8_SA(0, 1), cA + hstepA, voffA);
        if (wr == 1) PG8_BAR;
        PG8_WAIT_V(4); PG8_BAR;
        PG8_STAGE(PG8_SB(1, 0), cB + kstep, voffB); PG8_STAGE(PG8_SA(1, 0), cA + kstep, voffA); PG8_STAGE(PG8_SB(1, 1), cB + hstepB + kstep, voffB);
        PG8_WAIT_V(6); PG8_BAR;
    }
    for (;;) {
        const bool has_next = S.next(ui + 1, nxt);
        const char* nA = has_next ? (const char*)g.A + (size_t)nxt.pm * tstepA + (size_t)nxt.ka * 2 : cA; const char* nB = has_next ? (const char*)g.Bt + (size_t)nxt.pn * tstepB : cB;
#if LOOP_ALIGN
        asm volatile(".p2align 8" ::: "memory");
#endif
        for (int t = 0; t < nt; t += 2) {
            const bool last = (t == nt - 2);
            const char* a1 = cA + PG8_KOFF(t + 1);
            const char* a2 = last ? nA + PG8_KOFF(0) : cA + PG8_KOFF(t + 2); const char* b2 = last ? nB + PG8_KOFF(0) : cB + PG8_KOFF(t + 2);
            const char* a3 = last ? nA + PG8_KOFF(1) : cA + PG8_KOFF(t + 3); const char* b3 = last ? nB + PG8_KOFF(1) : cB + PG8_KOFF(t + 3);
            if (last && has_next) S.a_ready(nxt);
            if constexpr (SP2) {
#if BAL_DMA
#if DMA_SPLIT35
            PG8_LDB(B0, 0, 0); PG8_LDB(B1, 0, 1); PG8_SCHED; PG8_LDA(At, 0, 0); PG8_STAGE(PG8_SA(1, 0), a1, voffA); PG8_STAGE1(PG8_SA(1, 1), a1 + hstepA, voffA, 0);
            PG8_WAIT_V(7); PG8_WAIT_L(0); PG8_BAR; if (!HM || cur.hf != 2) { PG8_MMA(0, 0, At, B0); PG8_MMA(0, 1, At, B1); } PG8_BAR; PG8_SCHED;
            PG8_LDA(At, 0, 1); PG8_STAGE1(PG8_SA(1, 1), a1 + hstepA, voffA, 1); PG8_STAGE(PG8_SB(0, 0), b2, voffB); PG8_STAGE(PG8_SB(0, 1), b2 + hstepB, voffB);
            PG8_WAIT_V(6); PG8_WAIT_L(0); PG8_BAR; if (!HM || cur.hf != 1) { PG8_MMA(1, 0, At, B0); PG8_MMA(1, 1, At, B1); } PG8_BAR; PG8_SCHED;
            PG8_LDB(B0, 1, 0); PG8_LDB(B1, 1, 1); PG8_SCHED; PG8_LDA(At, 1, 0); PG8_STAGE(PG8_SA(0, 0), a2, voffA); PG8_STAGE1(PG8_SA(0, 1), a2 + hstepA, voffA, 0);
            PG8_WAIT_V(7); PG8_WAIT_L(0); PG8_BAR; if (!HM || cur.hf != 2) { PG8_MMA(0, 0, At, B0); PG8_MMA(0, 1, At, B1); } PG8_BAR; PG8_SCHED;
            PG8_LDA(At, 1, 1); PG8_STAGE1(PG8_SA(0, 1), a2 + hstepA, voffA, 1); PG8_STAGE(PG8_SB(1, 0), b3, voffB); PG8_STAGE(PG8_SB(1, 1), b3 + hstepB, voffB);
            PG8_WAIT_V(6); PG8_WAIT_L(0); PG8_BAR; if (!HM || cur.hf != 1) { PG8_MMA(1, 0, At, B0); PG8_MMA(1, 1, At, B1); } PG8_BAR; PG8_SCHED;
            (void)a3;
#elif STAGE_AFTER_L
            PG8_LDB(B0, 0, 0); PG8_LDB(B1, 0, 1); PG8_SCHED; PG8_LDA(At, 0, 0); PG8_WAIT_L(0); PG8_SCHED; PG8_STAGE(PG8_SA(1, 0), a1, voffA); PG8_STAGE(PG8_SA(1, 1), a1 + hstepA, voffA);
            PG8_WAIT_V(8); PG8_BAR; if (!HM || cur.hf != 2) { PG8_MMA(0, 0, At, B0); PG8_MMA(0, 1, At, B1); } PG8_BAR; PG8_SCHED;
            PG8_LDA(At, 0, 1); PG8_WAIT_L(0); PG8_SCHED; PG8_STAGE(PG8_SB(0, 0), b2, voffB); PG8_STAGE(PG8_SB(0, 1), b2 + hstepB, voffB);
            PG8_WAIT_V(6); PG8_BAR; if (!HM || cur.hf != 1) { PG8_MMA(1, 0, At, B0); PG8_MMA(1, 1, At, B1); } PG8_BAR; PG8_SCHED;
            PG8_LDB(B0, 1, 0); PG8_LDB(B1, 1, 1); PG8_SCHED; PG8_LDA(At, 1, 0); PG8_WAIT_L(0); PG8_SCHED; PG8_STAGE(PG8_SA(0, 0), a2, voffA); PG8_STAGE(PG8_SA(0, 1), a2 + hstepA, voffA);
            PG8_WAIT_V(8); PG8_BAR; if (!HM || cur.hf != 2) { PG8_MMA(0, 0, At, B0); PG8_MMA(0, 1, At, B1); } PG8_BAR; PG8_SCHED;
            PG8_LDA(At, 1, 1); PG8_WAIT_L(0); PG8_SCHED; PG8_STAGE(PG8_SB(1, 0), b3, voffB); PG8_STAGE(PG8_SB(1, 1), b3 + hstepB, voffB);
            PG8_WAIT_V(6); PG8_BAR; if (!HM || cur.hf != 1) { PG8_MMA(1, 0, At, B0); PG8_MMA(1, 1, At, B1); } PG8_BAR; PG8_SCHED;
            (void)a3;
#elif STAGE_FIRST
            PG8_STAGE(PG8_SA(1, 0), a1, voffA); PG8_STAGE(PG8_SA(1, 1), a1 + hstepA, voffA); PG8_SCHED; PG8_LDB(B0, 0, 0); PG8_LDB(B1, 0, 1); PG8_SCHED; PG8_LDA(At, 0, 0);
            PG8_WAIT_V(8); PG8_WAIT_L(0); PG8_BAR; if (!HM || cur.hf != 2) { PG8_MMA(0, 0, At, B0); PG8_MMA(0, 1, At, B1); } PG8_BAR; PG8_SCHED;
            PG8_STAGE(PG8_SB(0, 0), b2, voffB); PG8_STAGE(PG8_SB(0, 1), b2 + hstepB, voffB); PG8_SCHED; PG8_LDA(At, 0, 1);
            PG8_WAIT_V(6); PG8_WAIT_L(0); PG8_BAR; if (!HM || cur.hf != 1) { PG8_MMA(1, 0, At, B0); PG8_MMA(1, 1, At, B1); } PG8_BAR; PG8_SCHED;
            PG8_STAGE(PG8_SA(0, 0), a2, voffA); PG8_STAGE(PG8_SA(0, 1), a2 + hstepA, voffA); PG8_SCHED; PG8_LDB(B0, 1, 0); PG8_LDB(B1, 1, 1); PG8_SCHED; PG8_LDA(At, 1, 0);
            PG8_WAIT_V(8); PG8_WAIT_L(0); PG8_BAR; if (!HM || cur.hf != 2) { PG8_MMA(0, 0, At, B0); PG8_MMA(0, 1, At, B1); } PG8_BAR; PG8_SCHED;
            PG8_STAGE(PG8_SB(1, 0), b3, voffB); PG8_STAGE(PG8_SB(1, 1), b3 + hstepB, voffB); PG8_SCHED; PG8_LDA(At, 1, 1);
            PG8_WAIT_V(6); PG8_WAIT_L(0); PG8_BAR; if (!HM || cur.hf != 1) { PG8_MMA(1, 0, At, B0); PG8_MMA(1, 1, At, B1); } PG8_BAR; PG8_SCHED;
            (void)a3;
#else
            PG8_LDB(B0, 0, 0); PG8_LDB(B1, 0, 1); PG8_SCHED; PG8_LDA(At, 0, 0); PG8_STAGE(PG8_SA(1, 0), a1, voffA); PG8_STAGE(PG8_SA(1, 1), a1 + hstepA, voffA);
            PG8_WAIT_V(8); PG8_WAIT_L(0); PG8_BAR; if (!HM || cur.hf != 2) { PG8_MMA(0, 0, At, B0); PG8_MMA(0, 1, At, B1); } PG8_BAR; PG8_SCHED;
            PG8_LDA(At, 0, 1); PG8_STAGE(PG8_SB(0, 0), b2, voffB); PG8_STAGE(PG8_SB(0, 1), b2 + hstepB, voffB);
            PG8_WAIT_V(6); PG8_WAIT_L(0); PG8_BAR; if (!HM || cur.hf != 1) { PG8_MMA(1, 0, At, B0); PG8_MMA(1, 1, At, B1); } PG8_BAR; PG8_SCHED;
            PG8_LDB(B0, 1, 0); PG8_LDB(B1, 1, 1); PG8_SCHED; PG8_LDA(At, 1, 0); PG8_STAGE(PG8_SA(0, 0), a2, voffA); PG8_STAGE(PG8_SA(0, 1), a2 + hstepA, voffA);
            PG8_WAIT_V(8); PG8_WAIT_L(0); PG8_BAR; if (!HM || cur.hf != 2) { PG8_MMA(0, 0, At, B0); PG8_MMA(0, 1, At, B1); } PG8_BAR; PG8_SCHED;
            PG8_LDA(At, 1, 1); PG8_STAGE(PG8_SB(1, 0), b3, voffB); PG8_STAGE(PG8_SB(1, 1), b3 + hstepB, voffB);
            PG8_WAIT_V(6); PG8_WAIT_L(0); PG8_BAR; if (!HM || cur.hf != 1) { PG8_MMA(1, 0, At, B0); PG8_MMA(1, 1, At, B1); } PG8_BAR; PG8_SCHED;
            (void)a3;
#endif
#else
            PG8_LDB(B0, 0, 0); PG8_LDB(B1, 0, 1); PG8_SCHED; PG8_LDA(At, 0, 0); PG8_STAGE(PG8_SA(1, 1), a1 + hstepA, voffA);
            PG8_WAIT_VL(); PG8_WAIT_L(0); PG8_BAR; if (!HM || cur.hf != 2) { PG8_MMA(0, 0, At, B0); PG8_MMA(0, 1, At, B1); } PG8_BAR; PG8_SCHED;
            PG8_LDA(At, 0, 1); PG8_STAGE(PG8_SB(0, 0), b2, voffB); PG8_STAGE(PG8_SB(0, 1), b2 + hstepB, voffB); PG8_STAGE(PG8_SA(0, 0), a2, voffA); PG8_WARM(a2 + 2 * kstep, b2 + 2 * kstep);
            PG8_WAIT_VL(); PG8_WAIT_L(0); PG8_BAR; if (!HM || cur.hf != 1) { PG8_MMA(1, 0, At, B0); PG8_MMA(1, 1, At, B1); } PG8_BAR; PG8_SCHED;
            PG8_LDB(B0, 1, 0); PG8_LDB(B1, 1, 1); PG8_SCHED; PG8_LDA(At, 1, 0); PG8_STAGE(PG8_SA(0, 1), a2 + hstepA, voffA);
            PG8_WAIT_VL(); PG8_WAIT_L(0); PG8_BAR; if (!HM || cur.hf != 2) { PG8_MMA(0, 0, At, B0); PG8_MMA(0, 1, At, B1); } PG8_BAR; PG8_SCHED;
            PG8_LDA(At, 1, 1); PG8_STAGE(PG8_SB(1, 0), b3, voffB); PG8_STAGE(PG8_SB(1, 1), b3 + hstepB, voffB); PG8_STAGE(PG8_SA(1, 0), a3, voffA); PG8_WARM(a3 + 2 * kstep, b3 + 2 * kstep);
            PG8_WAIT_VL(); PG8_WAIT_L(0); PG8_BAR; if (!HM || cur.hf != 1) { PG8_MMA(1, 0, At, B0); PG8_MMA(1, 1, At, B1); } PG8_BAR; PG8_SCHED;
#endif
            } else {
            PG8_LDB(B0, 0, 0); PG8_SCHED; PG8_LDA(At, 0, 0); PG8_STAGE(PG8_SA(1, 1), a1 + hstepA, voffA);
            PG8_WAIT_L(8); PG8_BAR; PG8_WAIT_L(0); PG8_MMA(0, 0, At, B0); PG8_BAR; PG8_SCHED;
            PG8_LDB(B1, 0, 1); PG8_STAGE(PG8_SB(0, 0), b2, voffB);
            PG8_BAR; PG8_WAIT_L(0); PG8_MMA(0, 1, At, B1); PG8_BAR;
            PG8_LDA(At, 0, 1); PG8_STAGE(PG8_SA(0, 0), a2, voffA);
            PG8_BAR; PG8_WAIT_L(0); PG8_MMA(1, 0, At, B0); PG8_BAR; PG8_SCHED;
            PG8_STAGE(PG8_SB(0, 1), b2 + hstepB, voffB);
            PG8_WAIT_V(6); PG8_BAR; PG8_MMA(1, 1, At, B1); PG8_BAR;
            PG8_LDB(B0, 1, 0); PG8_SCHED; PG8_LDA(At, 1, 0); PG8_STAGE(PG8_SA(0, 1), a2 + hstepA, voffA);
            PG8_WAIT_L(8); PG8_BAR; PG8_WAIT_L(0); PG8_MMA(0, 0, At, B0); PG8_BAR; PG8_SCHED;
            PG8_LDB(B1, 1, 1); PG8_STAGE(PG8_SB(1, 0), b3, voffB);
            PG8_BAR; PG8_WAIT_L(0); PG8_MMA(0, 1, At, B1); PG8_BAR;
            PG8_LDA(At, 1, 1); PG8_STAGE(PG8_SA(1, 0), a3, voffA);
            PG8_BAR; PG8_WAIT_L(0); PG8_MMA(1, 0, At, B0); PG8_BAR; PG8_SCHED;
            PG8_STAGE(PG8_SB(1, 1), b3 + hstepB, voffB);
            PG8_WAIT_V(6); PG8_BAR; PG8_MMA(1, 1, At, B1); PG8_BAR;
            }
        }
        if constexpr (ALIGN_EPI) { if (wr == 0) PG8_BAR; }
        if constexpr (!Epi::AFTER_DRAIN) { E(acc, cur, wr, wc, fr, fq); S.done(cur); }
        if (!has_next) break;
#pragma unroll
        for (int a = 0; a < 2; ++a)
#pragma unroll
            for (int b = 0; b < 2; ++b)
#pragma unroll
                for (int m = 0; m < 4; ++m)
#pragma unroll
                    for (int n = 0; n < 2; ++n) acc[a][b][m][n] = (f32x4){0.f, 0.f, 0.f, 0.f};
        cur = nxt; cA = nA; cB = nB; ++ui;
        if constexpr (ALIGN_EPI) { if (wr == 1) PG8_BAR; }
    }
    PG8_WAIT_V(0);
    if constexpr (!ALIGN_EPI) { if (wr == 0) PG8_BAR; }
    PG8_BAR;
    if constexpr (Epi::AFTER_DRAIN) { E.fused(acc, cur, wr, wc, fr, fq, lds, wid, lane); S.done(cur); }
#undef PG8_SA
#undef PG8_SB
#undef PG8_STAGE
#undef PG8_LDA
#undef PG8_LDB
#undef PG8_MMA
#undef PG8_WAIT_V
#undef PG8_KOFF
#undef PG8_WARM
#undef PG8_WAIT_VL
#undef PG8_WAIT_L
#undef PG8_BAR
#undef PG8_SCHED
}
}
constexpr size_t MiB = 1u << 20;
constexpr size_t WS_CTL = 0, CTL_ZERO_BYTES = (DBG || PROBE) ? 1 * MiB : 128 * 1024;
constexpr size_t WS_SSQ = 1 * MiB;
constexpr size_t WS_ROPE_C = 2 * MiB, WS_ROPE_S = 3 * MiB;
constexpr size_t WS_MEMN = 16 * MiB;
constexpr size_t WS_MK = 5 * MiB, WS_MVT = 6 * MiB;
constexpr size_t WS_KB = 7 * MiB, WS_VT = 10 * MiB;
constexpr size_t WS_WPOOL = 13 * MiB;
constexpr size_t WS_WMKV = 17 * MiB + (size_t)256 * PITCH_PAD * 2, WMKV_BYTES = (size_t)4096 * cfg::PD * 2;
constexpr size_t WS_WIN = WS_WMKV + WMKV_BYTES, WIO_BYTES = (size_t)cfg::D * cfg::PD * 2;
constexpr size_t WS_WOUT = WS_WIN + 4 * WIO_BYTES;
constexpr size_t WS_WD = WS_WOUT + 4 * WIO_BYTES, WD_BYTES = (size_t)cfg::D * cfg::PF * 2;
constexpr size_t WS_WGU = WS_WD + 8 * WD_BYTES, WGU_BYTES = (size_t)cfg::NGU_PAD * cfg::PD * 2;
constexpr size_t ACT_BYTES = (size_t)cfg::S * cfg::PD * 2;
constexpr size_t WS_HB = WS_WGU + 8 * WGU_BYTES;
constexpr size_t WS_HL = WS_HB + ACT_BYTES;
constexpr size_t WS_AQ = WS_HL + ACT_BYTES;
constexpr size_t WS_Y = WS_AQ + ACT_BYTES;
constexpr size_t WS_HFF = WS_Y + ACT_BYTES;
constexpr size_t WS_Z = ((WS_HFF + (size_t)cfg::S * cfg::PF * 2 + MiB - 1) / MiB) * MiB;
constexpr size_t WS_WOUT2 = WS_Z, WS_WPS = WS_Z + 40 * MiB;
constexpr size_t WS_QMF = WS_Z + 48 * MiB;
constexpr size_t WS_SPL = DBG ? WS_Z : WS_QMF + 8 * MiB;
constexpr size_t WS_END = WS_QMF + 8 * MiB + (DBG ? 0 : 32 * MiB);
constexpr int CW_SPL = 20480;
static_assert(WS_WPOOL + 3 * MiB <= WS_MEMN && WS_MEMN + (size_t)256 * cfg::PD * 2 <= WS_WMKV && WS_QMF + 8 * MiB <= WS_END && (WS_WIN % 256) == 0 && (WS_WD % 256) == 0 && (WS_WGU % 256) == 0 && (WS_HB % 256) == 0 && (WS_HFF % 256) == 0, "d_ws map");
constexpr int CW_BAR = 4096;
constexpr int RING_OFF = 0, RING_BYTES = 131072;
constexpr int LDSCTL_OFF = RING_BYTES, MISC_OFF = LDSCTL_OFF + 320;
constexpr int RSTD_TAB_OFF = RING_BYTES + 8192;
constexpr int LDS_BYTES = 147456;
constexpr int NWAVES = 8;

#define GAS __attribute__((address_space(1)))
#define LAS __attribute__((address_space(3)))
typedef unsigned short bf16;
typedef unsigned v4u __attribute__((ext_vector_type(4)));
typedef unsigned v2u __attribute__((ext_vector_type(2)));
typedef float f32x4 __attribute__((ext_vector_type(4)));
typedef float f32x16 __attribute__((ext_vector_type(16)));
typedef short bf16x8 __attribute__((ext_vector_type(8)));
typedef short s16x4 __attribute__((ext_vector_type(4)));
#define LDS_WAIT() asm volatile("s_waitcnt lgkmcnt(0)" ::: "memory")
#define VM_WAIT() asm volatile("s_waitcnt vmcnt(0)" ::: "memory")
using pg8::pkbf;

#define XB_TMO      128
#define XB_XCNT(j)  (256  + 64 * (j))
#define XB_XSUB(j)  (1280 + 64 * (j))
#define XB_XGEN(j)  (2304 + 64 * (j))
#define XB_TOP      3328
#define XB_TOPGEN   3392
#define XCD_BAR_WORDS 3456
#define XB_SPIN_CAP (1u << 18)

__device__ __forceinline__ unsigned xb_ld(unsigned* p)              { return __hip_atomic_load(p, __ATOMIC_RELAXED, __HIP_MEMORY_SCOPE_AGENT); }
__device__ __forceinline__ unsigned xb_add(unsigned* p, unsigned v) { return __hip_atomic_fetch_add(p, v, __ATOMIC_RELAXED, __HIP_MEMORY_SCOPE_AGENT); }
__device__ __forceinline__ unsigned xb_xcc_id() { return (unsigned)__builtin_amdgcn_s_getreg((3 << 11) | 20) & 0xFu; }
#define XB_SPIN(cond, bar) do { unsigned _sp = 0; while (cond) { __builtin_amdgcn_s_sleep(1); \
    if ((++_sp & 255u) == 0u) { if (xb_ld(&(bar)[XB_TMO])) break; if (_sp > XB_SPIN_CAP) { atomicAdd(&(bar)[XB_TMO], 1u); break; } } } } while (0)

struct XcdBarrier {
    unsigned* bar; unsigned x;
    volatile LAS unsigned* st;
};

__device__ __forceinline__ XcdBarrier xcd_barrier_post(unsigned* bar, volatile LAS unsigned* st) {
    XcdBarrier b; b.bar = bar; b.x = xb_xcc_id(); b.st = st;
    if (threadIdx.x == 0) (void)xb_add(&bar[XB_XCNT(b.x)], 1u);
    return b;
}
__device__ __forceinline__ void xcd_barrier_complete(unsigned* bar, unsigned x, unsigned& nloc, unsigned& nx) {
    const unsigned G = gridDim.x * gridDim.y * gridDim.z;
    unsigned sum, cnt, mine, sp = 0u;
    for (;;) {
        sum = 0u; cnt = 0u; mine = 0u;
#pragma unroll
        for (unsigned j = 0; j < 16; ++j) { const unsigned c = xb_ld(&bar[XB_XCNT(j)]); sum += c; cnt += (c > 0u) ? 1u : 0u; mine = (j == x) ? c : mine; }
        if (sum == G) break;
        __builtin_amdgcn_s_sleep(1);
        if ((++sp & 255u) == 0u) { if (xb_ld(&bar[XB_TMO])) break; if (sp > XB_SPIN_CAP) { atomicAdd(&bar[XB_TMO], 1u); break; } }
    }
    nloc = mine > 0u ? mine : 1u; nx = cnt > 0u ? cnt : 1u;
}

__device__ __forceinline__ void xcd_barrier(const XcdBarrier& b) {
    asm volatile("s_waitcnt vmcnt(0)" ::: "memory");
    __syncthreads();
    if (threadIdx.x == 0) {
        unsigned* bar = b.bar;
        __builtin_amdgcn_s_waitcnt(0);
        unsigned nloc = b.st[0], nx = b.st[1];
        if (nloc == 0u) { xcd_barrier_complete(bar, b.x, nloc, nx); b.st[0] = nloc; b.st[1] = nx; }
        const unsigned old = xb_add(&bar[XB_XSUB(b.x)], 1u);
        const unsigned gen = old / nloc;
        if (old + 1u == (gen + 1u) * nloc) {
            __builtin_amdgcn_fence(__ATOMIC_RELEASE, "agent");
            asm volatile("s_waitcnt vmcnt(0)" ::: "memory");
            const unsigned og = xb_add(&bar[XB_TOP], 1u);
            const unsigned tg = og / nx;
            if (og + 1u == (tg + 1u) * nx) xb_add(&bar[XB_TOPGEN], 1u);
            else XB_SPIN(xb_ld(&bar[XB_TOPGEN]) == tg, bar);
            __builtin_amdgcn_fence(__ATOMIC_ACQUIRE, "agent");
            xb_add(&bar[XB_XGEN(b.x)], 1u);
            asm volatile("s_waitcnt vmcnt(0)" ::: "memory");
        } else {
#if EARLY_WB
            if (old == gen * nloc || old == gen * nloc + nloc / 2) { __builtin_amdgcn_fence(__ATOMIC_RELEASE, "agent"); asm volatile("s_waitcnt vmcnt(0)" ::: "memory"); }
#endif
            XB_SPIN(xb_ld(&bar[XB_XGEN(b.x)]) == gen, bar);
            __builtin_amdgcn_fence(__ATOMIC_ACQUIRE, "agent");
            asm volatile("s_waitcnt vmcnt(0)" ::: "memory");
        }
    }
    __syncthreads();
}

constexpr int CW_GRP = 12288, CW_GRPX = 16384;
__device__ __forceinline__ void grp_barrier(unsigned* ctl, int pm, unsigned target, bool same_xcd) {
    asm volatile("s_waitcnt vmcnt(0)" ::: "memory");
    __syncthreads();
    if (threadIdx.x == 0) {
        unsigned* ctr = ctl + CW_GRP + 64 * pm; unsigned* tmo = ctl + CW_BAR + XB_TMO;
        if (!same_xcd) __builtin_amdgcn_fence(__ATOMIC_RELEASE, "agent");
        asm volatile("s_waitcnt vmcnt(0)" ::: "memory");
        (void)xb_add(ctr, 1u);
#if EARLY_ACQ
        __builtin_amdgcn_fence(__ATOMIC_ACQUIRE, "agent");
#endif
        unsigned sp = 0u;
        while (xb_ld(ctr) < target) { __builtin_amdgcn_s_sleep(1); if ((++sp & 255u) == 0u) { if (xb_ld(tmo)) break; if (sp > XB_SPIN_CAP) { atomicAdd(tmo, 1u); break; } } }
#if !EARLY_ACQ
        __builtin_amdgcn_fence(__ATOMIC_ACQUIRE, "agent");
#endif
        asm volatile("s_waitcnt vmcnt(0)" ::: "memory");
    }
    __syncthreads();
}

struct Frame {
    LAS unsigned char* lds;
    volatile LAS unsigned* MISC;
    int tid, lane, wave, vcu, G;
    const float *x, *mem; const int* pos; const float *norms, *gate, *up, *down, *w_in, *w_out, *pool_w, *pool_scale, *w_kv, *kv_norm, *sinks, *w_mem_kv, *mem_norm, *final_norm;
    float* out; unsigned char* ws;
};
__device__ __forceinline__ float wave_sum(float v) {
#pragma unroll
    for (int o = 1; o < 64; o <<= 1) v += __shfl_xor(v, o);
    return v;
}
__device__ __forceinline__ int rope_slot(int d) { return 8 * ((d & 31) >> 2) + 4 * (d >> 5) + (d & 3); }
__device__ __forceinline__ int map_row(int map, int n) {
    if (map == 1) return (n >> 7) * 256 + (n & 127);
    if (map == 2) return (n >> 7) * 256 + 128 + (n & 127);
    if (map == 3) return n < 1536 ? (n & ~63) + rope_slot(n & 63) : n;
    if (map == 4) return n < 192 ? (n & ~63) + rope_slot(n & 63) : n;
    return n;
}
__device__ __forceinline__ void conv_item(const float* W, int N, int k0, int n0, const float* gain, bf16* dst, int dst_ld, int map, int row_off, LAS float* scr, int lane) {
    f32x4 v8[8];
    const int c = lane & 7;
    f32x4 g0 = (f32x4){1.f, 1.f, 1.f, 1.f}, g1 = g0;
    if (gain) { g0 = *(const f32x4*)(gain + k0 + 8 * c); g1 = *(const f32x4*)(gain + k0 + 8 * c + 4); }
#pragma unroll
    for (int i = 0; i < 8; ++i) { const int kr = (lane >> 3) + 8 * i; v8[i] = __builtin_nontemporal_load((const f32x4*)(W + (size_t)(k0 + kr) * N + n0 + (lane & 7) * 4)); }
    asm volatile("" ::: "memory");
#pragma unroll
    for (int i = 0; i < 8; ++i) { const int kr = (lane >> 3) + 8 * i; const f32x4 v = v8[i];
        LAS float* s = scr + kr * 33 + (lane & 7) * 4; s[0] = v[0]; s[1] = v[1]; s[2] = v[2]; s[3] = v[3]; }
    LDS_WAIT(); asm volatile("" ::: "memory");
#pragma unroll
    for (int j = 0; j < 4; ++j) { const int n = (lane >> 3) + 8 * j; const LAS float* s = scr + (8 * c) * 33 + n;
        v4u o; o.x = pkbf(s[0 * 33] * g0[0], s[1 * 33] * g0[1]); o.y = pkbf(s[2 * 33] * g0[2], s[3 * 33] * g0[3]); o.z = pkbf(s[4 * 33] * g1[0], s[5 * 33] * g1[1]); o.w = pkbf(s[6 * 33] * g1[2], s[7 * 33] * g1[3]);
        if (CONV_NT) __builtin_nontemporal_store(o, (v4u*)(dst + (size_t)(map_row(map, n0 + n) + row_off) * dst_ld + k0 + 8 * c)); else *(v4u*)(dst + (size_t)(map_row(map, n0 + n) + row_off) * dst_ld + k0 + 8 * c) = o; }
    LDS_WAIT(); asm volatile("" ::: "memory");
}
#ifndef CV_TAIL
#define CV_TAIL 0
#endif
#ifndef IO_IN_PRO
#define IO_IN_PRO 1
#endif
constexpr int CV_FFN1 = 3 * 5632, CV_IO1 = 2 * 2048, CV_NIO = IO_IN_PRO ? 4 : 1, CV_MISC = 4 * 1024 + 8 * 72 + 384, CV_REST = CV_FFN1 - CV_TAIL, CV_PRO = CV_FFN1 + 7 * CV_REST + CV_NIO * CV_IO1 + CV_MISC;
__device__ __forceinline__ void conv_ffn(Frame& F, int i8, int r3, LAS float* scr, int lane) {
    using namespace cfg;
    const int kind = r3 / 5632, r = r3 % 5632, l = i8 >> 1, half = i8 & 1;
    if (kind < 2) conv_item((kind ? F.up : F.gate) + (size_t)i8 * D * FF, FF, 64 * (r / 176), 32 * (r % 176), F.norms + (size_t)(l * 3 + (half ? 2 : 0)) * D, (bf16*)(F.ws + WS_WGU + (size_t)i8 * WGU_BYTES), PD, 1 + kind, 0, scr, lane);
    else conv_item(F.down + (size_t)i8 * FF * D, D, 64 * (r / 64), 32 * (r % 64), nullptr, (bf16*)(F.ws + WS_WD + (size_t)i8 * WD_BYTES), PF, 0, 0, scr, lane);
}
__device__ __forceinline__ void conv_io(Frame& F, int l, int r2, LAS float* scr, int lane) {
    using namespace cfg;
    const int r = r2 & 2047;
    if (r2 < 2048) conv_item(F.w_in + (size_t)l * D * D, D, 64 * (r / 64), 32 * (r % 64), F.norms + (size_t)(l * 3 + 1) * D, (bf16*)(F.ws + WS_WIN + (size_t)l * WIO_BYTES), PD, l >= 2 ? 3 : 0, 0, scr, lane);
    else conv_item(F.w_out + (size_t)l * D * D, D, 64 * (r / 64), 32 * (r % 64), nullptr, (bf16*)(F.ws + ((POOL_FOLD && l < 2 && r / 64 >= 24) ? WS_WOUT2 : WS_WOUT) + (size_t)l * WIO_BYTES), PD, 0, 0, scr, lane);
}
__device__ __forceinline__ void conv_misc(Frame& F, int it, LAS float* scr, int lane) {
    using namespace cfg;
    if (it < 4096) { const int l = it / 1024, r = it % 1024;
        conv_item(F.w_mem_kv + (size_t)l * D * 1024, 1024, 64 * (r / 32), 32 * (r % 32), nullptr, (bf16*)(F.ws + WS_WMKV), PD, 0, l * 1024, scr, lane); return; }
    it -= 4096;
    if (it < 576) { const int pg = it / 72, r = it % 72, l = pg >> 2, g = pg & 3;
        conv_item(F.pool_w + (size_t)pg * 384 * 384, 384, 64 * (r / 12), 32 * (r % 12), nullptr, (bf16*)(F.ws + WS_WPOOL) + (size_t)l * 2048 * 384, 384, 0, g * 512, scr, lane); return; }
    it -= 576;
    conv_item(F.w_kv, 384, 64 * (it / 12), 32 * (it % 12), F.kv_norm, (bf16*)(F.ws + WS_WGU + 4 * WGU_BYTES), PD, 4, NGU, scr, lane);
}
constexpr int CW_CONV = 8192;
__device__ __forceinline__ void conv_tail(Frame& F, int i) {
    if (i >= 7) return;
    int lane = threadIdx.x; asm volatile("" : "+v"(lane)); lane &= 63;
    LAS float* scr = (LAS float*)(F.lds + RING_OFF + F.wave * 16384);
    unsigned* head = (unsigned*)(F.ws + WS_CTL) + CW_CONV + 64 * i;
    const int nitems = CV_TAIL + (((i & 1) && !IO_IN_PRO) ? CV_IO1 : 0), nch = nitems / 8;
    if (nitems == 0) return;
    for (;;) {
        unsigned ch = 0u;
        if (lane == 0) ch = __hip_atomic_fetch_add(head, 1u, __ATOMIC_RELAXED, __HIP_MEMORY_SCOPE_AGENT);
        ch = (unsigned)__builtin_amdgcn_readfirstlane((int)ch);
        if ((int)ch >= nch) break;
        for (int k = 0; k < 8; ++k) { const int it = (int)ch * 8 + k; if (it < CV_TAIL) conv_ffn(F, i + 1, it, scr, lane); else conv_io(F, (i + 1) >> 1, it - CV_TAIL, scr, lane); }
    }
}
__device__ __forceinline__ void p0_prologue(Frame& F) {
    using namespace cfg;
    LAS float* scr = (LAS float*)(F.lds + RING_OFF + F.wave * 16384);
    const int gw = F.vcu * NWAVES + F.wave, NGW = F.G * NWAVES;
    for (int it = gw; it < CV_PRO; it += NGW) { int r = CONV_REVERSE ? CV_PRO - 1 - it : it;
        if (r < CV_FFN1) { conv_ffn(F, 0, r, scr, F.lane); continue; } r -= CV_FFN1;
        if (r < 7 * CV_REST) { conv_ffn(F, 1 + r / CV_REST, CV_TAIL + r % CV_REST, scr, F.lane); continue; } r -= 7 * CV_REST;
        if (r < CV_NIO * CV_IO1) { conv_io(F, r / CV_IO1, r % CV_IO1, scr, F.lane); continue; } r -= CV_NIO * CV_IO1;
        conv_misc(F, r, scr, F.lane); }
    bf16* HB = (bf16*)(F.ws + WS_HB); float* ssq = (float*)(F.ws + WS_SSQ);
    { f32x4 xv[8], xn[8];
      if (gw < S) { const f32x4* xr = (const f32x4*)(F.x + (size_t)gw * D) + F.lane;
#pragma unroll
          for (int j = 0; j < 8; ++j) xv[j] = xr[64 * j]; }
      for (int m = gw; m < S; m += NGW) { const int mn = m + NGW < S ? m + NGW : m; const f32x4* xr = (const f32x4*)(F.x + (size_t)mn * D) + F.lane;
#pragma unroll
          for (int j = 0; j < 8; ++j) xn[j] = xr[64 * j];
          asm volatile("" ::: "memory");
          float s = 0.f; v2u* o8 = (v2u*)(HB + (size_t)m * PD) + F.lane;
#pragma unroll
          for (int j = 0; j < 8; ++j) { const f32x4 v = xv[j]; s += (v[0] * v[0] + v[1] * v[1]) + (v[2] * v[2] + v[3] * v[3]); v2u w; w.x = pkbf(v[0], v[1]); w.y = pkbf(v[2], v[3]); o8[64 * j] = w; }
          s = wave_sum(s);
          if (F.lane < 8) ssq[(size_t)m * 8 + F.lane] = F.lane == 0 ? s : 0.f;
#pragma unroll
          for (int j = 0; j < 8; ++j) xv[j] = xn[j]; } }
    bf16* MEMN = (bf16*)(F.ws + WS_MEMN);
    for (int m = gw; m < ML; m += NGW) { const f32x4* xr = (const f32x4*)(F.mem + (size_t)m * D) + F.lane; const f32x4* gr = (const f32x4*)F.mem_norm + F.lane; float s = 0.f; f32x4 v[8];
#pragma unroll
        for (int j = 0; j < 8; ++j) { v[j] = xr[64 * j]; s += (v[j][0] * v[j][0] + v[j][1] * v[j][1]) + (v[j][2] * v[j][2] + v[j][3] * v[j][3]); }
        const float rs = __builtin_amdgcn_rsqf(wave_sum(s) * (1.0f / D) + EPS); v2u* o8 = (v2u*)(MEMN + (size_t)m * PD) + F.lane;
#pragma unroll
        for (int j = 0; j < 8; ++j) { const f32x4 g = gr[64 * j]; v2u w; w.x = pkbf(v[j][0] * rs * g[0], v[j][1] * rs * g[1]); w.y = pkbf(v[j][2] * rs * g[2], v[j][3] * rs * g[3]); o8[64 * j] = w; } }
#if POOL_FOLD
    for (int idx = gw * 64 + F.lane; idx < 8 * 384 * 96; idx += NGW * 64) { const int pg = idx / (384 * 96), rem = idx % (384 * 96), j = rem / 96, m4 = (rem % 96) * 4, l = pg >> 2, g = pg & 3;
        const f32x4 p = *(const f32x4*)(F.pool_w + ((size_t)pg * 384 + j) * 384 + m4), sc = *(const f32x4*)(F.pool_scale + (size_t)l * MIX + g * 384 + m4);
        v2u w; w.x = pkbf(p[0] * sc[0], p[1] * sc[1]); w.y = pkbf(p[2] * sc[2], p[3] * sc[3]);
        *(v2u*)((bf16*)(F.ws + WS_WPS) + ((size_t)l * 2048 + g * 512 + j) * 384 + m4) = w; }
#endif
    float* rc = (float*)(F.ws + WS_ROPE_C); float* rsn = (float*)(F.ws + WS_ROPE_S);
    for (int idx = gw * 64 + F.lane; idx < S * 32; idx += NGW * 64) { const int t = idx >> 5, i = idx & 31;
        const float inv_freq = 1.0f / powf(10000.0f, (float)i * (2.0f / 64.0f)); const float ang = (float)F.pos[t] * inv_freq; float sn, cs; sincosf(ang, &sn, &cs); rc[idx] = cs; rsn[idx] = sn; }
}
#define MFMA32(a, b, c) __builtin_amdgcn_mfma_f32_32x32x16_bf16((a), (b), (c), 0, 0, 0)
__device__ __forceinline__ bf16x8 cat8(s16x4 a, s16x4 b) { return __builtin_shufflevector(a, b, 0, 1, 2, 3, 4, 5, 6, 7); }
template <int ND> __device__ __forceinline__ void softmax_tile(f32x16& p, float& m, float& lsum, f32x16 (&o)[ND], bf16x8 (&pb)[2]) {
    float tm = p[0];
#pragma unroll
    for (int r = 1; r < 16; ++r) tm = fmaxf(tm, p[r]);
    tm = fmaxf(tm, __shfl_xor(tm, 32));
    const float mn = fmaxf(m, tm), f = __builtin_amdgcn_exp2f(m - mn); m = mn;
    float ps = 0.f;
#pragma unroll
    for (int r = 0; r < 16; ++r) { p[r] = __builtin_amdgcn_exp2f(p[r] - mn); ps += p[r]; }
    lsum = lsum * f + ps;
#pragma unroll
    for (int d = 0; d < ND; ++d)
#pragma unroll
        for (int r = 0; r < 16; ++r) o[d][r] *= f;
#pragma unroll
    for (int s = 0; s < 2; ++s) { v4u w; w.x = pkbf(p[8 * s + 0], p[8 * s + 1]); w.y = pkbf(p[8 * s + 2], p[8 * s + 3]); w.z = pkbf(p[8 * s + 4], p[8 * s + 5]); w.w = pkbf(p[8 * s + 6], p[8 * s + 7]); pb[s] = __builtin_bit_cast(bf16x8, w); }
}
__device__ __forceinline__ int opaque_lane() { int t = threadIdx.x; asm volatile("" : "+v"(t)); return t & 63; }
__device__ __forceinline__ void store_o32(bf16* yrow  , const f32x16& o, float inv, int hi) {
#pragma unroll
    for (int g = 0; g < 4; g += 2) {
        unsigned ax = pkbf(o[4 * g] * inv, o[4 * g + 1] * inv), ay = pkbf(o[4 * g + 2] * inv, o[4 * g + 3] * inv);
        unsigned bx = pkbf(o[4 * g + 4] * inv, o[4 * g + 5] * inv), by = pkbf(o[4 * g + 6] * inv, o[4 * g + 7] * inv);
        const auto r0 = __builtin_amdgcn_permlane32_swap(ax, bx, false, false); ax = r0[0]; bx = r0[1];
        const auto r1 = __builtin_amdgcn_permlane32_swap(ay, by, false, false); ay = r1[0]; by = r1[1];
        v4u w; w.x = ax; w.y = ay; w.z = bx; w.w = by;
        *(v4u*)(yrow + 8 * g + 8 * hi) = w; }
}
__device__ __forceinline__ void mem_item(Frame& F, int l, int h, int qb) {
    const int lane = opaque_lane(), r32 = lane & 31, hi = lane >> 5;
    bf16* Y = (bf16*)(F.ws + WS_Y);
    const bf16* Qp = (const bf16*)(F.ws + WS_QMF) + (size_t)((h * 256 + qb) * 8) * 512 + lane * 8;
    const bf16* Kp = (const bf16*)(F.ws + WS_MK) + (size_t)((l * 4 + h) * 8) * 8 * 512 + lane * 8;
    const bf16* Vp = (const bf16*)(F.ws + WS_MVT) + (size_t)((l * 4 + h) * 8) * 8 * 512 + lane * 8;
    bf16x8 qf[8], kf[8], vf[8];
#pragma unroll
    for (int j = 0; j < 8; ++j) { qf[j] = *(const bf16x8*)(Qp + j * 512); kf[j] = *(const bf16x8*)(Kp + j * 512); }
#pragma unroll
    for (int j = 0; j < 8; ++j) vf[j] = *(const bf16x8*)(Vp + j * 512);
    f32x16 o[4];
#pragma unroll
    for (int d = 0; d < 4; ++d)
#pragma unroll
        for (int r = 0; r < 16; ++r) o[d][r] = 0.f;
    float m = -1e30f, lsum = 0.f;
#pragma clang loop unroll(disable)
    for (int kt = 0; kt < 8; ++kt) {
        f32x16 p;
#pragma unroll
        for (int r = 0; r < 16; ++r) p[r] = 0.f;
#pragma unroll
        for (int j = 0; j < 8; ++j) p = MFMA32(kf[j], qf[j], p);
        const int kn = kt < 7 ? kt + 1 : kt;
#pragma unroll
        for (int j = 0; j < 8; ++j) kf[j] = *(const bf16x8*)(Kp + (size_t)(kn * 8 + j) * 512);
        bf16x8 pb[2]; softmax_tile<4>(p, m, lsum, o, pb);
#pragma unroll
        for (int d = 0; d < 4; ++d)
#pragma unroll
            for (int s2 = 0; s2 < 2; ++s2) o[d] = MFMA32(vf[d * 2 + s2], pb[s2], o[d]);
#pragma unroll
        for (int j = 0; j < 8; ++j) vf[j] = *(const bf16x8*)(Vp + (size_t)(kn * 8 + j) * 512);
    }
    lsum += __shfl_xor(lsum, 32); const float inv = 1.0f / lsum;
    bf16* yp = Y + (size_t)(qb * 32 + r32) * cfg::PD + 1536 + h * 128;
#pragma unroll
    for (int d = 0; d < 4; ++d) store_o32(yp + d * 32, o[d], inv, hi);
}
__device__ __forceinline__ void swa_item(Frame& F, int l, int hq, int qb) {
    const int lane = opaque_lane(), r32 = lane & 31, hi = lane >> 5, kvh = hq >> 3;
    bf16* Y = (bf16*)(F.ws + WS_Y);
    const bf16* Qp = (const bf16*)(F.ws + WS_AQ) + (size_t)((hq * 256 + qb) * 4) * 512 + lane * 8;
    const bf16* Kp = (const bf16*)(F.ws + WS_KB) + (size_t)(kvh * 256) * 4 * 512 + lane * 8;
    const bf16* Vp = (const bf16*)(F.ws + WS_VT) + (size_t)(kvh * 256) * 4 * 512 + lane * 8;
    const int i0 = qb < 4 ? 4 - qb : 0;
    bf16x8 qf[4], kf[4], vf[4];
#pragma unroll
    for (int j = 0; j < 4; ++j) { qf[j] = *(const bf16x8*)(Qp + j * 512); kf[j] = *(const bf16x8*)(Kp + (size_t)((qb - 4 + i0) * 4 + j) * 512); }
#pragma unroll
    for (int j = 0; j < 4; ++j) vf[j] = *(const bf16x8*)(Vp + (size_t)((qb - 4 + i0) * 4 + j) * 512);
    f32x16 o[2];
#pragma unroll
    for (int d = 0; d < 2; ++d)
#pragma unroll
        for (int r = 0; r < 16; ++r) o[d][r] = 0.f;
    float m = F.sinks[(l - 2) * cfg::NQH + hq] * cfg::LOG2E, lsum = hi == 0 ? 1.0f : 0.0f;
#pragma clang loop unroll(disable)
    for (int i = i0; i < 5; ++i) { const int kt = qb - 4 + i;
        f32x16 p;
#pragma unroll
        for (int r = 0; r < 16; ++r) p[r] = 0.f;
#pragma unroll
        for (int j = 0; j < 4; ++j) p = MFMA32(kf[j], qf[j], p);
        const int kn = i < 4 ? kt + 1 : kt;
#pragma unroll
        for (int j = 0; j < 4; ++j) kf[j] = *(const bf16x8*)(Kp + (size_t)(kn * 4 + j) * 512);
        if (i == 0 || i == 4) {
#pragma unroll
            for (int r = 0; r < 16; ++r) { const int jj = (r & 3) + 8 * (r >> 2) + 4 * hi; const bool ok = (i == 0) ? (jj >= r32 + 1) : (jj <= r32); p[r] = ok ? p[r] : -INFINITY; } }
        bf16x8 pb[2]; softmax_tile<2>(p, m, lsum, o, pb);
#pragma unroll
        for (int d = 0; d < 2; ++d)
#pragma unroll
            for (int s2 = 0; s2 < 2; ++s2) o[d] = MFMA32(vf[d * 2 + s2], pb[s2], o[d]);
#pragma unroll
        for (int j = 0; j < 4; ++j) vf[j] = *(const bf16x8*)(Vp + (size_t)(kn * 4 + j) * 512);
    }
    lsum += __shfl_xor(lsum, 32); const float inv = 1.0f / lsum;
    bf16* yp = Y + (size_t)(qb * 32 + r32) * cfg::PD + hq * 64;
#pragma unroll
    for (int d = 0; d < 2; ++d) store_o32(yp + d * 32, o[d], inv, hi);
}
__device__ __forceinline__ void stage_lds(Frame& F, const void* src, int lds_off, int bytes) {
    for (int i = 0; i < bytes / 8192; ++i)
        __builtin_amdgcn_global_load_lds((const unsigned*)((const char*)src + (size_t)i * 8192 + F.tid * 16), (LAS unsigned*)(F.lds + lds_off + i * 8192 + F.wave * 1024), 16, 0, 0);
}
__device__ __forceinline__ void mem_item_lds(Frame& F, int h, int qb, const LAS unsigned char* kv) {
    const int lane = opaque_lane(), r32 = lane & 31, hi = lane >> 5;
    bf16* Y = (bf16*)(F.ws + WS_Y);
    const bf16* Qp = (const bf16*)(F.ws + WS_QMF) + (size_t)((h * 256 + qb) * 8) * 512 + lane * 8;
    const LAS unsigned char* Kp = kv + lane * 16; const LAS unsigned char* Vp = kv + 65536 + lane * 16;
    bf16x8 qf[8];
#pragma unroll
    for (int j = 0; j < 8; ++j) qf[j] = *(const bf16x8*)(Qp + j * 512);
    f32x16 o[4];
#pragma unroll
    for (int d = 0; d < 4; ++d)
#pragma unroll
        for (int r = 0; r < 16; ++r) o[d][r] = 0.f;
#if ONEPASS_LDS
    f32x16 sc[8];
#pragma unroll
    for (int kt = 0; kt < 8; ++kt) {
#pragma unroll
        for (int r = 0; r < 16; ++r) sc[kt][r] = 0.f;
#pragma unroll
        for (int j = 0; j < 8; ++j) sc[kt] = MFMA32(*(const LAS bf16x8*)(Kp + (kt * 8 + j) * 1024), qf[j], sc[kt]);
    }
    float m = sc[0][0];
#pragma unroll
    for (int kt = 0; kt < 8; ++kt)
#pragma unroll
        for (int r = 0; r < 16; ++r) m = fmaxf(m, sc[kt][r]);
    m = fmaxf(m, __shfl_xor(m, 32));
    float lsum = 0.f;
#pragma unroll
    for (int kt = 0; kt < 8; ++kt) {
#pragma unroll
        for (int r = 0; r < 16; ++r) { sc[kt][r] = __builtin_amdgcn_exp2f(sc[kt][r] - m); lsum += sc[kt][r]; }
        bf16x8 pb[2];
#pragma unroll
        for (int s2 = 0; s2 < 2; ++s2) { v4u w; w.x = pkbf(sc[kt][8 * s2 + 0], sc[kt][8 * s2 + 1]); w.y = pkbf(sc[kt][8 * s2 + 2], sc[kt][8 * s2 + 3]); w.z = pkbf(sc[kt][8 * s2 + 4], sc[kt][8 * s2 + 5]); w.w = pkbf(sc[kt][8 * s2 + 6], sc[kt][8 * s2 + 7]); pb[s2] = __builtin_bit_cast(bf16x8, w); }
#pragma unroll
        for (int d = 0; d < 4; ++d)
#pragma unroll
            for (int s2 = 0; s2 < 2; ++s2) o[d] = MFMA32(*(const LAS bf16x8*)(Vp + (kt * 8 + d * 2 + s2) * 1024), pb[s2], o[d]);
    }
#else
    float m = -1e30f, lsum = 0.f;
#pragma clang loop unroll(disable)
    for (int kt = 0; kt < 8; ++kt) {
        f32x16 p;
#pragma unroll
        for (int r = 0; r < 16; ++r) p[r] = 0.f;
#pragma unroll
        for (int j = 0; j < 8; ++j) p = MFMA32(*(const LAS bf16x8*)(Kp + (kt * 8 + j) * 1024), qf[j], p);
        bf16x8 pb[2]; softmax_tile<4>(p, m, lsum, o, pb);
#pragma unroll
        for (int d = 0; d < 4; ++d)
#pragma unroll
            for (int s2 = 0; s2 < 2; ++s2) o[d] = MFMA32(*(const LAS bf16x8*)(Vp + (kt * 8 + d * 2 + s2) * 1024), pb[s2], o[d]);
    }
#endif
    lsum += __shfl_xor(lsum, 32); const float inv = 1.0f / lsum;
    bf16* yp = Y + (size_t)(qb * 32 + r32) * cfg::PD + 1536 + h * 128;
#pragma unroll
    for (int d = 0; d < 4; ++d) store_o32(yp + d * 32, o[d], inv, hi);
}
__device__ __forceinline__ void swa_item_lds(Frame& F, int l, int hq, int qb, const LAS unsigned char* kv, int t0c) {
    const int lane = opaque_lane(), r32 = lane & 31, hi = lane >> 5;
    bf16* Y = (bf16*)(F.ws + WS_Y);
    const bf16* Qp = (const bf16*)(F.ws + WS_AQ) + (size_t)((hq * 256 + qb) * 4) * 512 + lane * 8;
    const LAS unsigned char* Kp = kv + lane * 16; const LAS unsigned char* Vp = kv + 49152 + lane * 16;
    const int i0 = qb < 4 ? 4 - qb : 0;
    bf16x8 qf[4];
#pragma unroll
    for (int j = 0; j < 4; ++j) qf[j] = *(const bf16x8*)(Qp + j * 512);
    f32x16 o[2];
#pragma unroll
    for (int d = 0; d < 2; ++d)
#pragma unroll
        for (int r = 0; r < 16; ++r) o[d][r] = 0.f;
    float m = F.sinks[(l - 2) * cfg::NQH + hq] * cfg::LOG2E, lsum = hi == 0 ? 1.0f : 0.0f;
#pragma clang loop unroll(disable)
    for (int i = i0; i < 5; ++i) { const int sl = qb - 4 + i - t0c;
        f32x16 p;
#pragma unroll
        for (int r = 0; r < 16; ++r) p[r] = 0.f;
#pragma unroll
        for (int j = 0; j < 4; ++j) p = MFMA32(*(const LAS bf16x8*)(Kp + (sl * 4 + j) * 1024), qf[j], p);
        if (i == 0 || i == 4) {
#pragma unroll
            for (int r = 0; r < 16; ++r) { const int jj = (r & 3) + 8 * (r >> 2) + 4 * hi; const bool ok = (i == 0) ? (jj >= r32 + 1) : (jj <= r32); p[r] = ok ? p[r] : -INFINITY; } }
        bf16x8 pb[2]; softmax_tile<2>(p, m, lsum, o, pb);
#pragma unroll
        for (int d = 0; d < 2; ++d)
#pragma unroll
            for (int s2 = 0; s2 < 2; ++s2) o[d] = MFMA32(*(const LAS bf16x8*)(Vp + (sl * 4 + d * 2 + s2) * 1024), pb[s2], o[d]);
    }
    lsum += __shfl_xor(lsum, 32); const float inv = 1.0f / lsum;
    bf16* yp = Y + (size_t)(qb * 32 + r32) * cfg::PD + hq * 64;
#pragma unroll
    for (int d = 0; d < 2; ++d) store_o32(yp + d * 32, o[d], inv, hi);
}
template <int W> __device__ __forceinline__ void poolw_run(const float* Z, bf16* Y, const float* scale, int c, int t0) {
    f32x4 z[W + 7];
#pragma unroll
    for (int k = 0; k < W + 7; ++k) { const int j = t0 - (W - 1) + k; z[k] = j >= 0 ? *(const f32x4*)(Z + (size_t)j * cfg::MIX + c) : (f32x4){0.f, 0.f, 0.f, 0.f}; }
    const f32x4 sc = *(const f32x4*)(scale + c);
    f32x4 s = z[0];
#pragma unroll
    for (int k = 1; k < W; ++k) s += z[k];
#pragma unroll
    for (int i = 0; i < 8; ++i) { const int t = t0 + i;
        if (i > 0) s += z[W - 1 + i] - z[i - 1];
        const float rc = 1.0f / (float)(t + 1 < W ? t + 1 : W); const f32x4 y = (s * rc - z[W - 1 + i]) * sc;
        v2u o; o.x = pkbf(y[0], y[1]); o.y = pkbf(y[2], y[3]); *(v2u*)(Y + (size_t)t * cfg::PD + c) = o; }
}
template <int W> __device__ __forceinline__ void poolw_run_u(const bf16* U, bf16* Y, int c, int t0) {
    f32x4 z[W + 7];
#pragma unroll
    for (int k = 0; k < W + 7; ++k) { const int j = t0 - (W - 1) + k; v2u r; r.x = 0u; r.y = 0u; if (j >= 0) r = *(const v2u*)(U + (size_t)j * cfg::PD + c);
        z[k][0] = __uint_as_float(r.x << 16); z[k][1] = __uint_as_float(r.x & 0xffff0000u); z[k][2] = __uint_as_float(r.y << 16); z[k][3] = __uint_as_float(r.y & 0xffff0000u); }
    f32x4 s = z[0];
#pragma unroll
    for (int k = 1; k < W; ++k) s += z[k];
#pragma unroll
    for (int i = 0; i < 8; ++i) { const int t = t0 + i;
        if (i > 0) s += z[W - 1 + i] - z[i - 1];
        const float rc = 1.0f / (float)(t + 1 < W ? t + 1 : W); const f32x4 y = s * rc - z[W - 1 + i];
        v2u o; o.x = pkbf(y[0], y[1]); o.y = pkbf(y[2], y[3]); *(v2u*)(Y + (size_t)t * cfg::PD + c) = o; }
}
__device__ __forceinline__ void poolw_item(Frame& F, int l, int chunk, int rb) {
    const float* Z = (const float*)(F.ws + WS_Z); bf16* Y = (bf16*)(F.ws + WS_Y);
    const int lane = opaque_lane(), g = chunk / 3, c = chunk * 128 + (lane & 31) * 4, t0 = rb * 16 + 8 * (lane >> 5);
    const float* scale = F.pool_scale + (size_t)l * cfg::MIX;
#if POOL_FOLD
    const bf16* U = (const bf16*)(F.ws + WS_AQ); (void)Z; (void)scale;
    if (g == 0) poolw_run_u<2>(U, Y, c, t0); else if (g == 1) poolw_run_u<4>(U, Y, c, t0); else if (g == 2) poolw_run_u<8>(U, Y, c, t0); else poolw_run_u<16>(U, Y, c, t0);
#else
    if (g == 0) poolw_run<2>(Z, Y, scale, c, t0); else if (g == 1) poolw_run<4>(Z, Y, scale, c, t0); else if (g == 2) poolw_run<8>(Z, Y, scale, c, t0); else poolw_run<16>(Z, Y, scale, c, t0);
#endif
}
constexpr int PH_END = 66;
__device__ __forceinline__ int probe_class(int k) { if (k == 0) return 0; if (k >= 65) return 8; const int ii = (k - 1) / 8, j = (k - 1) % 8, ll = ii >> 1; return j == 0 ? 1 : j == 1 ? 2 : j == 2 ? 3 : j == 3 ? 4 : j == 4 ? (ll < 2 ? 5 : 6) : 7; }
struct Args { const float* in[17]; float* out; unsigned char* ws; int ph_lo, ph_hi; };
__global__ void __launch_bounds__(NWAVES * 64, 2) yoco_fwd(Args args) {
    extern __shared__ __attribute__((aligned(16))) unsigned char lds[];
    using namespace cfg;
    Frame F;
    F.lds = (LAS unsigned char*)lds;
    F.MISC = (volatile LAS unsigned*)(F.lds + MISC_OFF);
    F.tid = threadIdx.x; F.lane = F.tid & 63; F.wave = __builtin_amdgcn_readfirstlane(F.tid >> 6);
    F.G = gridDim.x; { const int bx = blockIdx.x; F.vcu = (F.G % 8 == 0) ? (bx % 8) * (F.G / 8) + bx / 8 : bx; }
    F.x = args.in[0]; F.mem = args.in[1]; F.pos = (const int*)args.in[2]; F.norms = args.in[3]; F.gate = args.in[4]; F.up = args.in[5]; F.down = args.in[6]; F.w_in = args.in[7]; F.w_out = args.in[8];
    F.pool_w = args.in[9]; F.pool_scale = args.in[10]; F.w_kv = args.in[11]; F.kv_norm = args.in[12]; F.sinks = args.in[13]; F.w_mem_kv = args.in[14]; F.mem_norm = args.in[15]; F.final_norm = args.in[16];
    F.out = args.out; F.ws = args.ws;
    for (int u = F.tid; u < (LDS_BYTES - LDSCTL_OFF) / 4; u += NWAVES * 64) ((LAS unsigned*)(F.lds + LDSCTL_OFF))[u] = 0u;
    __syncthreads();
    XcdBarrier bar = xcd_barrier_post((unsigned*)(F.ws + WS_CTL) + CW_BAR, F.MISC + 8);
    const int lo = args.ph_lo, hi = args.ph_hi;
#if !PROBE
#define IN(k) (lo <= (k) && (k) < hi)
#else
#define STAMP2(k) ((blockIdx.x == 0 && threadIdx.x == 0) ? (void)__hip_atomic_store((unsigned long long*)(args.ws + 768 * 1024) + 2 * (k), (unsigned long long)__builtin_amdgcn_s_memrealtime(), __ATOMIC_RELAXED, __HIP_MEMORY_SCOPE_AGENT) : (void)0)
#endif
#if PROBE
    unsigned long long* ts = (unsigned long long*)(F.ws + 768 * 1024);
#define STAMP(slot) do { if (blockIdx.x == 0 && F.tid == 0) __hip_atomic_store(ts + (slot), (unsigned long long)__builtin_amdgcn_s_memrealtime(), __ATOMIC_RELAXED, __HIP_MEMORY_SCOPE_AGENT); } while (0)
#define SEAM(k) do { STAMP(2 * (k) + 1); if (PROBE_Q >= 0 && F.tid == 0 && probe_class(k) == PROBE_C) { const unsigned long long t1_ = __builtin_amdgcn_s_memrealtime(); const unsigned long long t0_ = ((unsigned long long)F.MISC[17] << 32) | F.MISC[16]; F.MISC[18] = __float_as_uint(__uint_as_float(F.MISC[18]) + (float)(t1_ - t0_) * 0.01f); } if ((k) + 1 < hi || PROBE) xcd_barrier(bar); } while (0)
#define IN(k) ((lo <= (k) && (k) < hi) && (STAMP2(k), STAMP3(), true))
#define SEAM_G(k) do { STAMP(2 * (k) + 1); if (GROUP_BAR) { ++gcalls; grp_barrier((unsigned*)(F.ws + WS_CTL), mypm, 8u * gcalls, grp_same_xcd); } else xcd_barrier(bar); } while (0)
#define STAMP3() ((PROBE_Q >= 0 && threadIdx.x == 0) ? (void)(tnow_ = __builtin_amdgcn_s_memrealtime(), F.MISC[16] = (unsigned)tnow_, F.MISC[17] = (unsigned)(tnow_ >> 32)) : (void)0)
    unsigned long long tnow_ = 0ull;
#else
#define SEAM_G(k) do { if ((k) + 1 < hi) { if (GROUP_BAR) { ++gcalls; grp_barrier((unsigned*)(F.ws + WS_CTL), mypm, 8u * gcalls, grp_same_xcd); } else xcd_barrier(bar); } } while (0)
#define SEAM(k) do { if ((k) + 1 < hi) { xcd_barrier(bar); if (EXPT == 5) xcd_barrier(bar); if (EXPT == 6) { const unsigned long long t0_ = __builtin_amdgcn_s_memrealtime(); while (__builtin_amdgcn_s_memrealtime() - t0_ < 5000ull) __builtin_amdgcn_s_sleep(32); } } } while (0)
#endif
    unsigned char* ws = F.ws;
    float* H = F.out; bf16* HB = (bf16*)(ws + WS_HB); float* SSQ = (float*)(ws + WS_SSQ); bf16* HFF = (bf16*)(ws + WS_HFF); bf16* AQ = (bf16*)(ws + WS_AQ); bf16* Y = (bf16*)(ws + WS_Y);
    const float* RC = (const float*)(ws + WS_ROPE_C); const float* RS = (const float*)(ws + WS_ROPE_S);
    const int bx = (int)blockIdx.x;
#define KT0(K_) ((KSTAGGER && BAL_DMA && GEMM_SP2) ? ((((bx & 7) * ((K_) / 64)) >> 3) & ~1) : 0)
    int mypm, mypn; { pg8::StaticOrder S0; S0.init(S, D, F.G, bx); pg8::Unit u0; S0.next(0, u0); mypm = u0.pm; mypn = u0.pn; }
    unsigned gcalls = 0u;
    if (GROUP_BAR && F.tid == 0) (void)__hip_atomic_fetch_or((unsigned*)(F.ws + WS_CTL) + CW_GRPX + 64 * mypm, 1u << xb_xcc_id(), __ATOMIC_RELAXED, __HIP_MEMORY_SCOPE_AGENT);
    bool grp_same_xcd = false;

    if (IN(0)) for (int rep = 0; rep < NREP(0); ++rep) { if constexpr (PHON(0)) p0_prologue(F); SEAM(0); }
    if (GROUP_BAR && lo == 0 && hi > 1) {
        const unsigned m = (unsigned)__builtin_amdgcn_readfirstlane((int)__hip_atomic_load((unsigned*)(F.ws + WS_CTL) + CW_GRPX + 64 * mypm, __ATOMIC_RELAXED, __HIP_MEMORY_SCOPE_AGENT));
        grp_same_xcd = (__builtin_popcount(m) == 1) && (GROUP_BAR != 3); }

    for (int i = 0; i < 8; ++i) {
        const int l = i >> 1, half = i & 1, base = 1 + 8 * i;
        if (IN(base)) for (int rep = 0; rep < NREP(1); ++rep) {
            const bf16* WGU = (const bf16*)(ws + WS_WGU + (size_t)i * WGU_BYTES);
            if constexpr (PHON(1)) { pg8::Gemm g{HB, WGU, PD, PD, D}; g.kt0 = KT0(D); pg8::StaticOrder S_; S_.init(S, NGU, F.G, bx); const bool split_tail = (HALFTAIL || SPLITK_TAIL) && i != 0 && i != 4; if (split_tail) S_.maxr = 5; pg8::EpiSwiGLU E{HFF, SSQ, 0};
#if RSTD_LDS
              if (GROUP_BAR) { LAS float* rt_ = (LAS float*)(F.lds + RSTD_TAB_OFF); if (F.tid < 256) rt_[F.tid] = pg8::rstd_of(SSQ, 256 * mypm + F.tid); __syncthreads(); E.rtab = rt_; E.rtab_pm = mypm; }
#endif
#if EXPT
              if (rep) { int ns_ = 1; asm volatile("" : "+s"(ns_)); E.nostore = ns_; S_.flat = (EXPT == 2 || EXPT == 3); if (EXPT == 3) g.A = (const bf16*)(ws + WS_END); }
#endif
#if EXPT == 7 || EXPT == 8
              if (rep) pg8::gemm_phase<pg8::EpiSwiGLU, pg8::StaticOrder, true, GEMM_SP2, false, EXPT - 6>(F.lds + RING_OFF, g, S_, E); else
#endif
#if STAGGER_TICKS
              if (i != 0 && i != 4) { pg8::Unit tu_; if (!S_.next(5, tu_)) { const unsigned long long t0_ = __builtin_amdgcn_s_memrealtime(); while (__builtin_amdgcn_s_memrealtime() - t0_ < (unsigned long long)STAGGER_TICKS) __builtin_amdgcn_s_sleep(16); } }
#endif
              pg8::gemm_phase<pg8::EpiSwiGLU, pg8::StaticOrder, true, GEMM_SP2>(F.lds + RING_OFF, g, S_, E);
#if SPLITK_TAIL
              if (split_tail) {
                  const int j = mypn & 3, role = mypn >> 2, pair = mypm * 4 + j;
                  pg8::Gemm g2{HB + role * 1024, WGU + role * 1024, PD, PD, D / 2}; pg8::OneUnitOrder S2{mypm, 40 + j};
                  pg8::EpiSwiGLUSplit E2{HFF, SSQ, (float*)(ws + WS_SPL + (size_t)pair * 262144), (unsigned*)(ws + WS_CTL) + CW_SPL + 64 * pair, (unsigned*)(ws + WS_CTL) + CW_BAR + XB_TMO, (unsigned)(i < 4 ? i : i - 1), role, grp_same_xcd ? 1 : 0};
                  pg8::gemm_phase<pg8::EpiSwiGLUSplit, pg8::OneUnitOrder, false, GEMM_SP2>(F.lds + RING_OFF, g2, S2, E2); }
#endif
#if HALFTAIL
              if (split_tail) {
                  pg8::StaticOrder S2; S2.init(S, NGU, F.G, bx); S2.halftail = (HALFTAIL == 1); S2.r0 = 5; S2.maxr = 1;
                  pg8::gemm_phase<pg8::EpiSwiGLU, pg8::StaticOrder, false, GEMM_SP2, true>(F.lds + RING_OFF, g, S2, E); }
#endif
              }
            if constexpr (PHON(2)) if (i == 0) {
                pg8::Gemm g{(const bf16*)(ws + WS_MEMN), (const bf16*)(ws + WS_WMKV), PD, PD, D}; g.kt0 = KT0(D); pg8::SubsetOrder S_{128, 16, 16, bx}; pg8::EpiMemKV E{(bf16*)(ws + WS_MK), (bf16*)(ws + WS_MVT)};
                pg8::gemm_phase<pg8::EpiMemKV, pg8::SubsetOrder, false, GEMM_SP2>(F.lds + RING_OFF, g, S_, E); }
            if constexpr (PHON(3)) if (i == 4) {
                pg8::Gemm g{HB, WGU + (size_t)NGU * PD, PD, PD, D}; g.kt0 = KT0(D); pg8::SubsetOrder S_{0, 64, 2, (OWN_KV && (mypn == 4 || mypn == 5)) ? 2 * mypm + (mypn - 4) : (OWN_KV ? -1 : bx - 128)};   pg8::EpiKV E{(bf16*)(ws + WS_KB), (bf16*)(ws + WS_VT), SSQ, RC, RS};
                pg8::gemm_phase<pg8::EpiKV, pg8::SubsetOrder, false, GEMM_SP2>(F.lds + RING_OFF, g, S_, E); }
#if POOL_FOLD
            if (i < 2 && rep == 0) {
                pg8::Gemm g{(const bf16*)(ws + WS_WOUT + (size_t)i * WIO_BYTES), (const bf16*)(ws + WS_WPS) + (size_t)i * 2048 * 384, PD, 384, 384}; g.kt0 = 0;
                pg8::SubsetPoolOrder S_{i == 0 ? 144 : 128, 64, 8, bx}; pg8::EpiFold E{(bf16*)(ws + WS_WOUT2 + (size_t)i * WIO_BYTES)};
                pg8::gemm_phase<pg8::EpiFold, pg8::SubsetPoolOrder, false, GEMM_SP2>(F.lds + RING_OFF, g, S_, E); }
#endif
            if (rep == 0) conv_tail(F, i);
            SEAM_G(base);
        }
        if (IN(base + 1)) for (int rep = 0; rep < NREP(2); ++rep) {
            pg8::Gemm g{HFF, (const bf16*)(ws + WS_WD + (size_t)i * WD_BYTES), PF, PF, FF}; g.kt0 = KT0(FF); pg8::StaticOrder S_; S_.init(S, D, F.G, bx);
            pg8::EpiResid E{(i == 0 && rep == 0) ? F.x : nullptr, HB, (bf16*)(ws + WS_HL), SSQ, rep ? 0.0f : 0.5f, (EXPT == 4 && rep) ? 1 : 0};
            if constexpr (PHON(4)) pg8::gemm_phase<pg8::EpiResid, pg8::StaticOrder, false, GEMM_SP2>(F.lds + RING_OFF, g, S_, E);
            if (i == 4 || (!OWN_KV && i == 3) || (!OWN_FINAL && i == 7)) SEAM(base + 1); else SEAM_G(base + 1);
        }
        if (half == 0) {
            if (IN(base + 2)) for (int rep = 0; rep < NREP(3); ++rep) {
                pg8::Gemm g{HB, (const bf16*)(ws + WS_WIN + (size_t)l * WIO_BYTES), PD, PD, D}; g.kt0 = KT0(D); pg8::StaticOrder S_; S_.init(S, D, F.G, bx);
                pg8::EpiWin E{AQ, (bf16*)(ws + WS_QMF), SSQ, RC, RS, l >= 2 ? 1 : 0};
                if constexpr (PHON(5)) pg8::gemm_phase<pg8::EpiWin, pg8::StaticOrder, false, GEMM_SP2>(F.lds + RING_OFF, g, S_, E);
#if FUSE_SWA_MIX
                if (l >= 2) {
                    pg8::Unit u; S_.next(0, u);
                    asm volatile("s_waitcnt vmcnt(0)" ::: "memory");
#if LDS_KV
                    const LAS unsigned char* kvl = (const LAS unsigned char*)(F.lds + RING_OFF);
                    if (u.pn < 6) {
                        const int kvh = u.pn >> 1, t0c = (8 * u.pm - 4) < 0 ? 0 : 8 * u.pm - 4;
                        stage_lds(F, (const bf16*)(ws + WS_KB) + (size_t)((kvh * 256 + t0c) * 4) * 512, RING_OFF, 49152);
                        stage_lds(F, (const bf16*)(ws + WS_VT) + (size_t)((kvh * 256 + t0c) * 4) * 512, RING_OFF + 49152, 49152);
                        asm volatile("s_waitcnt vmcnt(0)" ::: "memory"); __syncthreads();
                        if constexpr (PHON(7)) for (int hh = 0; hh < 4; ++hh) swa_item_lds(F, l, 4 * u.pn + hh, 8 * u.pm + F.wave, kvl, t0c);
                    } else {
                        for (int hb = 0; hb < 2; ++hb) { const int h = 2 * (u.pn - 6) + hb;
                            if (hb) __syncthreads();
                            stage_lds(F, (const bf16*)(ws + WS_MK) + (size_t)((l * 4 + h) * 64) * 512, RING_OFF, 65536);
                            stage_lds(F, (const bf16*)(ws + WS_MVT) + (size_t)((l * 4 + h) * 64) * 512, RING_OFF + 65536, 65536);
                            asm volatile("s_waitcnt vmcnt(0)" ::: "memory"); __syncthreads();
                            if constexpr (PHON(7)) mem_item_lds(F, h, 8 * u.pm + F.wave, kvl); }
                    }
#else
                    if (F.tid == 0) F.MISC[0] = 0u;
                    __syncthreads();
                    const int nit = u.pn < 6 ? 32 : 16;
                    if constexpr (PHON(7)) for (;;) {
                        unsigned idx = 0u;
                        if (F.lane == 0) idx = __hip_atomic_fetch_add((LAS unsigned*)(F.lds + MISC_OFF), 1u, __ATOMIC_RELAXED, __HIP_MEMORY_SCOPE_WORKGROUP);
                        idx = (unsigned)__builtin_amdgcn_readfirstlane((int)idx);
                        if ((int)idx >= nit) break;
                        if (u.pn < 6) swa_item(F, l, 4 * u.pn + ((int)idx >> 3), 8 * u.pm + ((int)idx & 7));
                        else mem_item(F, l, 2 * (u.pn - 6) + ((int)idx >> 3), 8 * u.pm + ((int)idx & 7));
                    }
#endif
                }
#endif
                if (POOL_FOLD && l < 2) SEAM(base + 2); else SEAM_G(base + 2);
            }
            if (!POOL_FOLD && l < 2 && IN(base + 3)) for (int rep = 0; rep < NREP(4); ++rep) {
                pg8::Gemm g{AQ, (const bf16*)(ws + WS_WPOOL) + (size_t)l * 2048 * 384, PD, 384, 384}; g.kt0 = KT0(384); pg8::PoolOrder S_; S_.init(S, D, F.G, bx);
                pg8::EpiPool E{(float*)(ws + WS_Z)};
                if constexpr (PHON(6)) pg8::gemm_phase<pg8::EpiPool, pg8::PoolOrder, false, GEMM_SP2>(F.lds + RING_OFF, g, S_, E);
                SEAM(base + 3);
            }
            if ((l < 2 || !FUSE_SWA_MIX) && IN(base + 4)) for (int rep = 0; rep < (l < 2 ? NREP(5) : NREP(6)); ++rep) {
                if (F.tid == 0) F.MISC[0] = 0u;
#if LDS_KV
                {
                    const int h = OWN_POOLMIX ? (mypn & 3) : (F.vcu & 3);
                    stage_lds(F, (const bf16*)(ws + WS_MK) + (size_t)((l * 4 + h) * 64) * 512, RING_OFF, 65536);
                    stage_lds(F, (const bf16*)(ws + WS_MVT) + (size_t)((l * 4 + h) * 64) * 512, RING_OFF + 65536, 65536);
                    asm volatile("s_waitcnt vmcnt(0)" ::: "memory"); }
#endif
                __syncthreads();
                const int nit = 28;
                if constexpr (PHON(7)) for (;;) {
                    unsigned idx = 0u;
                    if (F.lane == 0) idx = __hip_atomic_fetch_add((LAS unsigned*)(F.lds + MISC_OFF), 1u, __ATOMIC_RELAXED, __HIP_MEMORY_SCOPE_WORKGROUP);
                    idx = (unsigned)__builtin_amdgcn_readfirstlane((int)idx);
                    if ((int)idx >= nit) break;
#if MIXEXP
                    if (rep && ((MIXEXP == 1) != (idx < 4u))) continue;
#endif
                    if (idx < 4u) { if (LDS_KV) mem_item_lds(F, OWN_POOLMIX ? (mypn & 3) : (F.vcu & 3), (OWN_POOLMIX ? 8 * mypm + 4 * (mypn >> 2) : 4 * (F.vcu >> 2)) + (int)idx, (const LAS unsigned char*)(F.lds + RING_OFF)); else if (OWN_POOLMIX) { const int e = 4 * mypn + (int)idx; mem_item(F, l, e >> 3, 8 * mypm + (e & 7)); } else mem_item(F, l, (int)idx, F.vcu); }
                    else if (l < 2) { if (OWN_POOLMIX) { const int e = 24 * mypn + (int)idx - 4; poolw_item(F, l, e % 12, 16 * mypm + e / 12); } else { const int item = 24 * F.vcu + (int)idx - 4; poolw_item(F, l, item % 12, item / 12); } }
                    else { const int k = (int)idx - 4, p = 3 * F.vcu + (k >> 3); swa_item(F, l, (p >> 8) * 8 + (k & 7), p & 255); }
                }
                if (OWN_POOLMIX) SEAM_G(base + 4); else SEAM(base + 4);
            }
            if (IN(base + 5)) for (int rep = 0; rep < NREP(7); ++rep) {
                pg8::Gemm g{Y, (const bf16*)(ws + ((POOL_FOLD && l < 2) ? WS_WOUT2 : WS_WOUT) + (size_t)l * WIO_BYTES), PD, PD, D}; g.kt0 = KT0(D); pg8::StaticOrder S_; S_.init(S, D, F.G, bx);
                pg8::EpiResid E{nullptr, HB, (bf16*)(ws + WS_HL), SSQ, rep ? 0.0f : 1.0f, 0};
                if constexpr (PHON(8)) pg8::gemm_phase<pg8::EpiResid, pg8::StaticOrder, false, GEMM_SP2>(F.lds + RING_OFF, g, S_, E);
                SEAM_G(base + 5);
            }
        }
    }
    if (IN(65)) {
#if OWN_FINAL
        { const int c = 256 * mypn + 4 * F.lane; const f32x4 gg = *(const f32x4*)(F.final_norm + c);
          for (int r0 = F.wave * 32; r0 < F.wave * 32 + 32; r0 += 8) { v2u ra[8], rb[8]; float rs[8];
#pragma unroll
              for (int j = 0; j < 8; ++j) { const int m = 256 * mypm + r0 + j; ra[j] = *(const v2u*)(HB + (size_t)m * PD + c); rb[j] = *(const v2u*)((const bf16*)(ws + WS_HL) + (size_t)m * PD + c); }
#pragma unroll
              for (int j = 0; j < 8; ++j) rs[j] = pg8::rstd_of(SSQ, 256 * mypm + r0 + j);
              asm volatile("" ::: "memory");
#pragma unroll
              for (int j = 0; j < 8; ++j) { const int m = 256 * mypm + r0 + j; const v2u a = ra[j], b = rb[j]; f32x4 h;
                  h[0] = __uint_as_float(a.x << 16) + __uint_as_float(b.x << 16); h[1] = __uint_as_float(a.x & 0xffff0000u) + __uint_as_float(b.x & 0xffff0000u);
                  h[2] = __uint_as_float(a.y << 16) + __uint_as_float(b.y << 16); h[3] = __uint_as_float(a.y & 0xffff0000u) + __uint_as_float(b.y & 0xffff0000u);
                  *(f32x4*)(H + (size_t)m * D + c) = h * rs[j] * gg; } } }
#else
        const int gw = F.vcu * NWAVES + F.wave, NGW = F.G * NWAVES;
        f32x4 gn[8];
#pragma unroll
        for (int j = 0; j < 8; ++j) gn[j] = ((const f32x4*)F.final_norm + F.lane)[64 * j];
        for (int m = gw; m < S; m += NGW) { const float rs = pg8::rstd_of(SSQ, m); f32x4* hr = (f32x4*)(H + (size_t)m * D) + F.lane;
            const v2u* hb = (const v2u*)(HB + (size_t)m * PD) + F.lane; const v2u* hl = (const v2u*)((const bf16*)(ws + WS_HL) + (size_t)m * PD) + F.lane;
            v2u ra[8], rb[8];
#pragma unroll
            for (int j = 0; j < 8; ++j) { ra[j] = hb[64 * j]; rb[j] = hl[64 * j]; }
            asm volatile("" ::: "memory");
#pragma unroll
            for (int j = 0; j < 8; ++j) { const v2u a = ra[j], b = rb[j]; f32x4 h;
                h[0] = __uint_as_float(a.x << 16) + __uint_as_float(b.x << 16); h[1] = __uint_as_float(a.x & 0xffff0000u) + __uint_as_float(b.x & 0xffff0000u);
                h[2] = __uint_as_float(a.y << 16) + __uint_as_float(b.y << 16); h[3] = __uint_as_float(a.y & 0xffff0000u) + __uint_as_float(b.y & 0xffff0000u);
                hr[64 * j] = h * rs * gn[j]; } }
#endif
#if PROBE
        if (F.tid == 0) __hip_atomic_store((unsigned*)(F.ws + 896 * 1024) + blockIdx.x, (unsigned)F.MISC[18], __ATOMIC_RELAXED, __HIP_MEMORY_SCOPE_AGENT);
        SEAM(65);
        if (blockIdx.x == 0 && F.tid == 0 && PROBE_Q >= 0) {
            float mx = -1.f, mn = 1e30f; int amx = 0, amn = 0;
            for (int b = 0; b < (int)gridDim.x; ++b) { const float v = __uint_as_float(__hip_atomic_load((unsigned*)(F.ws + 896 * 1024) + b, __ATOMIC_RELAXED, __HIP_MEMORY_SCOPE_AGENT)); if (v > mx) { mx = v; amx = b; } if (v < mn) { mn = v; amn = b; } }
            float val = 0.f;
            if (PROBE_Q == 0) val = mx * (1.0f / PROBE_SA); else if (PROBE_Q == 1) val = mn * (1.0f / PROBE_SA); else if (PROBE_Q == 2) val = (float)(amx % 8 + 1); else if (PROBE_Q == 3) val = (float)(amx / 8) * 0.25f + 1.0f; else if (PROBE_Q == 4) val = (float)(amn % 8 + 1); else val = (float)(amn / 8) * 0.25f + 1.0f;
            H[0] += val;
        }
        if (blockIdx.x == 0 && F.tid == 0 && PROBE_Q < 0) {
            float wallA = 0.f, wallB = 0.f;
            unsigned long long prev_start = 0ull; int prev_cls = -1;
            for (int k = 0; k <= 66; ++k) {
                bool ex = (k == 0 || k == 65 || k == 66); int c = (k == 0) ? 0 : 8;
                if (k >= 1 && k <= 64) { const int ii = (k - 1) / 8, j = (k - 1) % 8, ll = ii >> 1; ex = (j <= 1) || (!(ii & 1) && (j == 3 ? ll < 2 : (j == 4 ? (ll < 2 || !FUSE_SWA_MIX) : j <= 5))); c = j == 0 ? 1 : j == 1 ? 2 : j == 2 ? 3 : j == 3 ? 4 : j == 4 ? (ll < 2 ? 5 : 6) : 7; }
                if (!ex) continue;
                const unsigned long long st = (k == 66) ? __hip_atomic_load(ts + 2 * 65 + 1, __ATOMIC_RELAXED, __HIP_MEMORY_SCOPE_AGENT) : __hip_atomic_load(ts + 2 * k, __ATOMIC_RELAXED, __HIP_MEMORY_SCOPE_AGENT);
                if (prev_cls >= 0) { const float us = (float)(st - prev_start) * 0.01f; if (prev_cls == PROBE_A) wallA += us; if (prev_cls == PROBE_B) wallB += us; }
                if (k < 66) { const unsigned long long en = __hip_atomic_load(ts + 2 * k + 1, __ATOMIC_RELAXED, __HIP_MEMORY_SCOPE_AGENT); const float own = (float)(en - st) * 0.01f; if (c + 10 == PROBE_A) wallA += own; if (c + 10 == PROBE_B) wallB += own; }
                prev_start = st; prev_cls = c;
            }
            H[0] += wallA * (1.0f / PROBE_SA);
            const float vb = wallB * (1.0f / PROBE_SB);
            if (vb != 0.f) for (int j = 1; j <= 65536; ++j) H[j] += vb;
        }
#endif
    }
#undef IN
#undef SEAM
}

static int g_grid = 0;
static bool setup_grid() {
    if (g_grid != 0) return g_grid > 0;
    int dev = 0, cus = 0, per_cu = 0;
    if (hipGetDevice(&dev) != hipSuccess || hipDeviceGetAttribute(&cus, hipDeviceAttributeMultiprocessorCount, dev) != hipSuccess) { fprintf(stderr, "kernel_launch: device query failed\n"); g_grid = -1; return false; }
    if (hipFuncSetAttribute((const void*)yoco_fwd, hipFuncAttributeMaxDynamicSharedMemorySize, LDS_BYTES) != hipSuccess) { fprintf(stderr, "kernel_launch: hipFuncSetAttribute failed\n"); g_grid = -1; return false; }
    if (hipOccupancyMaxActiveBlocksPerMultiprocessor(&per_cu, (const void*)yoco_fwd, NWAVES * 64, LDS_BYTES) != hipSuccess || per_cu < 1) { fprintf(stderr, "kernel_launch: occupancy query reports %d workgroups per CU\n", per_cu); }
    (void)hipGetLastError();
    g_grid = cus;
    return true;
}
static void launch_phases(hipStream_t stream, void* const* d_in, void* d_out, void* d_ws, int lo, int hi) {
    Args a{};
    for (int i = 0; i < 17; ++i) a.in[i] = (const float*)d_in[i];
    a.out = (float*)d_out; a.ws = (unsigned char*)d_ws; a.ph_lo = lo; a.ph_hi = hi;
    hipLaunchKernelGGL(yoco_fwd, dim3(g_grid), dim3(NWAVES * 64), LDS_BYTES, stream, a);
}
static bool phase_exists(int k) {
    if (k == 0 || k == 65) return true;
    if (k < 1 || k > 64) return false;
    const int i = (k - 1) / 8, j = (k - 1) % 8, l = i >> 1;
    if (j <= 1) return true;
    if (i & 1) return false;
    if (j == 3) return l < 2;
    if (j == 4) return l < 2 || !FUSE_SWA_MIX;
    return j <= 5;
}
#if DBG
namespace dbg {
template <int FT  , int TR  >
__global__ void __launch_bounds__(256) k_cmp(const void* fast, long fld, const float* orc, long old, int rows, int cols, float fscale, unsigned* res) {
    float md = 0.f, mr = 0.f;
    const size_t n = (size_t)rows * cols;
    for (size_t idx = (size_t)blockIdx.x * 256 + threadIdx.x; idx < n; idx += (size_t)gridDim.x * 256) {
        const int r = (int)(idx / cols), c = (int)(idx % cols);
        const float o = orc[(size_t)r * old + c] * fscale;
        const size_t fo = TR ? (size_t)c * fld + r : (size_t)r * fld + c;
        float f;
        if (FT) { const unsigned short b = ((const unsigned short*)fast)[fo]; f = __uint_as_float((unsigned)b << 16); } else f = ((const float*)fast)[fo];
        float d = fabsf(f - o); if (!(d == d) || d > 1e30f) d = 1e30f;
        md = fmaxf(md, d); mr = fmaxf(mr, fabsf(o));
    }
#pragma unroll
    for (int o = 1; o < 64; o <<= 1) { md = fmaxf(md, __shfl_xor(md, o)); mr = fmaxf(mr, __shfl_xor(mr, o)); }
    if ((threadIdx.x & 63) == 0) { atomicMax(res, __float_as_uint(md)); atomicMax(res + 1, __float_as_uint(mr)); }
}
__global__ void __launch_bounds__(1024) k_report(const unsigned* res, int n, float tol, float* out) {
    __shared__ int first; __shared__ float ratio;
    if (threadIdx.x == 0) { first = -1; ratio = 0.f;
        for (int i = 1; i < n; ++i) { const float d = __uint_as_float(res[2 * i]), r = fmaxf(__uint_as_float(res[2 * i + 1]), 1e-20f); if (d > tol * r) { first = i; ratio = d / r; break; } } }
    __syncthreads();
    if (first >= 0) { const float V = 100.0f * (float)first; int nbad = (int)(fminf(ratio, 1000.f) * 1000.f); nbad = nbad < 1 ? 1 : nbad;
        for (int j = threadIdx.x; j < nbad; j += 1024) out[j] = V; }
}
struct Ctx { hipStream_t st; unsigned* res; };
template <int FT, int TR> static void cmp(const Ctx& c, int id, const void* fast, long fld, const float* orc, long old, int rows, int cols, float fscale = 1.f) {
    hipLaunchKernelGGL((k_cmp<FT, TR>), dim3(2048), dim3(256), 0, c.st, fast, fld, orc, old, rows, cols, fscale, c.res + 2 * id);
}
static void run(hipStream_t st, void* const* d_in, void* d_out, void* d_ws, const ref::In& in) {
    using namespace ref;
    unsigned char* ws = (unsigned char*)d_ws;
    unsigned* res = (unsigned*)(ws + 512 * 1024);
    Ctx c{st, res};
    float* ob = (float*)(ws + WS_END);
    float* Ho = ob; float* XN = Ho + (size_t)S * D; float* G = XN + (size_t)S * D; float* U = G + (size_t)S * FF; float* A = U; float* Yo = U + (size_t)S * D; float* DIFF = U + (size_t)2 * S * D;
    float* KV = U + (size_t)S * FF; float* MEMN = KV + (size_t)S * 384; float* MKV = MEMN + (size_t)ML * D;
    const unsigned short* HBf = (const unsigned short*)(ws + WS_HB); const unsigned short* HFFf = (const unsigned short*)(ws + WS_HFF); const unsigned short* AQf = (const unsigned short*)(ws + WS_AQ); const unsigned short* Yf = (const unsigned short*)(ws + WS_Y);
    auto fast = [&](int k) { launch_phases(st, d_in, d_out, d_ws, k, k + 1); };
    hipLaunchKernelGGL(k_rmsnorm, dim3(ML / 4), dim3(256), 0, st, in.mem, in.mem_norm, MEMN, ML, D);
    fast(0);
    cmp<1, 0>(c, 1, ws + WS_MEMN, cfg::PD, MEMN, D, ML, D);
    cmp<1, 0>(c, 2, HBf, cfg::PD, in.x, D, S, D);
    const float* hin = in.x;
    for (int l = 0; l < DEPTH; ++l) {
        const int idb = 5 + 20 * l;
        for (int half = 0; half < 2; ++half) {
            const int i = 2 * l + half, base = 1 + 8 * i;
            hipLaunchKernelGGL(k_rmsnorm, dim3(S / 4), dim3(256), 0, st, hin, in.norms + (size_t)(l * 3 + (half ? 2 : 0)) * D, XN, S, D);
            const size_t wo = (size_t)i * D * FF;
            gemm<0>(st, XN, D, in.gate + wo, FF, G, FF, S, FF, D);
            gemm<0>(st, XN, D, in.up + wo, FF, U, FF, S, FF, D);
            hipLaunchKernelGGL(k_swiglu, dim3(4096), dim3(256), 0, st, G, U, (size_t)S * FF / 4);
            fast(base);
            cmp<1, 0>(c, idb + (half ? 13 : 1), HFFf, cfg::PF, G, FF, S, FF);
            gemm<1>(st, G, FF, in.down + wo, D, Ho, D, S, D, FF, hin, 0.5f);
            hin = Ho;
            fast(base + 1);
            cmp<1, 0>(c, idb + (half ? 15 : 5), HBf, cfg::PD, Ho, D, S, D);
            if (half == 1) break;
            hipLaunchKernelGGL(k_rmsnorm, dim3(S / 4), dim3(256), 0, st, Ho, in.norms + (size_t)(l * 3 + 1) * D, XN, S, D);
            gemm<0>(st, XN, D, in.w_in + (size_t)l * D * D, D, A, D, S, D, D);
            fast(base + 2);
            if (l >= NA) hipLaunchKernelGGL(k_rope, dim3(S * NQH * 32 / 256), dim3(256), 0, st, A, D, NQH, in.pos);
            if (l < NA) cmp<1, 0>(c, idb + 6, AQf, cfg::PD, A, D, S, MIX, 1.f);
            if (l < NA) {
                hipLaunchKernelGGL(k_pool_diff, dim3(S * MIX / 256), dim3(256), 0, st, A, D, DIFF);
                for (int g = 0; g < 4; ++g) gemm<2>(st, DIFF + g * CG, MIX, in.pool_w + (size_t)(l * 4 + g) * CG * CG, CG, Yo + g * CG, D, S, CG, CG, nullptr, 1.f, in.pool_scale + (size_t)l * MIX + g * CG);
                fast(base + 3);
            } else {
                hipLaunchKernelGGL(k_swa, dim3(S * NQH / 4), dim3(256), 0, st, A, D, KV, 384, in.sinks + (size_t)(l - NA) * NQH, Yo, D);
            }
            gemm<0>(st, MEMN, D, in.w_mem_kv + (size_t)l * D * 1024, 1024, MKV, 1024, ML, 1024, D);
            hipLaunchKernelGGL(k_memattn, dim3(S * MH / 4), dim3(256), 0, st, A, D, MKV, Yo, D);
            fast(base + 4);
            cmp<1, 0>(c, idb + 10, Yf, cfg::PD, Yo, D, S, MIX);
            cmp<1, 0>(c, idb + 11, Yf + MIX, cfg::PD, Yo + MIX, D, S, 512);
            gemm<1>(st, Yo, D, in.w_out + (size_t)l * D * D, D, Ho, D, S, D, D, Ho, 1.0f);
            fast(base + 5);
        }
        if (l == NA - 1) {
            hipLaunchKernelGGL(k_rmsnorm, dim3(S / 4), dim3(256), 0, st, Ho, in.kv_norm, XN, S, D);
            gemm<0>(st, XN, D, in.w_kv, 384, KV, 384, S, 384, D);
            hipLaunchKernelGGL(k_rope, dim3(S * NKVH * 32 / 256), dim3(256), 0, st, KV, 384, NKVH, in.pos);
        }
    }
    hipLaunchKernelGGL(k_rmsnorm, dim3(S / 4), dim3(256), 0, st, Ho, in.final_norm, XN, S, D);
    fast(65);
    cmp<0, 0>(c, 90, d_out, D, XN, D, S, D);
    hipLaunchKernelGGL(k_report, dim3(1), dim3(1024), 0, st, res, 100, 0.05f, (float*)d_out);
}
}
#endif

extern "C" void kernel_launch(void* const* d_in, const int* in_sizes, int n_in, void* d_out, int out_size, void* d_ws, size_t ws_size, hipStream_t stream) {
    const size_t need = DBG ? WS_END + (size_t)495 * MiB : WS_END;
    if (n_in != 17 || out_size != cfg::S * cfg::D || ws_size < need) { fprintf(stderr, "kernel_launch: unexpected shapes n_in %d out %d ws %zu (need %zu)\n", n_in, out_size, ws_size, need); return; }
    if (!setup_grid()) return;
#if EXPT == 3
    (void)hipMemsetAsync((char*)d_ws + WS_END, 0, 2 * MiB, stream);
#endif
    if (hipMemsetAsync((char*)d_ws + WS_CTL, 0, CTL_ZERO_BYTES, stream) != hipSuccess) { fprintf(stderr, "kernel_launch: hipMemsetAsync failed\n"); return; }
#if DBG
    ref::In in;
    in.x = (const float*)d_in[0]; in.mem = (const float*)d_in[1]; in.pos = (const int*)d_in[2]; in.norms = (const float*)d_in[3];
    in.gate = (const float*)d_in[4]; in.up = (const float*)d_in[5]; in.down = (const float*)d_in[6]; in.w_in = (const float*)d_in[7]; in.w_out = (const float*)d_in[8];
    in.pool_w = (const float*)d_in[9]; in.pool_scale = (const float*)d_in[10]; in.w_kv = (const float*)d_in[11]; in.kv_norm = (const float*)d_in[12]; in.sinks = (const float*)d_in[13];
    in.w_mem_kv = (const float*)d_in[14]; in.mem_norm = (const float*)d_in[15]; in.final_norm = (const float*)d_in[16];
    dbg::run(stream, d_in, d_out, d_ws, in);
#elif defined(SPLIT_PHASES)
    for (int k = 0; k < PH_END; ++k) if (phase_exists(k)) launch_phases(stream, d_in, d_out, d_ws, k, k + 1);
#else
    launch_phases(stream, d_in, d_out, d_ws, 0, PH_END);
#endif
}
```

```cpp
#include <hip/hip_runtime.h>
#include <cstdio>
#include <cstdint>
#ifndef DBG
#define DBG 0
#endif
#ifndef PHMASK
#define PHMASK 0xFFFF
#endif
#define PHON(b) ((PHMASK >> (b)) & 1)
#ifndef REPMASK
#define REPMASK 0
#endif
#define NREP(c) (((REPMASK >> (c)) & 1) ? 2 : 1)
#ifndef EXPT
#define EXPT 0
#endif
#ifndef MIXEXP
#define MIXEXP 0
#endif
#ifndef HALFTAIL
#define HALFTAIL 0
#endif
#ifndef WT_STORES
#define WT_STORES 0
#endif
#ifndef CONV_NT
#define CONV_NT 0
#endif
#ifndef H_NT
#define H_NT 0
#endif
#ifndef GEMM_SP2
#define GEMM_SP2 true
#endif
#ifndef EARLY_WB
#define EARLY_WB 0
#endif
#ifndef LOOP_ALIGN
#define LOOP_ALIGN 0
#endif
#ifndef L2WARM
#define L2WARM 0
#endif
#ifndef BAL_DMA
#define BAL_DMA 1
#endif
#ifndef FUSE_SWA_MIX
#define FUSE_SWA_MIX 1
#endif
#ifndef GROUP_BAR
#define GROUP_BAR 1
#endif
#ifndef OWN_KV
#define OWN_KV 0
#endif
#ifndef OWN_POOLMIX
#define OWN_POOLMIX 1
#endif
#ifndef OWN_FINAL
#define OWN_FINAL 0
#endif
#ifndef B_NT_AUX
#define B_NT_AUX 0
#endif
#ifndef EARLY_ACQ
#define EARLY_ACQ 0
#endif
#ifndef SPLITK_TAIL
#define SPLITK_TAIL 0
#endif
#ifndef LDS_KV
#define LDS_KV 1
#endif
#ifndef ONEPASS_LDS
#define ONEPASS_LDS 0
#endif
#ifndef MMA_ORDER
#define MMA_ORDER 0
#endif
#ifndef CONV_REVERSE
#define CONV_REVERSE 1
#endif
#ifndef KSTAGGER
#define KSTAGGER 0
#endif
#ifndef MMA_SETPRIO
#define MMA_SETPRIO 1
#endif
#ifndef MMA_PRIO
#define MMA_PRIO 1
#endif
#ifndef DMA_SPLIT35
#define DMA_SPLIT35 0
#endif
#ifndef STAGE_AFTER_L
#define STAGE_AFTER_L 0
#endif
#ifndef STAGGER_TICKS
#define STAGGER_TICKS 0
#endif
#ifndef RESID_BATCH
#define RESID_BATCH 4
#endif
#ifndef RSTD_LDS
#define RSTD_LDS 0
#endif
#ifndef POOL_FOLD
#define POOL_FOLD 1
#endif
#ifndef FINAL_FUSED
#define FINAL_FUSED 1
#endif
#ifndef STAGE_FIRST
#define STAGE_FIRST 0
#endif
#ifndef PROBE
#define PROBE 0
#endif
#ifndef PROBE_SA
#define PROBE_SA 64.0f
#endif
#ifndef PROBE_SB
#define PROBE_SB 640.0f
#endif
#ifndef PROBE_C
#define PROBE_C 2
#endif
#ifndef PROBE_Q
#define PROBE_Q -1
#endif
#ifndef PROBE_A
#define PROBE_A 1
#endif
#ifndef PROBE_B
#define PROBE_B 2
#endif
#if DBG
namespace ref {
constexpr int S = 8192, D = 2048, FF = 5632, DEPTH = 4, NA = 2, MIX = 1536, MEMW = 512, CG = 384, NQH = 24, NKVH = 3, HD = 64, WIN = 128, ML = 256, MH = 4, MHD = 128;
constexpr float EPS = 1e-5f;
typedef float f32x16 __attribute__((ext_vector_type(16)));

__device__ __forceinline__ float wave_sum(float v) {
#pragma unroll
    for (int o = 1; o < 64; o <<= 1) v += __shfl_xor(v, o);
    return v;
}
__device__ __forceinline__ float wave_max(float v) {
#pragma unroll
    for (int o = 1; o < 64; o <<= 1) v = fmaxf(v, __shfl_xor(v, o));
    return v;
}

__global__ void __launch_bounds__(256) k_rmsnorm(const float* __restrict__ x, const float* __restrict__ g, float* __restrict__ out, int nrows, int ncols) {
    const int row = blockIdx.x * 4 + (threadIdx.x >> 6), lane = threadIdx.x & 63;
    if (row >= nrows) return;
    const float* xr = x + (size_t)row * ncols; float* o = out + (size_t)row * ncols;
    float s = 0.f;
    for (int c = lane * 4; c < ncols; c += 256) { const float4 v = *(const float4*)(xr + c); s += v.x * v.x + v.y * v.y + v.z * v.z + v.w * v.w; }
    s = wave_sum(s);
    const float r = rsqrtf(s / (float)ncols + EPS);
    for (int c = lane * 4; c < ncols; c += 256) { const float4 v = *(const float4*)(xr + c); const float4 gg = *(const float4*)(g + c);
        float4 w; w.x = v.x * r * gg.x; w.y = v.y * r * gg.y; w.z = v.z * r * gg.z; w.w = v.w * r * gg.w; *(float4*)(o + c) = w; }
}

template <int EPI>
__global__ void __launch_bounds__(256) k_gemm(const float* __restrict__ A, int lda, const float* __restrict__ B, int ldb, float* C, int ldc, int K,
                                              const float* R, float alpha, const float* __restrict__ colscale) {
    __shared__ float As[16][132];
    __shared__ float Bs[16][132];
    const int t = threadIdx.x, lane = t & 63, w = t >> 6, wm = w >> 1, wn = w & 1, r32 = lane & 31, hi = lane >> 5;
    const int m0 = blockIdx.y * 128, n0 = blockIdx.x * 128;
    f32x16 acc[2][2];
#pragma unroll
    for (int i = 0; i < 2; ++i)
#pragma unroll
        for (int j = 0; j < 2; ++j)
#pragma unroll
            for (int r = 0; r < 16; ++r) acc[i][j][r] = 0.f;
    for (int k0 = 0; k0 < K; k0 += 16) {
#pragma unroll
        for (int i = 0; i < 2; ++i) {
            const int row = (t >> 2) + 64 * i, kq = (t & 3) * 4;
            const float4 a = *(const float4*)(A + (size_t)(m0 + row) * lda + k0 + kq);
            As[kq + 0][row] = a.x; As[kq + 1][row] = a.y; As[kq + 2][row] = a.z; As[kq + 3][row] = a.w;
            const int kr = (t >> 5) + 8 * i, nq = (t & 31) * 4;
            const float4 b = *(const float4*)(B + (size_t)(k0 + kr) * ldb + n0 + nq);
            *(float4*)&Bs[kr][nq] = b;
        }
        __syncthreads();
#pragma unroll
        for (int kk = 0; kk < 16; kk += 2) {
            float a[2], b[2];
#pragma unroll
            for (int i = 0; i < 2; ++i) { a[i] = As[kk + hi][wm * 64 + i * 32 + r32]; b[i] = Bs[kk + hi][wn * 64 + i * 32 + r32]; }
#pragma unroll
            for (int i = 0; i < 2; ++i)
#pragma unroll
                for (int j = 0; j < 2; ++j) acc[i][j] = __builtin_amdgcn_mfma_f32_32x32x2f32(a[i], b[j], acc[i][j], 0, 0, 0);
        }
        __syncthreads();
    }
#pragma unroll
    for (int i = 0; i < 2; ++i)
#pragma unroll
        for (int j = 0; j < 2; ++j)
#pragma unroll
            for (int r = 0; r < 16; ++r) {
                const int row = m0 + wm * 64 + i * 32 + (r & 3) + 8 * (r >> 2) + 4 * hi, col = n0 + wn * 64 + j * 32 + r32;
                const size_t o = (size_t)row * ldc + col; float v = acc[i][j][r];
                if (EPI == 1) v = R[o] + alpha * v;
                if (EPI == 2) v = v * colscale[col];
                C[o] = v;
            }
}

__global__ void __launch_bounds__(256) k_swiglu(float* g, const float* __restrict__ u, size_t n4) {
    size_t i = (size_t)blockIdx.x * 256 + threadIdx.x;
    const size_t stride = (size_t)gridDim.x * 256;
    for (; i < n4; i += stride) { float4 a = ((float4*)g)[i]; const float4 b = ((const float4*)u)[i];
        a.x = a.x / (1.f + expf(-a.x)) * b.x; a.y = a.y / (1.f + expf(-a.y)) * b.y; a.z = a.z / (1.f + expf(-a.z)) * b.z; a.w = a.w / (1.f + expf(-a.w)) * b.w; ((float4*)g)[i] = a; }
}

__global__ void __launch_bounds__(256) k_pool_diff(const float* __restrict__ a, int lda, float* __restrict__ diff) {
    const int idx = blockIdx.x * 256 + threadIdx.x;
    const int t = idx / MIX, c = idx % MIX, g = c / CG; const int w = 2 << g;
    float s = 0.f; const int j0 = (t - w + 1) < 0 ? 0 : (t - w + 1);
    for (int j = j0; j <= t; ++j) s += a[(size_t)j * lda + c];
    const float cnt = (float)(t + 1 < w ? t + 1 : w);
    diff[(size_t)t * MIX + c] = s / cnt - a[(size_t)t * lda + c];
}

__global__ void __launch_bounds__(256) k_rope(float* x, int ld, int nh, const int* __restrict__ pos) {
    const int idx = blockIdx.x * 256 + threadIdx.x;
    const int i = idx & 31, h = (idx >> 5) % nh, t = (idx >> 5) / nh;
    if (t >= S) return;
    const float inv_freq = 1.0f / powf(10000.0f, (float)i * (2.0f / 64.0f));
    const float ang = (float)pos[t] * inv_freq; float sn, cs; sincosf(ang, &sn, &cs);
    float* p = x + (size_t)t * ld + h * 64;
    const float x1 = p[i], x2 = p[i + 32];
    p[i] = x1 * cs - x2 * sn; p[i + 32] = x2 * cs + x1 * sn;
}

__global__ void __launch_bounds__(256) k_swa(const float* __restrict__ q, int ldq, const float* __restrict__ kv, int ldkv, const float* __restrict__ sinks, float* __restrict__ y, int ldo) {
    __shared__ float ps[4][128];
    const int wv = threadIdx.x >> 6, lane = threadIdx.x & 63;
    const int item = blockIdx.x * 4 + wv; const int t = item / NQH, hq = item % NQH, kh = hq / 8;
    const float* qp = q + (size_t)t * ldq + hq * 64;
    float sc[2];
#pragma unroll
    for (int e = 0; e < 2; ++e) {
        const int j = t - 127 + lane + 64 * e;
        float s = -INFINITY;
        if (j >= 0 && j <= t) { const float* kp = kv + (size_t)j * ldkv + kh * 64; float d = 0.f; for (int c = 0; c < 64; ++c) d += qp[c] * kp[c]; s = d * 0.125f; }
        sc[e] = s;
    }
    const float sink = sinks[hq];
    const float m = fmaxf(wave_max(fmaxf(sc[0], sc[1])), sink);
    const float p0 = expf(sc[0] - m), p1 = expf(sc[1] - m);
    const float den = wave_sum(p0 + p1) + expf(sink - m);
    ps[wv][lane] = p0 / den; ps[wv][lane + 64] = p1 / den;
    __syncthreads();
    float o = 0.f;
    for (int jj = 0; jj < 128; ++jj) { const int j = t - 127 + jj; if (j < 0) continue; o += ps[wv][jj] * kv[(size_t)j * ldkv + 192 + kh * 64 + lane]; }
    y[(size_t)t * ldo + hq * 64 + lane] = o;
}

__global__ void __launch_bounds__(256) k_memattn(const float* __restrict__ a, int ldq, const float* __restrict__ mkv, float* __restrict__ y, int ldo) {
    __shared__ float ps[4][256];
    const int wv = threadIdx.x >> 6, lane = threadIdx.x & 63;
    const int item = blockIdx.x * 4 + wv; const int t = item / MH, h = item % MH;
    const float* qp = a + (size_t)t * ldq + MIX + h * MHD;
    float sc[4]; float mx = -INFINITY;
#pragma unroll
    for (int e = 0; e < 4; ++e) { const int j = lane + 64 * e; const float* kp = mkv + (size_t)j * 1024 + h * MHD; float d = 0.f; for (int c = 0; c < MHD; ++c) d += qp[c] * kp[c];
        sc[e] = d * 0.08838834764831845f; mx = fmaxf(mx, sc[e]); }
    mx = wave_max(mx); float sum = 0.f;
#pragma unroll
    for (int e = 0; e < 4; ++e) { sc[e] = expf(sc[e] - mx); sum += sc[e]; }
    sum = wave_sum(sum);
#pragma unroll
    for (int e = 0; e < 4; ++e) ps[wv][lane + 64 * e] = sc[e] / sum;
    __syncthreads();
    float o0 = 0.f, o1 = 0.f;
    for (int j = 0; j < ML; ++j) { const float p = ps[wv][j]; const float* vp = mkv + (size_t)j * 1024 + 512 + h * MHD; o0 += p * vp[lane]; o1 += p * vp[lane + 64]; }
    float* op = y + (size_t)t * ldo + MIX + h * MHD; op[lane] = o0; op[lane + 64] = o1;
}

template <int EPI>
static void gemm(hipStream_t st, const float* A, int lda, const float* B, int ldb, float* C, int ldc, int M, int N, int K, const float* R = nullptr, float alpha = 1.f, const float* cs = nullptr) {
    hipLaunchKernelGGL(k_gemm<EPI>, dim3(N / 128, M / 128), dim3(256), 0, st, A, lda, B, ldb, C, ldc, K, R, alpha, cs);
}

struct In { const float *x, *mem; const int* pos; const float *norms, *gate, *up, *down, *w_in, *w_out, *pool_w, *pool_scale, *w_kv, *kv_norm, *sinks, *w_mem_kv, *mem_norm, *final_norm; };

static void forward(hipStream_t st, const In& in, float* out, float* ws) {
    float* H = ws; float* XN = H + (size_t)S * D; float* G = XN + (size_t)S * D; float* U = G + (size_t)S * FF; float* A = U + (size_t)S * FF; float* Y = A + (size_t)S * D;
    float* DIFF = Y + (size_t)S * D; float* KV = DIFF + (size_t)S * MIX; float* MEMN = KV + (size_t)S * 384; float* MKV = MEMN + (size_t)ML * D;
    hipLaunchKernelGGL(k_rmsnorm, dim3(ML / 4), dim3(256), 0, st, in.mem, in.mem_norm, MEMN, ML, D);
    const float* hin = in.x;
    for (int l = 0; l < DEPTH; ++l) {
        for (int half = 0; half < 2; ++half) {
            if (half == 1) {
                hipLaunchKernelGGL(k_rmsnorm, dim3(S / 4), dim3(256), 0, st, hin, in.norms + (size_t)(l * 3 + 1) * D, XN, S, D);
                gemm<0>(st, XN, D, in.w_in + (size_t)l * D * D, D, A, D, S, D, D);
                if (l < NA) {
                    hipLaunchKernelGGL(k_pool_diff, dim3(S * MIX / 256), dim3(256), 0, st, A, D, DIFF);
                    for (int g = 0; g < 4; ++g)
                        gemm<2>(st, DIFF + g * CG, MIX, in.pool_w + (size_t)(l * 4 + g) * CG * CG, CG, Y + g * CG, D, S, CG, CG, nullptr, 1.f, in.pool_scale + (size_t)l * MIX + g * CG - 0);
                } else {
                    hipLaunchKernelGGL(k_rope, dim3(S * NQH * 32 / 256), dim3(256), 0, st, A, D, NQH, in.pos);
                    hipLaunchKernelGGL(k_swa, dim3(S * NQH / 4), dim3(256), 0, st, A, D, KV, 384, in.sinks + (size_t)(l - NA) * NQH, Y, D);
                }
                gemm<0>(st, MEMN, D, in.w_mem_kv + (size_t)l * D * 1024, 1024, MKV, 1024, ML, 1024, D);
                hipLaunchKernelGGL(k_memattn, dim3(S * MH / 4), dim3(256), 0, st, A, D, MKV, Y, D);
                gemm<1>(st, Y, D, in.w_out + (size_t)l * D * D, D, H, D, S, D, D, hin, 1.0f);
                hin = H;
            }
            hipLaunchKernelGGL(k_rmsnorm, dim3(S / 4), dim3(256), 0, st, hin, in.norms + (size_t)(l * 3 + (half ? 2 : 0)) * D, XN, S, D);
            const size_t wo = (size_t)(l * 2 + half) * D * FF;
            gemm<0>(st, XN, D, in.gate + wo, FF, G, FF, S, FF, D);
            gemm<0>(st, XN, D, in.up + wo, FF, U, FF, S, FF, D);
            hipLaunchKernelGGL(k_swiglu, dim3(4096), dim3(256), 0, st, G, U, (size_t)S * FF / 4);
            gemm<1>(st, G, FF, in.down + wo, D, H, D, S, D, FF, hin, 0.5f);
            hin = H;
        }
        if (l == NA - 1) {
            hipLaunchKernelGGL(k_rmsnorm, dim3(S / 4), dim3(256), 0, st, H, in.kv_norm, XN, S, D);
            gemm<0>(st, XN, D, in.w_kv, 384, KV, 384, S, 384, D);
            hipLaunchKernelGGL(k_rope, dim3(S * NKVH * 32 / 256), dim3(256), 0, st, KV, 384, NKVH, in.pos);
        }
    }
    hipLaunchKernelGGL(k_rmsnorm, dim3(S / 4), dim3(256), 0, st, H, in.final_norm, out, S, D);
}
constexpr size_t WS_FLOATS = (size_t)S * D * 4 + (size_t)S * FF * 2 + (size_t)S * MIX + (size_t)S * 384 + (size_t)ML * D + (size_t)ML * 1024;
}
#endif
namespace cfg {
constexpr int S = 8192, D = 2048, FF = 5632, MIX = 1536, NQH = 24, ML = 256;
constexpr int NGU = 2 * FF, NGU_PAD = NGU + 512;
#ifndef PITCH_PAD
#define PITCH_PAD 0
#endif
constexpr int PD = D + PITCH_PAD, PF = FF + PITCH_PAD;
constexpr float EPS = 1e-5f, LOG2E = 1.4426950408889634f;
constexpr float QSCALE = 0.125f * LOG2E;
constexpr float QMSCALE = 0.08838834764831845f * LOG2E;
}
__device__ __forceinline__ void grp_barrier(unsigned* ctl, int pm, unsigned target, bool same_xcd);
namespace pg8 {
#define PG8_LAS __attribute__((address_space(3)))
typedef unsigned short bf16_t;
typedef short bf16x8 __attribute__((ext_vector_type(8)));
typedef float f32x4 __attribute__((ext_vector_type(4)));
typedef unsigned u32x4 __attribute__((ext_vector_type(4)));
typedef unsigned u32x2 __attribute__((ext_vector_type(2)));
constexpr int BM = 256, BK = 64, HALF = 128, HTB = HALF * BK * 2  , STAGE_BYTES = 8 * HTB, NXCD = 8, WGM = 4;

__host__ __device__ __forceinline__ int lds_byte(int r, int c) { const int st = (r >> 4) * 2 + (c >> 5), rr = r & 15, cc = c & 31, ob = rr * 64 + cc * 2; return st * 1024 + (ob ^ (((ob >> 9) & 1) << 5)); }
__host__ __device__ __forceinline__ void stage_rc(int b, int& R, int& C) { const int st = b / 1024, sb = b % 1024, swz = sb ^ (((sb >> 9) & 1) << 5); R = (st >> 1) * 16 + swz / 64; C = (st & 1) * 32 + (swz % 64) / 2; }
__host__ __device__ __forceinline__ int perm32(int rho) { const int n = rho >> 4, i = rho & 15; return 8 * (i >> 2) + 4 * n + (i & 3); }

struct Unit { int pm, pn, ka, hf; };
struct Gemm { const bf16_t* A; const bf16_t* Bt; int lda, ldb, K; int kt0 = 0; };

struct StaticOrder {
    int nM, nN, nwg, G, c, flat, halftail, maxr, r0;
    __host__ __device__ __forceinline__ void init(int M, int N, int G_, int c_) { nM = M / BM; nN = N / BM; nwg = nM * nN; G = G_; c = c_; flat = 0; halftail = 0; maxr = 1 << 30; r0 = 0; }
    __host__ __device__ __forceinline__ bool next(int i, Unit& u) const {
        u.hf = 0;
        if (i >= maxr) return false;
        i += r0;
        long L = (long)i * G + c;
        if (halftail && (long)(i + 1) * G > nwg) { if ((long)i * G >= nwg) return false; const int hc = c % (G / 2); L = (long)i * G + hc; u.hf = 1 + (c >= G / 2); }
        if (L >= nwg) return false;
        int wgid = (int)L; { const int q = nwg / NXCD, r = nwg % NXCD, xcd = wgid % NXCD, off = wgid / NXCD; wgid = (xcd < r ? xcd * (q + 1) : r * (q + 1) + (xcd - r) * q) + off; }
        const int nig = WGM * nN, gid = wgid / nig, fm = gid * WGM, gsz = (nM - fm) < WGM ? (nM - fm) : WGM;
        u.pm = fm + ((wgid % nig) % gsz); u.pn = (wgid % nig) / gsz; u.ka = 0; if (flat) { u.pm = 0; u.pn = 0; } return true;
    }
    __device__ __forceinline__ void a_ready(const Unit&) const {}
    __device__ __forceinline__ void done(const Unit&) const {}
};
struct PoolOrder : StaticOrder {
    __host__ __device__ __forceinline__ bool next(int i, Unit& u) const { if (!StaticOrder::next(i, u)) return false; u.ka = (u.pn >> 1) * 384; return true; }
};
struct SubsetPoolOrder {
    int c0, n, nN, c;
    __host__ __device__ __forceinline__ bool next(int i, Unit& u) const { const int k = c - c0; if (i != 0 || k < 0 || k >= n) return false; u.pm = k / nN; u.pn = k % nN; u.ka = (u.pn >> 1) * 384; u.hf = 0; return true; }
    __device__ __forceinline__ void a_ready(const Unit&) const {}
    __device__ __forceinline__ void done(const Unit&) const {}
};
struct SubsetOrder {
    int c0, n, nN, c;
    __host__ __device__ __forceinline__ bool next(int i, Unit& u) const { const int k = c - c0; if (i != 0 || k < 0 || k >= n) return false; u.pm = k / nN; u.pn = k % nN; u.ka = 0; u.hf = 0; return true; }
    __device__ __forceinline__ void a_ready(const Unit&) const {}
    __device__ __forceinline__ void done(const Unit&) const {}
};

struct OneUnitOrder {
    int pm, pn;
    __host__ __device__ __forceinline__ bool next(int i, Unit& u) const { if (i != 0) return false; u.pm = pm; u.pn = pn; u.ka = 0; u.hf = 0; return true; }
    __device__ __forceinline__ void a_ready(const Unit&) const {}
    __device__ __forceinline__ void done(const Unit&) const {}
};
typedef float f32x2_t __attribute__((ext_vector_type(2))); typedef __bf16 bf16x2_t __attribute__((ext_vector_type(2)));
__device__ __forceinline__ unsigned pkbf(float lo, float hi) { f32x2_t v = {lo, hi}; bf16x2_t b = __builtin_convertvector(v, bf16x2_t); return __builtin_bit_cast(unsigned, b); }
__device__ __forceinline__ float rstd_of(const float* ssq, int row) {
    const f32x4 a = *(const f32x4*)(ssq + (size_t)row * 8), b = *(const f32x4*)(ssq + (size_t)row * 8 + 4);
    return __builtin_amdgcn_rsqf((((a[0] + a[1]) + (a[2] + a[3])) + ((b[0] + b[1]) + (b[2] + b[3]))) * (1.0f / 2048.0f) + cfg::EPS);
}
__device__ __forceinline__ void rstd8(const float* ssq, int rowbase  , int fr, int fq, float (&rs)[2][4]) {
    float loc[2];
#pragma unroll
    for (int k = 0; k < 2; ++k) loc[k] = rstd_of(ssq, rowbase + (fq >> 1) * HALF + (2 * (fq & 1) + k) * 16);
#pragma unroll
    for (int ai = 0; ai < 2; ++ai)
#pragma unroll
        for (int m = 0; m < 4; ++m) rs[ai][m] = __shfl(loc[m & 1], fr + 16 * (ai * 2 + (m >> 1)));
}
struct EpiSwiGLU {
    static constexpr bool PERM = true, AFTER_DRAIN = false;
    bf16_t* O; const float* ssq; int nostore; const PG8_LAS float* rtab = nullptr; int rtab_pm = -1;
    __device__ __forceinline__ void operator()(const f32x4 (&acc)[2][2][4][2], const Unit& u, int wr, int wc, int fr, int fq) const {
        if (nostore) return;
        const int row0 = u.pm * BM + wr * 64 + fr, col0 = u.pn * 128 + wc * 32 + 8 * fq;
        float rs8[2][4];
        if (RSTD_LDS && u.pm == rtab_pm) {
#pragma unroll
            for (int ai = 0; ai < 2; ++ai)
#pragma unroll
                for (int m = 0; m < 4; ++m) rs8[ai][m] = rtab[ai * HALF + wr * 64 + m * 16 + fr]; }
        else rstd8(ssq, row0, fr, fq, rs8);
        const __amdgpu_buffer_rsrc_t rs_o = __builtin_amdgcn_make_buffer_rsrc((void*)O, (short)0, (int)((size_t)cfg::S * cfg::PF * 2), 0x00020000);
#pragma unroll
        for (int ai = 0; ai < 2; ++ai) { if (u.hf == 2 - ai) continue;
#pragma unroll
            for (int m = 0; m < 4; ++m) { const int row = row0 + ai * HALF + m * 16; const float rs = rs8[ai][m];
                const float rsl = -cfg::LOG2E * rs, irs2 = __builtin_amdgcn_rcpf(rs * rs);
                float o[8];
#pragma unroll
                for (int n = 0; n < 2; ++n)
#pragma unroll
                    for (int e = 0; e < 4; ++e) { const float ag = acc[ai][0][m][n][e], au = acc[ai][1][m][n][e];
                        o[4 * n + e] = (ag * au) * __builtin_amdgcn_rcpf(__builtin_fmaf(__builtin_amdgcn_exp2f(ag * rsl), irs2, irs2)); }
                u32x4 w; w.x = pkbf(o[0], o[1]); w.y = pkbf(o[2], o[3]); w.z = pkbf(o[4], o[5]); w.w = pkbf(o[6], o[7]);
                if (WT_STORES) __builtin_amdgcn_raw_buffer_store_b128(w, rs_o, (int)(((size_t)row * cfg::PF + col0) * 2), 0, 16); else *(u32x4*)(O + (size_t)row * cfg::PF + col0) = w; } }
    }
};
struct EpiSwiGLUSplit {
    static constexpr bool PERM = true, AFTER_DRAIN = true;
    bf16_t* O; const float* ssq; float* slab; unsigned* ctr; unsigned* tmo; unsigned epoch; int role; int same_xcd;
    __device__ __forceinline__ void fused(f32x4 (&acc)[2][2][4][2], const Unit& u, int wr, int wc, int fr, int fq, PG8_LAS unsigned char* lds, int wid, int lane) const {
        const int tid = wid * 64 + lane;
        f32x4* sl = (f32x4*)slab + tid;
        if (role == 1) {
#pragma unroll
            for (int ai = 0; ai < 2; ++ai)
#pragma unroll
                for (int bj = 0; bj < 2; ++bj)
#pragma unroll
                    for (int m = 0; m < 4; ++m)
#pragma unroll
                        for (int n = 0; n < 2; ++n) sl[(size_t)((((ai * 2 + bj) * 4 + m) * 2 + n)) * 512] = acc[ai][bj][m][n];
            asm volatile("s_waitcnt vmcnt(0)" ::: "memory"); __builtin_amdgcn_s_barrier(); asm volatile("" ::: "memory");
            if (tid == 0) { if (!same_xcd) { __builtin_amdgcn_fence(__ATOMIC_RELEASE, "agent"); asm volatile("s_waitcnt vmcnt(0)" ::: "memory"); }
                (void)__hip_atomic_fetch_add(ctr, 1u, __ATOMIC_RELAXED, __HIP_MEMORY_SCOPE_AGENT); }
            return;
        }
        if (tid == 0) { unsigned sp = 0u;
            while (__hip_atomic_load(ctr, __ATOMIC_RELAXED, __HIP_MEMORY_SCOPE_AGENT) < epoch) { __builtin_amdgcn_s_sleep(1);
                if ((++sp & 255u) == 0u) { if (__hip_atomic_load(tmo, __ATOMIC_RELAXED, __HIP_MEMORY_SCOPE_AGENT)) break; if (sp > (1u << 18)) { atomicAdd(tmo, 1u); break; } } }
            __builtin_amdgcn_fence(__ATOMIC_ACQUIRE, "agent"); asm volatile("s_waitcnt vmcnt(0)" ::: "memory"); }
        asm volatile("s_waitcnt vmcnt(0) lgkmcnt(0)" ::: "memory"); __builtin_amdgcn_s_barrier(); asm volatile("" ::: "memory");
        const int row0 = u.pm * BM + wr * 64 + fr, col0 = u.pn * 128 + wc * 32 + 8 * fq;
        float rs8[2][4]; rstd8(ssq, row0, fr, fq, rs8);
#pragma unroll
        for (int ai = 0; ai < 2; ++ai)
#pragma unroll
            for (int m = 0; m < 4; ++m) { const int row = row0 + ai * HALF + m * 16; const float rs = rs8[ai][m];
                const float rsl = -cfg::LOG2E * rs, irs2 = __builtin_amdgcn_rcpf(rs * rs);
                f32x4 g[2], up[2];
#pragma unroll
                for (int n = 0; n < 2; ++n) { g[n] = acc[ai][0][m][n] + sl[(size_t)((((ai * 2 + 0) * 4 + m) * 2 + n)) * 512]; up[n] = acc[ai][1][m][n] + sl[(size_t)((((ai * 2 + 1) * 4 + m) * 2 + n)) * 512]; }
                float o[8];
#pragma unroll
                for (int n = 0; n < 2; ++n)
#pragma unroll
                    for (int e = 0; e < 4; ++e) o[4 * n + e] = (g[n][e] * up[n][e]) * __builtin_amdgcn_rcpf(__builtin_fmaf(__builtin_amdgcn_exp2f(g[n][e] * rsl), irs2, irs2));
                u32x4 w; w.x = pkbf(o[0], o[1]); w.y = pkbf(o[2], o[3]); w.z = pkbf(o[4], o[5]); w.w = pkbf(o[6], o[7]);
                *(u32x4*)(O + (size_t)row * cfg::PF + col0) = w; }
    }
};
struct EpiResid {
    static constexpr bool PERM = true, AFTER_DRAIN = true;
    const float* R32; bf16_t* HB; bf16_t* HL; float* ssq; float alpha; int nostore; float* OUT = nullptr; const float* fgain = nullptr; unsigned* bctl = nullptr; int bpm = 0; unsigned btarget = 0u; bool bsame = false;
    __device__ __forceinline__ void fused(f32x4 (&acc)[2][2][4][2], const Unit& u, int wr, int wc, int fr, int fq, PG8_LAS unsigned char* lds, int wid, int lane) const {
        if (nostore) return;
        PG8_LAS float* P = (PG8_LAS float*)lds;
        const int col0 = u.pn * BM + wc * 32 + 8 * fq;
#if RESID_BATCH
        constexpr int NB = 16 / RESID_BATCH;
        u32x4 X[2][RESID_BATCH], Y[2][RESID_BATCH];
#define RS_OFF(it) ((size_t)(u.pm * BM + ((it) >> 3) * HALF + wr * 64 + (((it) >> 1) & 3) * 16 + fr))
#define RS_LOAD(buf, b) do { _Pragma("unroll") for (int j = 0; j < RESID_BATCH; ++j) { const int it = (b) * RESID_BATCH + j; \
            if (R32) { const float* px = R32 + RS_OFF(it) * cfg::D + col0 + (it & 1) * HALF; X[buf][j] = *(const u32x4*)px; Y[buf][j] = *(const u32x4*)(px + 4); } \
            else { const size_t o2 = RS_OFF(it) * cfg::PD + col0 + (it & 1) * HALF; X[buf][j] = *(const u32x4*)(HB + o2); Y[buf][j] = *(const u32x4*)(HL + o2); } } } while (0)
        RS_LOAD(0, 0);
        float s = 0.f;
#pragma unroll
        for (int b = 0; b < NB; ++b) {
            if (b + 1 < NB) RS_LOAD((b + 1) & 1, b + 1);
#pragma unroll
            for (int j = 0; j < RESID_BATCH; ++j) { const int it = b * RESID_BATCH + j, ai = it >> 3, m = (it >> 1) & 3, bj = it & 1; const int rl = ai * HALF + wr * 64 + m * 16 + fr;
                const size_t o2 = (size_t)(u.pm * BM + rl) * cfg::PD + col0 + bj * HALF; const u32x4 a = X[b & 1][j], bb = Y[b & 1][j]; f32x4 h0, h1;
                if (R32) { h0[0] = __uint_as_float(a.x); h0[1] = __uint_as_float(a.y); h0[2] = __uint_as_float(a.z); h0[3] = __uint_as_float(a.w);
                           h1[0] = __uint_as_float(bb.x); h1[1] = __uint_as_float(bb.y); h1[2] = __uint_as_float(bb.z); h1[3] = __uint_as_float(bb.w); }
                else { h0[0] = __uint_as_float(a.x << 16) + __uint_as_float(bb.x << 16); h0[1] = __uint_as_float(a.x & 0xffff0000u) + __uint_as_float(bb.x & 0xffff0000u);
                    h0[2] = __uint_as_float(a.y << 16) + __uint_as_float(bb.y << 16); h0[3] = __uint_as_float(a.y & 0xffff0000u) + __uint_as_float(bb.y & 0xffff0000u);
                    h1[0] = __uint_as_float(a.z << 16) + __uint_as_float(bb.z << 16); h1[1] = __uint_as_float(a.z & 0xffff0000u) + __uint_as_float(bb.z & 0xffff0000u);
                    h1[2] = __uint_as_float(a.w << 16) + __uint_as_float(bb.w << 16); h1[3] = __uint_as_float(a.w & 0xffff0000u) + __uint_as_float(bb.w & 0xffff0000u); }
                const f32x4 v0 = h0 + acc[ai][bj][m][0] * alpha, v1 = h1 + acc[ai][bj][m][1] * alpha;
                if (bj == 0) s = 0.f;
                s += ((v0[0] * v0[0] + v0[1] * v0[1]) + (v0[2] * v0[2] + v0[3] * v0[3])) + ((v1[0] * v1[0] + v1[1] * v1[1]) + (v1[2] * v1[2] + v1[3] * v1[3]));
                u32x4 w; w.x = pkbf(v0[0], v0[1]); w.y = pkbf(v0[2], v0[3]); w.z = pkbf(v1[0], v1[1]); w.w = pkbf(v1[2], v1[3]);
                u32x4 l; l.x = pkbf(v0[0] - __uint_as_float(w.x << 16), v0[1] - __uint_as_float(w.x & 0xffff0000u)); l.y = pkbf(v0[2] - __uint_as_float(w.y << 16), v0[3] - __uint_as_float(w.y & 0xffff0000u));
                l.z = pkbf(v1[0] - __uint_as_float(w.z << 16), v1[1] - __uint_as_float(w.z & 0xffff0000u)); l.w = pkbf(v1[2] - __uint_as_float(w.w << 16), v1[3] - __uint_as_float(w.w & 0xffff0000u));
                if (FINAL_FUSED && OUT) { acc[ai][bj][m][0] = v0; acc[ai][bj][m][1] = v1; }
                else { *(u32x4*)(HB + o2) = w; *(u32x4*)(HL + o2) = l; }
                if (bj == 1) { float t_ = s; t_ += __shfl_xor(t_, 16); t_ += __shfl_xor(t_, 32); if (fq == 0) P[rl * 4 + wc] = t_; } }
        }
#undef RS_LOAD
#undef RS_OFF
#else
#pragma unroll
        for (int ai = 0; ai < 2; ++ai)
#pragma unroll
            for (int m = 0; m < 4; ++m) { const int rl = ai * HALF + wr * 64 + m * 16 + fr; const size_t off = (size_t)(u.pm * BM + rl) * cfg::PD + col0, offx = (size_t)(u.pm * BM + rl) * cfg::D + col0; float s = 0.f;
#pragma unroll
                for (int bj = 0; bj < 2; ++bj) { const size_t o2 = off + bj * HALF; f32x4 h0, h1;
                    if (R32) { h0 = *(const f32x4*)(R32 + offx + bj * HALF); h1 = *(const f32x4*)(R32 + offx + bj * HALF + 4); }
                    else { const u32x4 a = *(const u32x4*)(HB + o2), b = *(const u32x4*)(HL + o2);
                        h0[0] = __uint_as_float(a.x << 16) + __uint_as_float(b.x << 16); h0[1] = __uint_as_float(a.x & 0xffff0000u) + __uint_as_float(b.x & 0xffff0000u);
                        h0[2] = __uint_as_float(a.y << 16) + __uint_as_float(b.y << 16); h0[3] = __uint_as_float(a.y & 0xffff0000u) + __uint_as_float(b.y & 0xffff0000u);
                        h1[0] = __uint_as_float(a.z << 16) + __uint_as_float(b.z << 16); h1[1] = __uint_as_float(a.z & 0xffff0000u) + __uint_as_float(b.z & 0xffff0000u);
                        h1[2] = __uint_as_float(a.w << 16) + __uint_as_float(b.w << 16); h1[3] = __uint_as_float(a.w & 0xffff0000u) + __uint_as_float(b.w & 0xffff0000u); }
                    const f32x4 v0 = h0 + acc[ai][bj][m][0] * alpha, v1 = h1 + acc[ai][bj][m][1] * alpha;
                    s += ((v0[0] * v0[0] + v0[1] * v0[1]) + (v0[2] * v0[2] + v0[3] * v0[3])) + ((v1[0] * v1[0] + v1[1] * v1[1]) + (v1[2] * v1[2] + v1[3] * v1[3]));
                    u32x4 w; w.x = pkbf(v0[0], v0[1]); w.y = pkbf(v0[2], v0[3]); w.z = pkbf(v1[0], v1[1]); w.w = pkbf(v1[2], v1[3]);
                    u32x4 l; l.x = pkbf(v0[0] - __uint_as_float(w.x << 16), v0[1] - __uint_as_float(w.x & 0xffff0000u)); l.y = pkbf(v0[2] - __uint_as_float(w.y << 16), v0[3] - __uint_as_float(w.y & 0xffff0000u));
                    l.z = pkbf(v1[0] - __uint_as_float(w.z << 16), v1[1] - __uint_as_float(w.z & 0xffff0000u)); l.w = pkbf(v1[2] - __uint_as_float(w.w << 16), v1[3] - __uint_as_float(w.w & 0xffff0000u));
                    *(u32x4*)(HB + o2) = w; *(u32x4*)(HL + o2) = l; }
                s += __shfl_xor(s, 16); s += __shfl_xor(s, 32);
                if (fq == 0) P[rl * 4 + wc] = s; }
#endif
        asm volatile("s_waitcnt lgkmcnt(0)" ::: "memory"); __builtin_amdgcn_s_barrier(); asm volatile("" ::: "memory");
        const int t = wid * 64 + lane;
        if (t < 256) { const f32x4 p = *(const PG8_LAS f32x4*)(P + t * 4); ssq[(size_t)(u.pm * BM + t) * 8 + u.pn] = (p[0] + p[1]) + (p[2] + p[3]); }
#if FINAL_FUSED
        if (OUT) {
            ::grp_barrier(bctl, bpm, btarget, bsame);
            float rs8[2][4]; rstd8(ssq, u.pm * BM + wr * 64 + fr, fr, fq, rs8);
            f32x4 gq[2][2];
#pragma unroll
            for (int bj = 0; bj < 2; ++bj) { gq[bj][0] = *(const f32x4*)(fgain + col0 + bj * HALF); gq[bj][1] = *(const f32x4*)(fgain + col0 + bj * HALF + 4); }
#pragma unroll
            for (int ai = 0; ai < 2; ++ai)
#pragma unroll
                for (int m = 0; m < 4; ++m) { const size_t orow = (size_t)(u.pm * BM + ai * HALF + wr * 64 + m * 16 + fr) * cfg::D + col0; const float rs = rs8[ai][m];
#pragma unroll
                    for (int bj = 0; bj < 2; ++bj) { *(f32x4*)(OUT + orow + bj * HALF) = acc[ai][bj][m][0] * rs * gq[bj][0]; *(f32x4*)(OUT + orow + bj * HALF + 4) = acc[ai][bj][m][1] * rs * gq[bj][1]; } }
        }
#endif
    }
};
struct EpiWin {
    static constexpr bool PERM = true, AFTER_DRAIN = false;
    bf16_t* AQ; bf16_t* QMF; const float* ssq; const float* cs; const float* sn; int swa;
    __device__ __forceinline__ void operator()(const f32x4 (&acc)[2][2][4][2], const Unit& u, int wr, int wc, int fr, int fq) const {
        const int row0 = u.pm * BM + wr * 64 + fr;
        float rs8[2][4]; rstd8(ssq, row0, fr, fq, rs8);
#pragma unroll
        for (int ai = 0; ai < 2; ++ai) {
            f32x4 ropc[4], rops[4];
            if (swa && u.pn < 6) { const int dq = (((wc & 1) * 32 + 8 * fq) >> 3) * 4;
#pragma unroll
                for (int m = 0; m < 4; ++m) { const int row = row0 + ai * HALF + m * 16; ropc[m] = *(const f32x4*)(cs + (size_t)row * 32 + dq); rops[m] = *(const f32x4*)(sn + (size_t)row * 32 + dq); } }
            else {
#pragma unroll
                for (int m = 0; m < 4; ++m) { ropc[m] = (f32x4){0.f, 0.f, 0.f, 0.f}; rops[m] = ropc[m]; } }
            asm volatile("" ::: "memory");
#pragma unroll
            for (int m = 0; m < 4; ++m) { const int row = row0 + ai * HALF + m * 16; const float rs = rs8[ai][m]; const int qb = row >> 5, r32 = row & 31;
#pragma unroll
                for (int bj = 0; bj < 2; ++bj) { const int c0 = u.pn * BM + bj * HALF + wc * 32 + 8 * fq; f32x4 v0 = acc[ai][bj][m][0] * rs, v1 = acc[ai][bj][m][1] * rs;
                    if (u.pn >= 6) {
                        v0 = v0 * cfg::QMSCALE; v1 = v1 * cfg::QMSCALE; const int cm = c0 - 1536, h = cm >> 7, dm = cm & 127, j = dm >> 4, hi = (dm >> 3) & 1;
                        u32x4 w; w.x = pkbf(v0[0], v0[1]); w.y = pkbf(v0[2], v0[3]); w.z = pkbf(v1[0], v1[1]); w.w = pkbf(v1[2], v1[3]);
                        *(u32x4*)(QMF + ((size_t)(((h * 256 + qb) * 8 + j) * 64 + hi * 32 + r32)) * 8) = w; }
                    else if (!swa) { u32x4 w; w.x = pkbf(v0[0], v0[1]); w.y = pkbf(v0[2], v0[3]); w.z = pkbf(v1[0], v1[1]); w.w = pkbf(v1[2], v1[3]); *(u32x4*)(AQ + (size_t)row * cfg::PD + c0) = w; }
                    else { const int hq = c0 >> 6, jj = (c0 & 63) >> 3; const f32x4 c = ropc[m], sv = rops[m];
                        const f32x4 o1 = (v0 * c - v1 * sv) * cfg::QSCALE, o2 = (v1 * c + v0 * sv) * cfg::QSCALE;
                        u32x2 w1, w2; w1.x = pkbf(o1[0], o1[1]); w1.y = pkbf(o1[2], o1[3]); w2.x = pkbf(o2[0], o2[1]); w2.y = pkbf(o2[2], o2[3]);
                        bf16_t* qp = AQ + ((size_t)(((hq * 256 + qb) * 4 + (jj >> 2)) * 64 + ((jj >> 1) & 1) * 32 + r32)) * 8 + 4 * (jj & 1);
                        *(u32x2*)qp = w1; *(u32x2*)(qp + 2 * 512) = w2; } } } }
    }
};
struct EpiPool {
    static constexpr bool PERM = false, AFTER_DRAIN = false;
    float* Z;
    __device__ __forceinline__ void operator()(const f32x4 (&acc)[2][2][4][2], const Unit& u, int wr, int wc, int fr, int fq) const {
        const int row0 = u.pm * BM + wr * 64 + fr, g = u.pn >> 1;
#pragma unroll
        for (int ai = 0; ai < 2; ++ai)
#pragma unroll
            for (int m = 0; m < 4; ++m) { float* zp = Z + (size_t)(row0 + ai * HALF + m * 16) * cfg::MIX + g * 384;
#pragma unroll
                for (int bj = 0; bj < 2; ++bj) { if ((u.pn & 1) && bj) continue;
#pragma unroll
                    for (int n = 0; n < 2; ++n) *(f32x4*)(zp + (u.pn & 1) * 256 + bj * HALF + wc * 32 + n * 16 + 4 * fq) = acc[ai][bj][m][n]; } }
    }
};
struct EpiKV {
    static constexpr bool PERM = true, AFTER_DRAIN = false;
    bf16_t* KF; bf16_t* VF; const float* ssq; const float* cs; const float* sn;
    __device__ __forceinline__ void operator()(const f32x4 (&acc)[2][2][4][2], const Unit& u, int wr, int wc, int fr, int fq) const {
        const int row0 = u.pm * BM + wr * 64 + fr;
        float rs8[2][4]; rstd8(ssq, row0, fr, fq, rs8);
#pragma unroll
        for (int ai = 0; ai < 2; ++ai)
#pragma unroll
            for (int m = 0; m < 4; ++m) { const int row = row0 + ai * HALF + m * 16; const float rs = rs8[ai][m]; const int kt = row >> 5, r32 = row & 31;
#pragma unroll
                for (int bj = 0; bj < 2; ++bj) { const int cg = u.pn * BM + bj * HALF + wc * 32 + 8 * fq; if (cg >= 384) continue;
                    const f32x4 v0 = acc[ai][bj][m][0] * rs, v1 = acc[ai][bj][m][1] * rs;
                    if (cg < 192) { const int kvh = cg >> 6, jj = (cg & 63) >> 3, d = jj * 4; const f32x4 c = *(const f32x4*)(cs + (size_t)row * 32 + d), sv = *(const f32x4*)(sn + (size_t)row * 32 + d);
                        const f32x4 o1 = v0 * c - v1 * sv, o2 = v1 * c + v0 * sv;
                        u32x2 w1, w2; w1.x = pkbf(o1[0], o1[1]); w1.y = pkbf(o1[2], o1[3]); w2.x = pkbf(o2[0], o2[1]); w2.y = pkbf(o2[2], o2[3]);
                        bf16_t* kp = KF + ((size_t)(((kvh * 256 + kt) * 4 + (jj >> 2)) * 64 + ((jj >> 1) & 1) * 32 + r32)) * 8 + 4 * (jj & 1);
                        *(u32x2*)kp = w1; *(u32x2*)(kp + 2 * 512) = w2; }
                    else {
                        const int v = cg - 192, kvh = v >> 6, d = v & 63, k16 = r32 & 15, sk = r32 >> 4, hik = (k16 >> 2) & 1, jv = 4 * (k16 >> 3) + (k16 & 3);
                        bf16_t* vp = VF + ((size_t)((((kvh * 256 + kt) * 2 + (d >> 5)) * 2 + sk) * 64 + hik * 32 + (d & 31))) * 8 + jv;
#pragma unroll
                        for (int e = 0; e < 4; ++e) { vp[e * 8] = (bf16_t)(pkbf(v0[e], 0.f) & 0xffffu); vp[(4 + e) * 8] = (bf16_t)(pkbf(v1[e], 0.f) & 0xffffu); } } } }
    }
};
struct EpiFold {
    static constexpr bool PERM = true, AFTER_DRAIN = false;
    bf16_t* W2;
    __device__ __forceinline__ void operator()(const f32x4 (&acc)[2][2][4][2], const Unit& u, int wr, int wc, int fr, int fq) const {
        const int row0 = u.pm * BM + wr * 64 + fr, g = u.pn >> 1;
#pragma unroll
        for (int ai = 0; ai < 2; ++ai)
#pragma unroll
            for (int m = 0; m < 4; ++m) { const int row = row0 + ai * HALF + m * 16;
#pragma unroll
                for (int bj = 0; bj < 2; ++bj) { const int jp = (u.pn & 1) * BM + bj * HALF + wc * 32 + 8 * fq; if (jp >= 384) continue;
                    const f32x4 v0 = acc[ai][bj][m][0], v1 = acc[ai][bj][m][1];
                    u32x4 w; w.x = pkbf(v0[0], v0[1]); w.y = pkbf(v0[2], v0[3]); w.z = pkbf(v1[0], v1[1]); w.w = pkbf(v1[2], v1[3]);
                    *(u32x4*)(W2 + (size_t)row * cfg::PD + g * 384 + jp) = w; } }
    }
};
struct EpiMemKV {
    static constexpr bool PERM = true, AFTER_DRAIN = false;
    bf16_t* MKF; bf16_t* MVF;
    __device__ __forceinline__ void operator()(const f32x4 (&acc)[2][2][4][2], const Unit& u, int wr, int wc, int fr, int fq) const {
        const int row0 = wr * 64 + fr;
#pragma unroll
        for (int ai = 0; ai < 2; ++ai)
#pragma unroll
            for (int m = 0; m < 4; ++m) { const int row = row0 + ai * HALF + m * 16, kt = row >> 5, r32 = row & 31;
#pragma unroll
                for (int bj = 0; bj < 2; ++bj) { const int cg = u.pn * BM + bj * HALF + wc * 32 + 8 * fq, l = cg >> 10, w = cg & 1023;
                    const f32x4 v0 = acc[ai][bj][m][0], v1 = acc[ai][bj][m][1];
                    if (w < 512) { const int h = w >> 7, dm = w & 127; u32x4 q; q.x = pkbf(v0[0], v0[1]); q.y = pkbf(v0[2], v0[3]); q.z = pkbf(v1[0], v1[1]); q.w = pkbf(v1[2], v1[3]);
                        *(u32x4*)(MKF + ((size_t)(((((l * 4 + h) * 8 + kt) * 8 + (dm >> 4)) * 64) + ((dm >> 3) & 1) * 32 + r32)) * 8) = q; }
                    else { const int dv = w - 512, h = dv >> 7, d = dv & 127, k16 = r32 & 15, sk = r32 >> 4, hik = (k16 >> 2) & 1, jv = 4 * (k16 >> 3) + (k16 & 3);
                        bf16_t* vp = MVF + ((size_t)((((((l * 4 + h) * 8 + kt) * 4 + (d >> 5)) * 2 + sk) * 64) + hik * 32 + (d & 31))) * 8 + jv;
#pragma unroll
                        for (int e = 0; e < 4; ++e) { vp[e * 8] = (bf16_t)(pkbf(v0[e], 0.f) & 0xffffu); vp[(4 + e) * 8] = (bf16_t)(pkbf(v1[e], 0.f) & 0xffffu); } } } }
    }
};

template <class Epi, class Sched, bool ALIGN_EPI = false, bool SP2 = false, bool HM = false  , int DIAG = 0  >
__device__ __forceinline__ void gemm_phase(PG8_LAS unsigned char* lds, const Gemm g, const Sched& S, const Epi& E) {
    int tid_ = threadIdx.x; asm volatile("" : "+v"(tid_));
    const int tid = tid_, wid = __builtin_amdgcn_readfirstlane(tid >> 6), lane = tid & 63, wr = wid >> 2, wc = wid & 3, fr = lane & 15, fq = lane >> 4;
    int K_ = g.K; asm volatile("" : "+s"(K_));
    const int K = K_, nt = K / BK;
    int kt0_ = g.kt0; asm volatile("" : "+s"(kt0_));
    const int kt0 = kt0_;
#define PG8_KOFF(tt) ((size_t)(((tt) + kt0) >= nt ? ((tt) + kt0) - nt : ((tt) + kt0)) * kstep)
    unsigned voffA[2], voffB[2];
#pragma unroll
    for (int i = 0; i < 2; ++i) { int R, C; stage_rc(tid * 16 + i * 8192, R, C); const int Rb = Epi::PERM ? ((R & ~31) + perm32(R & 31)) : R;
        voffA[i] = (unsigned)(R * g.lda + C) * 2u; voffB[i] = (unsigned)(Rb * g.ldb + C) * 2u; }
    const size_t kstep = (size_t)(BK * 2);
    const size_t hstepA = (size_t)HALF * g.lda * 2, hstepB = (size_t)HALF * g.ldb * 2;
    const size_t tstepA = 2 * hstepA, tstepB = 2 * hstepB;
    const unsigned ldsw = (unsigned)wid * 1024u;
    const int aoff = lds_byte(wr * 64 + fr, fq * 8), boff = lds_byte(wc * 32 + fr, fq * 8);
#define PG8_SA(b, h) (((b) * 2 + (h)) * HTB)
#define PG8_SB(b, h) ((4 + (b) * 2 + (h)) * HTB)
#define PG8_STAGE(bufoff, gbase, voff) do { if (DIAG == 2) break; _Pragma("unroll") for (int _i = 0; _i < 2; ++_i) \
        __builtin_amdgcn_global_load_lds((const unsigned*)((const char*)(gbase) + (voff)[_i]), (PG8_LAS unsigned*)(lds + (bufoff) + ldsw + _i * 8192), 16, 0, ((const void*)(voff) == (const void*)voffB) ? B_NT_AUX : 0); } while (0)
#define PG8_STAGE1(bufoff, gbase, voff, _i) do { if (DIAG == 2) break; \
        __builtin_amdgcn_global_load_lds((const unsigned*)((const char*)(gbase) + (voff)[_i]), (PG8_LAS unsigned*)(lds + (bufoff) + ldsw + (_i) * 8192), 16, 0, 0); } while (0)
#define PG8_LDA(dst, b, h) do { _Pragma("unroll") for (int m = 0; m < 4; ++m) _Pragma("unroll") for (int k = 0; k < 2; ++k) dst[m][k] = *(const PG8_LAS bf16x8*)(lds + PG8_SA(b, h) + aoff + m * 2048 + k * 1024); } while (0)
#define PG8_LDB(dst, b, h) do { _Pragma("unroll") for (int n = 0; n < 2; ++n) _Pragma("unroll") for (int k = 0; k < 2; ++k) dst[n][k] = *(const PG8_LAS bf16x8*)(lds + PG8_SB(b, h) + boff + n * 2048 + k * 1024); } while (0)
#if MMA_ORDER == 1
#define PG8_MMA(ai, bj, At, Bt) do { if (DIAG == 1) break; if (MMA_SETPRIO) __builtin_amdgcn_s_setprio(MMA_PRIO); _Pragma("unroll") for (int k = 0; k < 2; ++k) _Pragma("unroll") for (int n = 0; n < 2; ++n) _Pragma("unroll") for (int m = 0; m < 4; ++m) \
        acc[ai][bj][m][n] = __builtin_amdgcn_mfma_f32_16x16x32_bf16(Bt[n][k], At[m][k], acc[ai][bj][m][n], 0, 0, 0); if (MMA_SETPRIO) __builtin_amdgcn_s_setprio(0); } while (0)
#elif MMA_ORDER == 2
#define PG8_MMA(ai, bj, At, Bt) do { if (DIAG == 1) break; if (MMA_SETPRIO) __builtin_amdgcn_s_setprio(MMA_PRIO); _Pragma("unroll") for (int k = 0; k < 2; ++k) _Pragma("unroll") for (int m = 0; m < 4; ++m) _Pragma("unroll") for (int n = 0; n < 2; ++n) \
        acc[ai][bj][m][n] = __builtin_amdgcn_mfma_f32_16x16x32_bf16(Bt[n][k], At[m][k], acc[ai][bj][m][n], 0, 0, 0); if (MMA_SETPRIO) __builtin_amdgcn_s_setprio(0); } while (0)
#else
#define PG8_MMA(ai, bj, At, Bt) do { if (DIAG == 1) break; if (MMA_SETPRIO) __builtin_amdgcn_s_setprio(MMA_PRIO); _Pragma("unroll") for (int m = 0; m < 4; ++m) _Pragma("unroll") for (int n = 0; n < 2; ++n) _Pragma("unroll") for (int k = 0; k < 2; ++k) \
        acc[ai][bj][m][n] = __builtin_amdgcn_mfma_f32_16x16x32_bf16(Bt[n][k], At[m][k], acc[ai][bj][m][n], 0, 0, 0); if (MMA_SETPRIO) __builtin_amdgcn_s_setprio(0); } while (0)
#endif
#define PG8_WAIT_V(n) asm volatile("s_waitcnt vmcnt(" #n ")" ::: "memory")
#if L2WARM
    const unsigned wlane = (unsigned)((wid & 3) * 64 + lane);
    const unsigned voffW = (wid < 4) ? wlane * (unsigned)g.lda * 2u : wlane * (unsigned)g.ldb * 2u;
#define PG8_WARM(abase, bbase) __builtin_amdgcn_global_load_lds((const unsigned*)((wid < 4 ? (const char*)(abase) : (const char*)(bbase)) + voffW), (PG8_LAS unsigned*)(lds + STAGE_BYTES + 1024), 4, 0, 0)
#define PG8_WAIT_VL() PG8_WAIT_V(9)
#else
#define PG8_WARM(abase, bbase) do {} while (0)
#define PG8_WAIT_VL() PG8_WAIT_V(8)
#endif
#define PG8_WAIT_L(n) asm volatile("s_waitcnt lgkmcnt(" #n ")" ::: "memory")
#define PG8_BAR __builtin_amdgcn_s_barrier()
#define PG8_SCHED __builtin_amdgcn_sched_barrier(0)
    Unit cur, nxt; int ui = 0;
    if (!S.next(0, cur)) return;
    f32x4 acc[2][2][4][2];
#pragma unroll
    for (int a = 0; a < 2; ++a)
#pragma unroll
        for (int b = 0; b < 2; ++b)
#pragma unroll
            for (int m = 0; m < 4; ++m)
#pragma unroll
                for (int n = 0; n < 2; ++n) acc[a][b][m][n] = (f32x4){0.f, 0.f, 0.f, 0.f};
    bf16x8 At[4][2], B0[2][2], B1[2][2];
    const char* cA = (const char*)g.A + (size_t)cur.pm * tstepA + (size_t)cur.ka * 2; const char* cB = (const char*)g.Bt + (size_t)cur.pn * tstepB;
    S.a_ready(cur);
    if constexpr (SP2) {
        PG8_STAGE(PG8_SB(0, 0), cB + PG8_KOFF(0), voffB); PG8_STAGE(PG8_SB(0, 1), cB + hstepB + PG8_KOFF(0), voffB); PG8_STAGE(PG8_SA(0, 0), cA + PG8_KOFF(0), voffA); PG8_STAGE(PG8_SA(0, 1), cA + hstepA + PG8_KOFF(0), voffA);
        if (wr == 1) PG8_BAR;
        PG8_WAIT_V(2); PG8_BAR;
#if BAL_DMA
        PG8_STAGE(PG8_SB(1, 0), cB + PG8_KOFF(1), voffB); PG8_STAGE(PG8_SB(1, 1), cB + hstepB + PG8_KOFF(1), voffB);
        PG8_WAIT_V(4); PG8_BAR;
#else
        PG8_STAGE(PG8_SB(1, 0), cB + kstep, voffB); PG8_STAGE(PG8_SA(1, 0), cA + kstep, voffA); PG8_STAGE(PG8_SB(1, 1), cB + hstepB + kstep, voffB);
        PG8_WAIT_V(6); PG8_BAR;
#endif
    } else {
        PG8_STAGE(PG8_SB(0, 0), cB, voffB); PG8_STAGE(PG8_SA(0, 0), cA, voffA); PG8_STAGE(PG8_SB(0, 1), cB + hstepB, voffB); PG8_STAGE(PG8_SA(0, 1), cA + hstepA, voffA);
        if (wr == 1) PG8_BAR;
        PG8_WAIT_V(4); PG8_BAR;
        PG8_STAGE(PG8_SB(1, 0), cB + kstep, voffB); PG8_STAGE(PG8_SA(1, 0), cA + kstep, voffA); PG8_STAGE(PG8_SB(1, 1), cB + hstepB + kstep, voffB);
        PG8_WAIT_V(6); PG8_BAR;
    }
    for (;;) {
        const bool has_next = S.next(ui + 1, nxt);
        const char* nA = has_next ? (const char*)g.A + (size_t)nxt.pm * tstepA + (size_t)nxt.ka * 2 : cA; const char* nB = has_next ? (const char*)g.Bt + (size_t)nxt.pn * tstepB : cB;
#if LOOP_ALIGN
        asm volatile(".p2align 8" ::: "memory");
#endif
        for (int t = 0; t < nt; t += 2) {
            const bool last = (t == nt - 2);
            const char* a1 = cA + PG8_KOFF(t + 1);
            const char* a2 = last ? nA + PG8_KOFF(0) : cA + PG8_KOFF(t + 2); const char* b2 = last ? nB + PG8_KOFF(0) : cB + PG8_KOFF(t + 2);
            const char* a3 = last ? nA + PG8_KOFF(1) : cA + PG8_KOFF(t + 3); const char* b3 = last ? nB + PG8_KOFF(1) : cB + PG8_KOFF(t + 3);
            if (last && has_next) S.a_ready(nxt);
            if constexpr (SP2) {
#if BAL_DMA
#if DMA_SPLIT35
            PG8_LDB(B0, 0, 0); PG8_LDB(B1, 0, 1); PG8_SCHED; PG8_LDA(At, 0, 0); PG8_STAGE(PG8_SA(1, 0), a1, voffA); PG8_STAGE1(PG8_SA(1, 1), a1 + hstepA, voffA, 0);
            PG8_WAIT_V(7); PG8_WAIT_L(0); PG8_BAR; if (!HM || cur.hf != 2) { PG8_MMA(0, 0, At, B0); PG8_MMA(0, 1, At, B1); } PG8_BAR; PG8_SCHED;
            PG8_LDA(At, 0, 1); PG8_STAGE1(PG8_SA(1, 1), a1 + hstepA, voffA, 1); PG8_STAGE(PG8_SB(0, 0), b2, voffB); PG8_STAGE(PG8_SB(0, 1), b2 + hstepB, voffB);
            PG8_WAIT_V(6); PG8_WAIT_L(0); PG8_BAR; if (!HM || cur.hf != 1) { PG8_MMA(1, 0, At, B0); PG8_MMA(1, 1, At, B1); } PG8_BAR; PG8_SCHED;
            PG8_LDB(B0, 1, 0); PG8_LDB(B1, 1, 1); PG8_SCHED; PG8_LDA(At, 1, 0); PG8_STAGE(PG8_SA(0, 0), a2, voffA); PG8_STAGE1(PG8_SA(0, 1), a2 + hstepA, voffA, 0);
            PG8_WAIT_V(7); PG8_WAIT_L(0); PG8_BAR; if (!HM || cur.hf != 2) { PG8_MMA(0, 0, At, B0); PG8_MMA(0, 1, At, B1); } PG8_BAR; PG8_SCHED;
            PG8_LDA(At, 1, 1); PG8_STAGE1(PG8_SA(0, 1), a2 + hstepA, voffA, 1); PG8_STAGE(PG8_SB(1, 0), b3, voffB); PG8_STAGE(PG8_SB(1, 1), b3 + hstepB, voffB);
            PG8_WAIT_V(6); PG8_WAIT_L(0); PG8_BAR; if (!HM || cur.hf != 1) { PG8_MMA(1, 0, At, B0); PG8_MMA(1, 1, At, B1); } PG8_BAR; PG8_SCHED;
            (void)a3;
#elif STAGE_AFTER_L
            PG8_LDB(B0, 0, 0); PG8_LDB(B1, 0, 1); PG8_SCHED; PG8_LDA(At, 0, 0); PG8_WAIT_L(0); PG8_SCHED; PG8_STAGE(PG8_SA(1, 0), a1, voffA); PG8_STAGE(PG8_SA(1, 1), a1 + hstepA, voffA);
            PG8_WAIT_V(8); PG8_BAR; if (!HM || cur.hf != 2) { PG8_MMA(0, 0, At, B0); PG8_MMA(0, 1, At, B1); } PG8_BAR; PG8_SCHED;
            PG8_LDA(At, 0, 1); PG8_WAIT_L(0); PG8_SCHED; PG8_STAGE(PG8_SB(0, 0), b2, voffB); PG8_STAGE(PG8_SB(0, 1), b2 + hstepB, voffB);
            PG8_WAIT_V(6); PG8_BAR; if (!HM || cur.hf != 1) { PG8_MMA(1, 0, At, B0); PG8_MMA(1, 1, At, B1); } PG8_BAR; PG8_SCHED;
            PG8_LDB(B0, 1, 0); PG8_LDB(B1, 1, 1); PG8_SCHED; PG8_LDA(At, 1, 0); PG8_WAIT_L(0); PG8_SCHED; PG8_STAGE(PG8_SA(0, 0), a2, voffA); PG8_STAGE(PG8_SA(0, 1), a2 + hstepA, voffA);
            PG8_WAIT_V(8); PG8_BAR; if (!HM || cur.hf != 2) { PG8_MMA(0, 0, At, B0); PG8_MMA(0, 1, At, B1); } PG8_BAR; PG8_SCHED;
            PG8_LDA(At, 1, 1); PG8_WAIT_L(0); PG8_SCHED; PG8_STAGE(PG8_SB(1, 0), b3, voffB); PG8_STAGE(PG8_SB(1, 1), b3 + hstepB, voffB);
            PG8_WAIT_V(6); PG8_BAR; if (!HM || cur.hf != 1) { PG8_MMA(1, 0, At, B0); PG8_MMA(1, 1, At, B1); } PG8_BAR; PG8_SCHED;
            (void)a3;
#elif STAGE_FIRST
            PG8_STAGE(PG8_SA(1, 0), a1, voffA); PG8_STAGE(PG8_SA(1, 1), a1 + hstepA, voffA); PG8_SCHED; PG8_LDB(B0, 0, 0); PG8_LDB(B1, 0, 1); PG8_SCHED; PG8_LDA(At, 0, 0);
            PG8_WAIT_V(8); PG8_WAIT_L(0); PG8_BAR; if (!HM || cur.hf != 2) { PG8_MMA(0, 0, At, B0); PG8_MMA(0, 1, At, B1); } PG8_BAR; PG8_SCHED;
            PG8_STAGE(PG8_SB(0, 0), b2, voffB); PG8_STAGE(PG8_SB(0, 1), b2 + hstepB, voffB); PG8_SCHED; PG8_LDA(At, 0, 1);
            PG8_WAIT_V(6); PG8_WAIT_L(0); PG8_BAR; if (!HM || cur.hf != 1) { PG8_MMA(1, 0, At, B0); PG8_MMA(1, 1, At, B1); } PG8_BAR; PG8_SCHED;
            PG8_STAGE(PG8_SA(0, 0), a2, voffA); PG8_STAGE(PG8_SA(0, 1), a2 + hstepA, voffA); PG8_SCHED; PG8_LDB(B0, 1, 0); PG8_LDB(B1, 1, 1); PG8_SCHED; PG8_LDA(At, 1, 0);
            PG8_WAIT_V(8); PG8_WAIT_L(0); PG8_BAR; if (!HM || cur.hf != 2) { PG8_MMA(0, 0, At, B0); PG8_MMA(0, 1, At, B1); } PG8_BAR; PG8_SCHED;
            PG8_STAGE(PG8_SB(1, 0), b3, voffB); PG8_STAGE(PG8_SB(1, 1), b3 + hstepB, voffB); PG8_SCHED; PG8_LDA(At, 1, 1);
            PG8_WAIT_V(6); PG8_WAIT_L(0); PG8_BAR; if (!HM || cur.hf != 1) { PG8_MMA(1, 0, At, B0); PG8_MMA(1, 1, At, B1); } PG8_BAR; PG8_SCHED;
            (void)a3;
#else
            PG8_LDB(B0, 0, 0); PG8_LDB(B1, 0, 1); PG8_SCHED; PG8_LDA(At, 0, 0); PG8_STAGE(PG8_SA(1, 0), a1, voffA); PG8_STAGE(PG8_SA(1, 1), a1 + hstepA, voffA);
            PG8_WAIT_V(8); PG8_WAIT_L(0); PG8_BAR; if (!HM || cur.hf != 2) { PG8_MMA(0, 0, At, B0); PG8_MMA(0, 1, At, B1); } PG8_BAR; PG8_SCHED;
            PG8_LDA(At, 0, 1); PG8_STAGE(PG8_SB(0, 0), b2, voffB); PG8_STAGE(PG8_SB(0, 1), b2 + hstepB, voffB);
            PG8_WAIT_V(6); PG8_WAIT_L(0); PG8_BAR; if (!HM || cur.hf != 1) { PG8_MMA(1, 0, At, B0); PG8_MMA(1, 1, At, B1); } PG8_BAR; PG8_SCHED;
            PG8_LDB(B0, 1, 0); PG8_LDB(B1, 1, 1); PG8_SCHED; PG8_LDA(At, 1, 0); PG8_STAGE(PG8_SA(0, 0), a2, voffA); PG8_STAGE(PG8_SA(0, 1), a2 + hstepA, voffA);
            PG8_WAIT_V(8); PG8_WAIT_L(0); PG8_BAR; if (!HM || cur.hf != 2) { PG8_MMA(0, 0, At, B0); PG8_MMA(0, 1, At, B1); } PG8_BAR; PG8_SCHED;
            PG8_LDA(At, 1, 1); PG8_STAGE(PG8_SB(1, 0), b3, voffB); PG8_STAGE(PG8_SB(1, 1), b3 + hstepB, voffB);
            PG8_WAIT_V(6); PG8_WAIT_L(0); PG8_BAR; if (!HM || cur.hf != 1) { PG8_MMA(1, 0, At, B0); PG8_MMA(1, 1, At, B1); } PG8_BAR; PG8_SCHED;
            (void)a3;
#endif
#else
            PG8_LDB(B0, 0, 0); PG8_LDB(B1, 0, 1); PG8_SCHED; PG8_LDA(At, 0, 0); PG8_STAGE(PG8_SA(1, 1), a1 + hstepA, voffA);
            PG8_WAIT_VL(); PG8_WAIT_L(0); PG8_BAR; if (!HM || cur.hf != 2) { PG8_MMA(0, 0, At, B0); PG8_MMA(0, 1, At, B1); } PG8_BAR; PG8_SCHED;
            PG8_LDA(At, 0, 1); PG8_STAGE(PG8_SB(0, 0), b2, voffB); PG8_STAGE(PG8_SB(0, 1), b2 + hstepB, voffB); PG8_STAGE(PG8_SA(0, 0), a2, voffA); PG8_WARM(a2 + 2 * kstep, b2 + 2 * kstep);
            PG8_WAIT_VL(); PG8_WAIT_L(0); PG8_BAR; if (!HM || cur.hf != 1) { PG8_MMA(1, 0, At, B0); PG8_MMA(1, 1, At, B1); } PG8_BAR; PG8_SCHED;
            PG8_LDB(B0, 1, 0); PG8_LDB(B1, 1, 1); PG8_SCHED; PG8_LDA(At, 1, 0); PG8_STAGE(PG8_SA(0, 1), a2 + hstepA, voffA);
            PG8_WAIT_VL(); PG8_WAIT_L(0); PG8_BAR; if (!HM || cur.hf != 2) { PG8_MMA(0, 0, At, B0); PG8_MMA(0, 1, At, B1); } PG8_BAR; PG8_SCHED;
            PG8_LDA(At, 1, 1); PG8_STAGE(PG8_SB(1, 0), b3, voffB); PG8_STAGE(PG8_SB(1, 1), b3 + hstepB, voffB); PG8_STAGE(PG8_SA(1, 0), a3, voffA); PG8_WARM(a3 + 2 * kstep, b3 + 2 * kstep);
            PG8_WAIT_VL(); PG8_WAIT_L(0); PG8_BAR; if (!HM || cur.hf != 1) { PG8_MMA(1, 0, At, B0); PG8_MMA(1, 1, At, B1); } PG8_BAR; PG8_SCHED;
#endif
            } else {
            PG8_LDB(B0, 0, 0); PG8_SCHED; PG8_LDA(At, 0, 0); PG8_STAGE(PG8_SA(1, 1), a1 + hstepA, voffA);
            PG8_WAIT_L(8); PG8_BAR; PG8_WAIT_L(0); PG8_MMA(0, 0, At, B0); PG8_BAR; PG8_SCHED;
            PG8_LDB(B1, 0, 1); PG8_STAGE(PG8_SB(0, 0), b2, voffB);
            PG8_BAR; PG8_WAIT_L(0); PG8_MMA(0, 1, At, B1); PG8_BAR;
            PG8_LDA(At, 0, 1); PG8_STAGE(PG8_SA(0, 0), a2, voffA);
            PG8_BAR; PG8_WAIT_L(0); PG8_MMA(1, 0, At, B0); PG8_BAR; PG8_SCHED;
            PG8_STAGE(PG8_SB(0, 1), b2 + hstepB, voffB);
            PG8_WAIT_V(6); PG8_BAR; PG8_MMA(1, 1, At, B1); PG8_BAR;
            PG8_LDB(B0, 1, 0); PG8_SCHED; PG8_LDA(At, 1, 0); PG8_STAGE(PG8_SA(0, 1), a2 + hstepA, voffA);
            PG8_WAIT_L(8); PG8_BAR; PG8_WAIT_L(0); PG8_MMA(0, 0, At, B0); PG8_BAR; PG8_SCHED;
            PG8_LDB(B1, 1, 1); PG8_STAGE(PG8_SB(1, 0), b3, voffB);
            PG8_BAR; PG8_WAIT_L(0); PG8_MMA(0, 1, At, B1); PG8_BAR;
            PG8_LDA(At, 1, 1); PG8_STAGE(PG8_SA(1, 0), a3, voffA);
            PG8_BAR; PG8_WAIT_L(0); PG8_MMA(1, 0, At, B0); PG8_BAR; PG8_SCHED;
            PG8_STAGE(PG8_SB(1, 1), b3 + hstepB, voffB);
            PG8_WAIT_V(6); PG8_BAR; PG8_MMA(1, 1, At, B1); PG8_BAR;
            }
        }
        if constexpr (ALIGN_EPI) { if (wr == 0) PG8_BAR; }
        if constexpr (!Epi::AFTER_DRAIN) { E(acc, cur, wr, wc, fr, fq); S.done(cur); }
        if (!has_next) break;
#pragma unroll
        for (int a = 0; a < 2; ++a)
#pragma unroll
            for (int b = 0; b < 2; ++b)
#pragma unroll
                for (int m = 0; m < 4; ++m)
#pragma unroll
                    for (int n = 0; n < 2; ++n) acc[a][b][m][n] = (f32x4){0.f, 0.f, 0.f, 0.f};
        cur = nxt; cA = nA; cB = nB; ++ui;
        if constexpr (ALIGN_EPI) { if (wr == 1) PG8_BAR; }
    }
    PG8_WAIT_V(0);
    if constexpr (!ALIGN_EPI) { if (wr == 0) PG8_BAR; }
    PG8_BAR;
    if constexpr (Epi::AFTER_DRAIN) { E.fused(acc, cur, wr, wc, fr, fq, lds, wid, lane); S.done(cur); }
#undef PG8_SA
#undef PG8_SB
#undef PG8_STAGE
#undef PG8_LDA
#undef PG8_LDB
#undef PG8_MMA
#undef PG8_WAIT_V
#undef PG8_KOFF
#undef PG8_WARM
#undef PG8_WAIT_VL
#undef PG8_WAIT_L
#undef PG8_BAR
#undef PG8_SCHED
}
}
constexpr size_t MiB = 1u << 20;
constexpr size_t WS_CTL = 0, CTL_ZERO_BYTES = (DBG || PROBE) ? 1 * MiB : 128 * 1024;
constexpr size_t WS_SSQ = 1 * MiB;
constexpr size_t WS_ROPE_C = 2 * MiB, WS_ROPE_S = 3 * MiB;
constexpr size_t WS_MEMN = 16 * MiB;
constexpr size_t WS_MK = 5 * MiB, WS_MVT = 6 * MiB;
constexpr size_t WS_KB = 7 * MiB, WS_VT = 10 * MiB;
constexpr size_t WS_WPOOL = 13 * MiB;
constexpr size_t WS_WMKV = 17 * MiB + (size_t)256 * PITCH_PAD * 2, WMKV_BYTES = (size_t)4096 * cfg::PD * 2;
constexpr size_t WS_WIN = WS_WMKV + WMKV_BYTES, WIO_BYTES = (size_t)cfg::D * cfg::PD * 2;
constexpr size_t WS_WOUT = WS_WIN + 4 * WIO_BYTES;
constexpr size_t WS_WD = WS_WOUT + 4 * WIO_BYTES, WD_BYTES = (size_t)cfg::D * cfg::PF * 2;
constexpr size_t WS_WGU = WS_WD + 8 * WD_BYTES, WGU_BYTES = (size_t)cfg::NGU_PAD * cfg::PD * 2;
constexpr size_t ACT_BYTES = (size_t)cfg::S * cfg::PD * 2;
constexpr size_t WS_HB = WS_WGU + 8 * WGU_BYTES;
constexpr size_t WS_HL = WS_HB + ACT_BYTES;
constexpr size_t WS_AQ = WS_HL + ACT_BYTES;
constexpr size_t WS_Y = WS_AQ + ACT_BYTES;
constexpr size_t WS_HFF = WS_Y + ACT_BYTES;
constexpr size_t WS_Z = ((WS_HFF + (size_t)cfg::S * cfg::PF * 2 + MiB - 1) / MiB) * MiB;
constexpr size_t WS_WOUT2 = WS_Z, WS_WPS = WS_Z + 40 * MiB;
constexpr size_t WS_QMF = WS_Z + 48 * MiB;
constexpr size_t WS_SPL = DBG ? WS_Z : WS_QMF + 8 * MiB;
constexpr size_t WS_END = WS_QMF + 8 * MiB + (DBG ? 0 : 32 * MiB);
constexpr int CW_SPL = 20480;
static_assert(WS_WPOOL + 3 * MiB <= WS_MEMN && WS_MEMN + (size_t)256 * cfg::PD * 2 <= WS_WMKV && WS_QMF + 8 * MiB <= WS_END && (WS_WIN % 256) == 0 && (WS_WD % 256) == 0 && (WS_WGU % 256) == 0 && (WS_HB % 256) == 0 && (WS_HFF % 256) == 0, "d_ws map");
constexpr int CW_BAR = 4096;
constexpr int RING_OFF = 0, RING_BYTES = 131072;
constexpr int LDSCTL_OFF = RING_BYTES, MISC_OFF = LDSCTL_OFF + 320;
constexpr int RSTD_TAB_OFF = RING_BYTES + 8192;
constexpr int LDS_BYTES = 147456;
constexpr int NWAVES = 8;

#define GAS __attribute__((address_space(1)))
#define LAS __attribute__((address_space(3)))
typedef unsigned short bf16;
typedef unsigned v4u __attribute__((ext_vector_type(4)));
typedef unsigned v2u __attribute__((ext_vector_type(2)));
typedef float f32x4 __attribute__((ext_vector_type(4)));
typedef float f32x16 __attribute__((ext_vector_type(16)));
typedef short bf16x8 __attribute__((ext_vector_type(8)));
typedef short s16x4 __attribute__((ext_vector_type(4)));
#define LDS_WAIT() asm volatile("s_waitcnt lgkmcnt(0)" ::: "memory")
#define VM_WAIT() asm volatile("s_waitcnt vmcnt(0)" ::: "memory")
using pg8::pkbf;

#define XB_TMO      128
#define XB_XCNT(j)  (256  + 64 * (j))
#define XB_XSUB(j)  (1280 + 64 * (j))
#define XB_XGEN(j)  (2304 + 64 * (j))
#define XB_TOP      3328
#define XB_TOPGEN   3392
#define XCD_BAR_WORDS 3456
#define XB_SPIN_CAP (1u << 18)

__device__ __forceinline__ unsigned xb_ld(unsigned* p)              { return __hip_atomic_load(p, __ATOMIC_RELAXED, __HIP_MEMORY_SCOPE_AGENT); }
__device__ __forceinline__ unsigned xb_add(unsigned* p, unsigned v) { return __hip_atomic_fetch_add(p, v, __ATOMIC_RELAXED, __HIP_MEMORY_SCOPE_AGENT); }
__device__ __forceinline__ unsigned xb_xcc_id() { return (unsigned)__builtin_amdgcn_s_getreg((3 << 11) | 20) & 0xFu; }
#define XB_SPIN(cond, bar) do { unsigned _sp = 0; while (cond) { __builtin_amdgcn_s_sleep(1); \
    if ((++_sp & 255u) == 0u) { if (xb_ld(&(bar)[XB_TMO])) break; if (_sp > XB_SPIN_CAP) { atomicAdd(&(bar)[XB_TMO], 1u); break; } } } } while (0)

struct XcdBarrier {
    unsigned* bar; unsigned x;
    volatile LAS unsigned* st;
};

__device__ __forceinline__ XcdBarrier xcd_barrier_post(unsigned* bar, volatile LAS unsigned* st) {
    XcdBarrier b; b.bar = bar; b.x = xb_xcc_id(); b.st = st;
    if (threadIdx.x == 0) (void)xb_add(&bar[XB_XCNT(b.x)], 1u);
    return b;
}
__device__ __forceinline__ void xcd_barrier_complete(unsigned* bar, unsigned x, unsigned& nloc, unsigned& nx) {
    const unsigned G = gridDim.x * gridDim.y * gridDim.z;
    unsigned sum, cnt, mine, sp = 0u;
    for (;;) {
        sum = 0u; cnt = 0u; mine = 0u;
#pragma unroll
        for (unsigned j = 0; j < 16; ++j) { const unsigned c = xb_ld(&bar[XB_XCNT(j)]); sum += c; cnt += (c > 0u) ? 1u : 0u; mine = (j == x) ? c : mine; }
        if (sum == G) break;
        __builtin_amdgcn_s_sleep(1);
        if ((++sp & 255u) == 0u) { if (xb_ld(&bar[XB_TMO])) break; if (sp > XB_SPIN_CAP) { atomicAdd(&bar[XB_TMO], 1u); break; } }
    }
    nloc = mine > 0u ? mine : 1u; nx = cnt > 0u ? cnt : 1u;
}

__device__ __forceinline__ void xcd_barrier(const XcdBarrier& b) {
    asm volatile("s_waitcnt vmcnt(0)" ::: "memory");
    __syncthreads();
    if (threadIdx.x == 0) {
        unsigned* bar = b.bar;
        __builtin_amdgcn_s_waitcnt(0);
        unsigned nloc = b.st[0], nx = b.st[1];
        if (nloc == 0u) { xcd_barrier_complete(bar, b.x, nloc, nx); b.st[0] = nloc; b.st[1] = nx; }
        const unsigned old = xb_add(&bar[XB_XSUB(b.x)], 1u);
        const unsigned gen = old / nloc;
        if (old + 1u == (gen + 1u) * nloc) {
            __builtin_amdgcn_fence(__ATOMIC_RELEASE, "agent");
            asm volatile("s_waitcnt vmcnt(0)" ::: "memory");
            const unsigned og = xb_add(&bar[XB_TOP], 1u);
            const unsigned tg = og / nx;
            if (og + 1u == (tg + 1u) * nx) xb_add(&bar[XB_TOPGEN], 1u);
            else XB_SPIN(xb_ld(&bar[XB_TOPGEN]) == tg, bar);
            __builtin_amdgcn_fence(__ATOMIC_ACQUIRE, "agent");
            xb_add(&bar[XB_XGEN(b.x)], 1u);
            asm volatile("s_waitcnt vmcnt(0)" ::: "memory");
        } else {
#if EARLY_WB
            if (old == gen * nloc || old == gen * nloc + nloc / 2) { __builtin_amdgcn_fence(__ATOMIC_RELEASE, "agent"); asm volatile("s_waitcnt vmcnt(0)" ::: "memory"); }
#endif
            XB_SPIN(xb_ld(&bar[XB_XGEN(b.x)]) == gen, bar);
            __builtin_amdgcn_fence(__ATOMIC_ACQUIRE, "agent");
            asm volatile("s_waitcnt vmcnt(0)" ::: "memory");
        }
    }
    __syncthreads();
}

constexpr int CW_GRP = 12288, CW_GRPX = 16384;
__device__ __forceinline__ void grp_barrier(unsigned* ctl, int pm, unsigned target, bool same_xcd) {
    asm volatile("s_waitcnt vmcnt(0)" ::: "memory");
    __syncthreads();
    if (threadIdx.x == 0) {
        unsigned* ctr = ctl + CW_GRP + 64 * pm; unsigned* tmo = ctl + CW_BAR + XB_TMO;
        if (!same_xcd) __builtin_amdgcn_fence(__ATOMIC_RELEASE, "agent");
        asm volatile("s_waitcnt vmcnt(0)" ::: "memory");
        (void)xb_add(ctr, 1u);
#if EARLY_ACQ
        __builtin_amdgcn_fence(__ATOMIC_ACQUIRE, "agent");
#endif
        unsigned sp = 0u;
        while (xb_ld(ctr) < target) { __builtin_amdgcn_s_sleep(1); if ((++sp & 255u) == 0u) { if (xb_ld(tmo)) break; if (sp > XB_SPIN_CAP) { atomicAdd(tmo, 1u); break; } } }
#if !EARLY_ACQ
        __builtin_amdgcn_fence(__ATOMIC_ACQUIRE, "agent");
#endif
        asm volatile("s_waitcnt vmcnt(0)" ::: "memory");
    }
    __syncthreads();
}

struct Frame {
    LAS unsigned char* lds;
    volatile LAS unsigned* MISC;
    int tid, lane, wave, vcu, G;
    const float *x, *mem; const int* pos; const float *norms, *gate, *up, *down, *w_in, *w_out, *pool_w, *pool_scale, *w_kv, *kv_norm, *sinks, *w_mem_kv, *mem_norm, *final_norm;
    float* out; unsigned char* ws;
};
__device__ __forceinline__ float wave_sum(float v) {
#pragma unroll
    for (int o = 1; o < 64; o <<= 1) v += __shfl_xor(v, o);
    return v;
}
__device__ __forceinline__ int rope_slot(int d) { return 8 * ((d & 31) >> 2) + 4 * (d >> 5) + (d & 3); }
__device__ __forceinline__ int map_row(int map, int n) {
    if (map == 1) return (n >> 7) * 256 + (n & 127);
    if (map == 2) return (n >> 7) * 256 + 128 + (n & 127);
    if (map == 3) return n < 1536 ? (n & ~63) + rope_slot(n & 63) : n;
    if (map == 4) return n < 192 ? (n & ~63) + rope_slot(n & 63) : n;
    return n;
}
__device__ __forceinline__ void conv_item(const float* W, int N, int k0, int n0, const float* gain, bf16* dst, int dst_ld, int map, int row_off, LAS float* scr, int lane) {
    f32x4 v8[8];
    const int c = lane & 7;
    f32x4 g0 = (f32x4){1.f, 1.f, 1.f, 1.f}, g1 = g0;
    if (gain) { g0 = *(const f32x4*)(gain + k0 + 8 * c); g1 = *(const f32x4*)(gain + k0 + 8 * c + 4); }
#pragma unroll
    for (int i = 0; i < 8; ++i) { const int kr = (lane >> 3) + 8 * i; v8[i] = __builtin_nontemporal_load((const f32x4*)(W + (size_t)(k0 + kr) * N + n0 + (lane & 7) * 4)); }
    asm volatile("" ::: "memory");
#pragma unroll
    for (int i = 0; i < 8; ++i) { const int kr = (lane >> 3) + 8 * i; const f32x4 v = v8[i];
        LAS float* s = scr + kr * 33 + (lane & 7) * 4; s[0] = v[0]; s[1] = v[1]; s[2] = v[2]; s[3] = v[3]; }
    LDS_WAIT(); asm volatile("" ::: "memory");
#pragma unroll
    for (int j = 0; j < 4; ++j) { const int n = (lane >> 3) + 8 * j; const LAS float* s = scr + (8 * c) * 33 + n;
        v4u o; o.x = pkbf(s[0 * 33] * g0[0], s[1 * 33] * g0[1]); o.y = pkbf(s[2 * 33] * g0[2], s[3 * 33] * g0[3]); o.z = pkbf(s[4 * 33] * g1[0], s[5 * 33] * g1[1]); o.w = pkbf(s[6 * 33] * g1[2], s[7 * 33] * g1[3]);
        if (CONV_NT) __builtin_nontemporal_store(o, (v4u*)(dst + (size_t)(map_row(map, n0 + n) + row_off) * dst_ld + k0 + 8 * c)); else *(v4u*)(dst + (size_t)(map_row(map, n0 + n) + row_off) * dst_ld + k0 + 8 * c) = o; }
    LDS_WAIT(); asm volatile("" ::: "memory");
}
#ifndef CV_TAIL
#define CV_TAIL 0
#endif
#ifndef IO_IN_PRO
#define IO_IN_PRO 1
#endif
constexpr int CV_FFN1 = 3 * 5632, CV_IO1 = 2 * 2048, CV_NIO = IO_IN_PRO ? 4 : 1, CV_MISC = 4 * 1024 + 8 * 72 + 384, CV_REST = CV_FFN1 - CV_TAIL, CV_PRO = CV_FFN1 + 7 * CV_REST + CV_NIO * CV_IO1 + CV_MISC;
__device__ __forceinline__ void conv_ffn(Frame& F, int i8, int r3, LAS float* scr, int lane) {
    using namespace cfg;
    const int kind = r3 / 5632, r = r3 % 5632, l = i8 >> 1, half = i8 & 1;
    if (kind < 2) conv_item((kind ? F.up : F.gate) + (size_t)i8 * D * FF, FF, 64 * (r / 176), 32 * (r % 176), F.norms + (size_t)(l * 3 + (half ? 2 : 0)) * D, (bf16*)(F.ws + WS_WGU + (size_t)i8 * WGU_BYTES), PD, 1 + kind, 0, scr, lane);
    else conv_item(F.down + (size_t)i8 * FF * D, D, 64 * (r / 64), 32 * (r % 64), nullptr, (bf16*)(F.ws + WS_WD + (size_t)i8 * WD_BYTES), PF, 0, 0, scr, lane);
}
__device__ __forceinline__ void conv_io(Frame& F, int l, int r2, LAS float* scr, int lane) {
    using namespace cfg;
    const int r = r2 & 2047;
    if (r2 < 2048) conv_item(F.w_in + (size_t)l * D * D, D, 64 * (r / 64), 32 * (r % 64), F.norms + (size_t)(l * 3 + 1) * D, (bf16*)(F.ws + WS_WIN + (size_t)l * WIO_BYTES), PD, l >= 2 ? 3 : 0, 0, scr, lane);
    else conv_item(F.w_out + (size_t)l * D * D, D, 64 * (r / 64), 32 * (r % 64), nullptr, (bf16*)(F.ws + ((POOL_FOLD && l < 2 && r / 64 >= 24) ? WS_WOUT2 : WS_WOUT) + (size_t)l * WIO_BYTES), PD, 0, 0, scr, lane);
}
__device__ __forceinline__ void conv_misc(Frame& F, int it, LAS float* scr, int lane) {
    using namespace cfg;
    if (it < 4096) { const int l = it / 1024, r = it % 1024;
        conv_item(F.w_mem_kv + (size_t)l * D * 1024, 1024, 64 * (r / 32), 32 * (r % 32), nullptr, (bf16*)(F.ws + WS_WMKV), PD, 0, l * 1024, scr, lane); return; }
    it -= 4096;
    if (it < 576) { const int pg = it / 72, r = it % 72, l = pg >> 2, g = pg & 3;
        conv_item(F.pool_w + (size_t)pg * 384 * 384, 384, 64 * (r / 12), 32 * (r % 12), nullptr, (bf16*)(F.ws + WS_WPOOL) + (size_t)l * 2048 * 384, 384, 0, g * 512, scr, lane); return; }
    it -= 576;
    conv_item(F.w_kv, 384, 64 * (it / 12), 32 * (it % 12), F.kv_norm, (bf16*)(F.ws + WS_WGU + 4 * WGU_BYTES), PD, 4, NGU, scr, lane);
}
constexpr int CW_CONV = 8192;
__device__ __forceinline__ void conv_tail(Frame& F, int i) {
    if (i >= 7) return;
    int lane = threadIdx.x; asm volatile("" : "+v"(lane)); lane &= 63;
    LAS float* scr = (LAS float*)(F.lds + RING_OFF + F.wave * 16384);
    unsigned* head = (unsigned*)(F.ws + WS_CTL) + CW_CONV + 64 * i;
    const int nitems = CV_TAIL + (((i & 1) && !IO_IN_PRO) ? CV_IO1 : 0), nch = nitems / 8;
    if (nitems == 0) return;
    for (;;) {
        unsigned ch = 0u;
        if (lane == 0) ch = __hip_atomic_fetch_add(head, 1u, __ATOMIC_RELAXED, __HIP_MEMORY_SCOPE_AGENT);
        ch = (unsigned)__builtin_amdgcn_readfirstlane((int)ch);
        if ((int)ch >= nch) break;
        for (int k = 0; k < 8; ++k) { const int it = (int)ch * 8 + k; if (it < CV_TAIL) conv_ffn(F, i + 1, it, scr, lane); else conv_io(F, (i + 1) >> 1, it - CV_TAIL, scr, lane); }
    }
}
__device__ __forceinline__ void p0_prologue(Frame& F) {
    using namespace cfg;
    LAS float* scr = (LAS float*)(F.lds + RING_OFF + F.wave * 16384);
    const int gw = F.vcu * NWAVES + F.wave, NGW = F.G * NWAVES;
    for (int it = gw; it < CV_PRO; it += NGW) { int r = CONV_REVERSE ? CV_PRO - 1 - it : it;
        if (r < CV_FFN1) { conv_ffn(F, 0, r, scr, F.lane); continue; } r -= CV_FFN1;
        if (r < 7 * CV_REST) { conv_ffn(F, 1 + r / CV_REST, CV_TAIL + r % CV_REST, scr, F.lane); continue; } r -= 7 * CV_REST;
        if (r < CV_NIO * CV_IO1) { conv_io(F, r / CV_IO1, r % CV_IO1, scr, F.lane); continue; } r -= CV_NIO * CV_IO1;
        conv_misc(F, r, scr, F.lane); }
    bf16* HB = (bf16*)(F.ws + WS_HB); float* ssq = (float*)(F.ws + WS_SSQ);
    { f32x4 xv[8], xn[8];
      if (gw < S) { const f32x4* xr = (const f32x4*)(F.x + (size_t)gw * D) + F.lane;
#pragma unroll
          for (int j = 0; j < 8; ++j) xv[j] = xr[64 * j]; }
      for (int m = gw; m < S; m += NGW) { const int mn = m + NGW < S ? m + NGW : m; const f32x4* xr = (const f32x4*)(F.x + (size_t)mn * D) + F.lane;
#pragma unroll
          for (int j = 0; j < 8; ++j) xn[j] = xr[64 * j];
          asm volatile("" ::: "memory");
          float s = 0.f; v2u* o8 = (v2u*)(HB + (size_t)m * PD) + F.lane;
#pragma unroll
          for (int j = 0; j < 8; ++j) { const f32x4 v = xv[j]; s += (v[0] * v[0] + v[1] * v[1]) + (v[2] * v[2] + v[3] * v[3]); v2u w; w.x = pkbf(v[0], v[1]); w.y = pkbf(v[2], v[3]); o8[64 * j] = w; }
          s = wave_sum(s);
          if (F.lane < 8) ssq[(size_t)m * 8 + F.lane] = F.lane == 0 ? s : 0.f;
#pragma unroll
          for (int j = 0; j < 8; ++j) xv[j] = xn[j]; } }
    bf16* MEMN = (bf16*)(F.ws + WS_MEMN);
    for (int m = gw; m < ML; m += NGW) { const f32x4* xr = (const f32x4*)(F.mem + (size_t)m * D) + F.lane; const f32x4* gr = (const f32x4*)F.mem_norm + F.lane; float s = 0.f; f32x4 v[8];
#pragma unroll
        for (int j = 0; j < 8; ++j) { v[j] = xr[64 * j]; s += (v[j][0] * v[j][0] + v[j][1] * v[j][1]) + (v[j][2] * v[j][2] + v[j][3] * v[j][3]); }
        const float rs = __builtin_amdgcn_rsqf(wave_sum(s) * (1.0f / D) + EPS); v2u* o8 = (v2u*)(MEMN + (size_t)m * PD) + F.lane;
#pragma unroll
        for (int j = 0; j < 8; ++j) { const f32x4 g = gr[64 * j]; v2u w; w.x = pkbf(v[j][0] * rs * g[0], v[j][1] * rs * g[1]); w.y = pkbf(v[j][2] * rs * g[2], v[j][3] * rs * g[3]); o8[64 * j] = w; } }
#if POOL_FOLD
    for (int idx = gw * 64 + F.lane; idx < 8 * 384 * 96; idx += NGW * 64) { const int pg = idx / (384 * 96), rem = idx % (384 * 96), j = rem / 96, m4 = (rem % 96) * 4, l = pg >> 2, g = pg & 3;
        const f32x4 p = *(const f32x4*)(F.pool_w + ((size_t)pg * 384 + j) * 384 + m4), sc = *(const f32x4*)(F.pool_scale + (size_t)l * MIX + g * 384 + m4);
        v2u w; w.x = pkbf(p[0] * sc[0], p[1] * sc[1]); w.y = pkbf(p[2] * sc[2], p[3] * sc[3]);
        *(v2u*)((bf16*)(F.ws + WS_WPS) + ((size_t)l * 2048 + g * 512 + j) * 384 + m4) = w; }
#endif
    float* rc = (float*)(F.ws + WS_ROPE_C); float* rsn = (float*)(F.ws + WS_ROPE_S);
    for (int idx = gw * 64 + F.lane; idx < S * 32; idx += NGW * 64) { const int t = idx >> 5, i = idx & 31;
        const float inv_freq = 1.0f / powf(10000.0f, (float)i * (2.0f / 64.0f)); const float ang = (float)F.pos[t] * inv_freq; float sn, cs; sincosf(ang, &sn, &cs); rc[idx] = cs; rsn[idx] = sn; }
}
#define MFMA32(a, b, c) __builtin_amdgcn_mfma_f32_32x32x16_bf16((a), (b), (c), 0, 0, 0)
__device__ __forceinline__ bf16x8 cat8(s16x4 a, s16x4 b) { return __builtin_shufflevector(a, b, 0, 1, 2, 3, 4, 5, 6, 7); }
template <int ND> __device__ __forceinline__ void softmax_tile(f32x16& p, float& m, float& lsum, f32x16 (&o)[ND], bf16x8 (&pb)[2]) {
    float tm = p[0];
#pragma unroll
    for (int r = 1; r < 16; ++r) tm = fmaxf(tm, p[r]);
    tm = fmaxf(tm, __shfl_xor(tm, 32));
    const float mn = fmaxf(m, tm), f = __builtin_amdgcn_exp2f(m - mn); m = mn;
    float ps = 0.f;
#pragma unroll
    for (int r = 0; r < 16; ++r) { p[r] = __builtin_amdgcn_exp2f(p[r] - mn); ps += p[r]; }
    lsum = lsum * f + ps;
#pragma unroll
    for (int d = 0; d < ND; ++d)
#pragma unroll
        for (int r = 0; r < 16; ++r) o[d][r] *= f;
#pragma unroll
    for (int s = 0; s < 2; ++s) { v4u w; w.x = pkbf(p[8 * s + 0], p[8 * s + 1]); w.y = pkbf(p[8 * s + 2], p[8 * s + 3]); w.z = pkbf(p[8 * s + 4], p[8 * s + 5]); w.w = pkbf(p[8 * s + 6], p[8 * s + 7]); pb[s] = __builtin_bit_cast(bf16x8, w); }
}
__device__ __forceinline__ int opaque_lane() { int t = threadIdx.x; asm volatile("" : "+v"(t)); return t & 63; }
__device__ __forceinline__ void store_o32(bf16* yrow  , const f32x16& o, float inv, int hi) {
#pragma unroll
    for (int g = 0; g < 4; g += 2) {
        unsigned ax = pkbf(o[4 * g] * inv, o[4 * g + 1] * inv), ay = pkbf(o[4 * g + 2] * inv, o[4 * g + 3] * inv);
        unsigned bx = pkbf(o[4 * g + 4] * inv, o[4 * g + 5] * inv), by = pkbf(o[4 * g + 6] * inv, o[4 * g + 7] * inv);
        const auto r0 = __builtin_amdgcn_permlane32_swap(ax, bx, false, false); ax = r0[0]; bx = r0[1];
        const auto r1 = __builtin_amdgcn_permlane32_swap(ay, by, false, false); ay = r1[0]; by = r1[1];
        v4u w; w.x = ax; w.y = ay; w.z = bx; w.w = by;
        *(v4u*)(yrow + 8 * g + 8 * hi) = w; }
}
__device__ __forceinline__ void mem_item(Frame& F, int l, int h, int qb) {
    const int lane = opaque_lane(), r32 = lane & 31, hi = lane >> 5;
    bf16* Y = (bf16*)(F.ws + WS_Y);
    const bf16* Qp = (const bf16*)(F.ws + WS_QMF) + (size_t)((h * 256 + qb) * 8) * 512 + lane * 8;
    const bf16* Kp = (const bf16*)(F.ws + WS_MK) + (size_t)((l * 4 + h) * 8) * 8 * 512 + lane * 8;
    const bf16* Vp = (const bf16*)(F.ws + WS_MVT) + (size_t)((l * 4 + h) * 8) * 8 * 512 + lane * 8;
    bf16x8 qf[8], kf[8], vf[8];
#pragma unroll
    for (int j = 0; j < 8; ++j) { qf[j] = *(const bf16x8*)(Qp + j * 512); kf[j] = *(const bf16x8*)(Kp + j * 512); }
#pragma unroll
    for (int j = 0; j < 8; ++j) vf[j] = *(const bf16x8*)(Vp + j * 512);
    f32x16 o[4];
#pragma unroll
    for (int d = 0; d < 4; ++d)
#pragma unroll
        for (int r = 0; r < 16; ++r) o[d][r] = 0.f;
    float m = -1e30f, lsum = 0.f;
#pragma clang loop unroll(disable)
    for (int kt = 0; kt < 8; ++kt) {
        f32x16 p;
#pragma unroll
        for (int r = 0; r < 16; ++r) p[r] = 0.f;
#pragma unroll
        for (int j = 0; j < 8; ++j) p = MFMA32(kf[j], qf[j], p);
        const int kn = kt < 7 ? kt + 1 : kt;
#pragma unroll
        for (int j = 0; j < 8; ++j) kf[j] = *(const bf16x8*)(Kp + (size_t)(kn * 8 + j) * 512);
        bf16x8 pb[2]; softmax_tile<4>(p, m, lsum, o, pb);
#pragma unroll
        for (int d = 0; d < 4; ++d)
#pragma unroll
            for (int s2 = 0; s2 < 2; ++s2) o[d] = MFMA32(vf[d * 2 + s2], pb[s2], o[d]);
#pragma unroll
        for (int j = 0; j < 8; ++j) vf[j] = *(const bf16x8*)(Vp + (size_t)(kn * 8 + j) * 512);
    }
    lsum += __shfl_xor(lsum, 32); const float inv = 1.0f / lsum;
    bf16* yp = Y + (size_t)(qb * 32 + r32) * cfg::PD + 1536 + h * 128;
#pragma unroll
    for (int d = 0; d < 4; ++d) store_o32(yp + d * 32, o[d], inv, hi);
}
__device__ __forceinline__ void swa_item(Frame& F, int l, int hq, int qb) {
    const int lane = opaque_lane(), r32 = lane & 31, hi = lane >> 5, kvh = hq >> 3;
    bf16* Y = (bf16*)(F.ws + WS_Y);
    const bf16* Qp = (const bf16*)(F.ws + WS_AQ) + (size_t)((hq * 256 + qb) * 4) * 512 + lane * 8;
    const bf16* Kp = (const bf16*)(F.ws + WS_KB) + (size_t)(kvh * 256) * 4 * 512 + lane * 8;
    const bf16* Vp = (const bf16*)(F.ws + WS_VT) + (size_t)(kvh * 256) * 4 * 512 + lane * 8;
    const int i0 = qb < 4 ? 4 - qb : 0;
    bf16x8 qf[4], kf[4], vf[4];
#pragma unroll
    for (int j = 0; j < 4; ++j) { qf[j] = *(const bf16x8*)(Qp + j * 512); kf[j] = *(const bf16x8*)(Kp + (size_t)((qb - 4 + i0) * 4 + j) * 512); }
#pragma unroll
    for (int j = 0; j < 4; ++j) vf[j] = *(const bf16x8*)(Vp + (size_t)((qb - 4 + i0) * 4 + j) * 512);
    f32x16 o[2];
#pragma unroll
    for (int d = 0; d < 2; ++d)
#pragma unroll
        for (int r = 0; r < 16; ++r) o[d][r] = 0.f;
    float m = F.sinks[(l - 2) * cfg::NQH + hq] * cfg::LOG2E, lsum = hi == 0 ? 1.0f : 0.0f;
#pragma clang loop unroll(disable)
    for (int i = i0; i < 5; ++i) { const int kt = qb - 4 + i;
        f32x16 p;
#pragma unroll
        for (int r = 0; r < 16; ++r) p[r] = 0.f;
#pragma unroll
        for (int j = 0; j < 4; ++j) p = MFMA32(kf[j], qf[j], p);
        const int kn = i < 4 ? kt + 1 : kt;
#pragma unroll
        for (int j = 0; j < 4; ++j) kf[j] = *(const bf16x8*)(Kp + (size_t)(kn * 4 + j) * 512);
        if (i == 0 || i == 4) {
#pragma unroll
            for (int r = 0; r < 16; ++r) { const int jj = (r & 3) + 8 * (r >> 2) + 4 * hi; const bool ok = (i == 0) ? (jj >= r32 + 1) : (jj <= r32); p[r] = ok ? p[r] : -INFINITY; } }
        bf16x8 pb[2]; softmax_tile<2>(p, m, lsum, o, pb);
#pragma unroll
        for (int d = 0; d < 2; ++d)
#pragma unroll
            for (int s2 = 0; s2 < 2; ++s2) o[d] = MFMA32(vf[d * 2 + s2], pb[s2], o[d]);
#pragma unroll
        for (int j = 0; j < 4; ++j) vf[j] = *(const bf16x8*)(Vp + (size_t)(kn * 4 + j) * 512);
    }
    lsum += __shfl_xor(lsum, 32); const float inv = 1.0f / lsum;
    bf16* yp = Y + (size_t)(qb * 32 + r32) * cfg::PD + hq * 64;
#pragma unroll
    for (int d = 0; d < 2; ++d) store_o32(yp + d * 32, o[d], inv, hi);
}
__device__ __forceinline__ void stage_lds(Frame& F, const void* src, int lds_off, int bytes) {
    for (int i = 0; i < bytes / 8192; ++i)
        __builtin_amdgcn_global_load_lds((const unsigned*)((const char*)src + (size_t)i * 8192 + F.tid * 16), (LAS unsigned*)(F.lds + lds_off + i * 8192 + F.wave * 1024), 16, 0, 0);
}
__device__ __forceinline__ void mem_item_lds(Frame& F, int h, int qb, const LAS unsigned char* kv) {
    const int lane = opaque_lane(), r32 = lane & 31, hi = lane >> 5;
    bf16* Y = (bf16*)(F.ws + WS_Y);
    const bf16* Qp = (const bf16*)(F.ws + WS_QMF) + (size_t)((h * 256 + qb) * 8) * 512 + lane * 8;
    const LAS unsigned char* Kp = kv + lane * 16; const LAS unsigned char* Vp = kv + 65536 + lane * 16;
    bf16x8 qf[8];
#pragma unroll
    for (int j = 0; j < 8; ++j) qf[j] = *(const bf16x8*)(Qp + j * 512);
    f32x16 o[4];
#pragma unroll
    for (int d = 0; d < 4; ++d)
#pragma unroll
        for (int r = 0; r < 16; ++r) o[d][r] = 0.f;
#if ONEPASS_LDS
    f32x16 sc[8];
#pragma unroll
    for (int kt = 0; kt < 8; ++kt) {
#pragma unroll
        for (int r = 0; r < 16; ++r) sc[kt][r] = 0.f;
#pragma unroll
        for (int j = 0; j < 8; ++j) sc[kt] = MFMA32(*(const LAS bf16x8*)(Kp + (kt * 8 + j) * 1024), qf[j], sc[kt]);
    }
    float m = sc[0][0];
#pragma unroll
    for (int kt = 0; kt < 8; ++kt)
#pragma unroll
        for (int r = 0; r < 16; ++r) m = fmaxf(m, sc[kt][r]);
    m = fmaxf(m, __shfl_xor(m, 32));
    float lsum = 0.f;
#pragma unroll
    for (int kt = 0; kt < 8; ++kt) {
#pragma unroll
        for (int r = 0; r < 16; ++r) { sc[kt][r] = __builtin_amdgcn_exp2f(sc[kt][r] - m); lsum += sc[kt][r]; }
        bf16x8 pb[2];
#pragma unroll
        for (int s2 = 0; s2 < 2; ++s2) { v4u w; w.x = pkbf(sc[kt][8 * s2 + 0], sc[kt][8 * s2 + 1]); w.y = pkbf(sc[kt][8 * s2 + 2], sc[kt][8 * s2 + 3]); w.z = pkbf(sc[kt][8 * s2 + 4], sc[kt][8 * s2 + 5]); w.w = pkbf(sc[kt][8 * s2 + 6], sc[kt][8 * s2 + 7]); pb[s2] = __builtin_bit_cast(bf16x8, w); }
#pragma unroll
        for (int d = 0; d < 4; ++d)
#pragma unroll
            for (int s2 = 0; s2 < 2; ++s2) o[d] = MFMA32(*(const LAS bf16x8*)(Vp + (kt * 8 + d * 2 + s2) * 1024), pb[s2], o[d]);
    }
#else
    float m = -1e30f, lsum = 0.f;
#pragma clang loop unroll(disable)
    for (int kt = 0; kt < 8; ++kt) {
        f32x16 p;
#pragma unroll
        for (int r = 0; r < 16; ++r) p[r] = 0.f;
#pragma unroll
        for (int j = 0; j < 8; ++j) p = MFMA32(*(const LAS bf16x8*)(Kp + (kt * 8 + j) * 1024), qf[j], p);
        bf16x8 pb[2]; softmax_tile<4>(p, m, lsum, o, pb);
#pragma unroll
        for (int d = 0; d < 4; ++d)
#pragma unroll
            for (int s2 = 0; s2 < 2; ++s2) o[d] = MFMA32(*(const LAS bf16x8*)(Vp + (kt * 8 + d * 2 + s2) * 1024), pb[s2], o[d]);
    }
#endif
    lsum += __shfl_xor(lsum, 32); const float inv = 1.0f / lsum;
    bf16* yp = Y + (size_t)(qb * 32 + r32) * cfg::PD + 1536 + h * 128;
#pragma unroll
    for (int d = 0; d < 4; ++d) store_o32(yp + d * 32, o[d], inv, hi);
}
__device__ __forceinline__ void swa_item_lds(Frame& F, int l, int hq, int qb, const LAS unsigned char* kv, int t0c) {
    const int lane = opaque_lane(), r32 = lane & 31, hi = lane >> 5;
    bf16* Y = (bf16*)(F.ws + WS_Y);
    const bf16* Qp = (const bf16*)(F.ws + WS_AQ) + (size_t)((hq * 256 + qb) * 4) * 512 + lane * 8;
    const LAS unsigned char* Kp = kv + lane * 16; const LAS unsigned char* Vp = kv + 49152 + lane * 16;
    const int i0 = qb < 4 ? 4 - qb : 0;
    bf16x8 qf[4];
#pragma unroll
    for (int j = 0; j < 4; ++j) qf[j] = *(const bf16x8*)(Qp + j * 512);
    f32x16 o[2];
#pragma unroll
    for (int d = 0; d < 2; ++d)
#pragma unroll
        for (int r = 0; r < 16; ++r) o[d][r] = 0.f;
    float m = F.sinks[(l - 2) * cfg::NQH + hq] * cfg::LOG2E, lsum = hi == 0 ? 1.0f : 0.0f;
#pragma clang loop unroll(disable)
    for (int i = i0; i < 5; ++i) { const int sl = qb - 4 + i - t0c;
        f32x16 p;
#pragma unroll
        for (int r = 0; r < 16; ++r) p[r] = 0.f;
#pragma unroll
        for (int j = 0; j < 4; ++j) p = MFMA32(*(const LAS bf16x8*)(Kp + (sl * 4 + j) * 1024), qf[j], p);
        if (i == 0 || i == 4) {
#pragma unroll
            for (int r = 0; r < 16; ++r) { const int jj = (r & 3) + 8 * (r >> 2) + 4 * hi; const bool ok = (i == 0) ? (jj >= r32 + 1) : (jj <= r32); p[r] = ok ? p[r] : -INFINITY; } }
        bf16x8 pb[2]; softmax_tile<2>(p, m, lsum, o, pb);
#pragma unroll
        for (int d = 0; d < 2; ++d)
#pragma unroll
            for (int s2 = 0; s2 < 2; ++s2) o[d] = MFMA32(*(const LAS bf16x8*)(Vp + (sl * 4 + d * 2 + s2) * 1024), pb[s2], o[d]);
    }
    lsum += __shfl_xor(lsum, 32); const float inv = 1.0f / lsum;
    bf16* yp = Y + (size_t)(qb * 32 + r32) * cfg::PD + hq * 64;
#pragma unroll
    for (int d = 0; d < 2; ++d) store_o32(yp + d * 32, o[d], inv, hi);
}
template <int W> __device__ __forceinline__ void poolw_run(const float* Z, bf16* Y, const float* scale, int c, int t0) {
    f32x4 z[W + 7];
#pragma unroll
    for (int k = 0; k < W + 7; ++k) { const int j = t0 - (W - 1) + k; z[k] = j >= 0 ? *(const f32x4*)(Z + (size_t)j * cfg::MIX + c) : (f32x4){0.f, 0.f, 0.f, 0.f}; }
    const f32x4 sc = *(const f32x4*)(scale + c);
    f32x4 s = z[0];
#pragma unroll
    for (int k = 1; k < W; ++k) s += z[k];
#pragma unroll
    for (int i = 0; i < 8; ++i) { const int t = t0 + i;
        if (i > 0) s += z[W - 1 + i] - z[i - 1];
        const float rc = 1.0f / (float)(t + 1 < W ? t + 1 : W); const f32x4 y = (s * rc - z[W - 1 + i]) * sc;
        v2u o; o.x = pkbf(y[0], y[1]); o.y = pkbf(y[2], y[3]); *(v2u*)(Y + (size_t)t * cfg::PD + c) = o; }
}
template <int W> __device__ __forceinline__ void poolw_run_u(const bf16* U, bf16* Y, int c, int t0) {
    f32x4 z[W + 7];
#pragma unroll
    for (int k = 0; k < W + 7; ++k) { const int j = t0 - (W - 1) + k; v2u r; r.x = 0u; r.y = 0u; if (j >= 0) r = *(const v2u*)(U + (size_t)j * cfg::PD + c);
        z[k][0] = __uint_as_float(r.x << 16); z[k][1] = __uint_as_float(r.x & 0xffff0000u); z[k][2] = __uint_as_float(r.y << 16); z[k][3] = __uint_as_float(r.y & 0xffff0000u); }
    f32x4 s = z[0];
#pragma unroll
    for (int k = 1; k < W; ++k) s += z[k];
#pragma unroll
    for (int i = 0; i < 8; ++i) { const int t = t0 + i;
        if (i > 0) s += z[W - 1 + i] - z[i - 1];
        const float rc = 1.0f / (float)(t + 1 < W ? t + 1 : W); const f32x4 y = s * rc - z[W - 1 + i];
        v2u o; o.x = pkbf(y[0], y[1]); o.y = pkbf(y[2], y[3]); *(v2u*)(Y + (size_t)t * cfg::PD + c) = o; }
}
__device__ __forceinline__ void poolw_item(Frame& F, int l, int chunk, int rb) {
    const float* Z = (const float*)(F.ws + WS_Z); bf16* Y = (bf16*)(F.ws + WS_Y);
    const int lane = opaque_lane(), g = chunk / 3, c = chunk * 128 + (lane & 31) * 4, t0 = rb * 16 + 8 * (lane >> 5);
    const float* scale = F.pool_scale + (size_t)l * cfg::MIX;
#if POOL_FOLD
    const bf16* U = (const bf16*)(F.ws + WS_AQ); (void)Z; (void)scale;
    if (g == 0) poolw_run_u<2>(U, Y, c, t0); else if (g == 1) poolw_run_u<4>(U, Y, c, t0); else if (g == 2) poolw_run_u<8>(U, Y, c, t0); else poolw_run_u<16>(U, Y, c, t0);
#else
    if (g == 0) poolw_run<2>(Z, Y, scale, c, t0); else if (g == 1) poolw_run<4>(Z, Y, scale, c, t0); else if (g == 2) poolw_run<8>(Z, Y, scale, c, t0); else poolw_run<16>(Z, Y, scale, c, t0);
#endif
}
constexpr int PH_END = 66;
__device__ __forceinline__ int probe_class(int k) { if (k == 0) return 0; if (k >= 65) return 8; const int ii = (k - 1) / 8, j = (k - 1) % 8, ll = ii >> 1; return j == 0 ? 1 : j == 1 ? 2 : j == 2 ? 3 : j == 3 ? 4 : j == 4 ? (ll < 2 ? 5 : 6) : 7; }
struct Args { const float* in[17]; float* out; unsigned char* ws; int ph_lo, ph_hi; };
__global__ void __launch_bounds__(NWAVES * 64, 2) yoco_fwd(Args args) {
    extern __shared__ __attribute__((aligned(16))) unsigned char lds[];
    using namespace cfg;
    Frame F;
    F.lds = (LAS unsigned char*)lds;
    F.MISC = (volatile LAS unsigned*)(F.lds + MISC_OFF);
    F.tid = threadIdx.x; F.lane = F.tid & 63; F.wave = __builtin_amdgcn_readfirstlane(F.tid >> 6);
    F.G = gridDim.x; { const int bx = blockIdx.x; F.vcu = (F.G % 8 == 0) ? (bx % 8) * (F.G / 8) + bx / 8 : bx; }
    F.x = args.in[0]; F.mem = args.in[1]; F.pos = (const int*)args.in[2]; F.norms = args.in[3]; F.gate = args.in[4]; F.up = args.in[5]; F.down = args.in[6]; F.w_in = args.in[7]; F.w_out = args.in[8];
    F.pool_w = args.in[9]; F.pool_scale = args.in[10]; F.w_kv = args.in[11]; F.kv_norm = args.in[12]; F.sinks = args.in[13]; F.w_mem_kv = args.in[14]; F.mem_norm = args.in[15]; F.final_norm = args.in[16];
    F.out = args.out; F.ws = args.ws;
    for (int u = F.tid; u < (LDS_BYTES - LDSCTL_OFF) / 4; u += NWAVES * 64) ((LAS unsigned*)(F.lds + LDSCTL_OFF))[u] = 0u;
    __syncthreads();
    XcdBarrier bar = xcd_barrier_post((unsigned*)(F.ws + WS_CTL) + CW_BAR, F.MISC + 8);
    const int lo = args.ph_lo, hi = args.ph_hi;
#if !PROBE
#define IN(k) (lo <= (k) && (k) < hi)
#else
#define STAMP2(k) ((blockIdx.x == 0 && threadIdx.x == 0) ? (void)__hip_atomic_store((unsigned long long*)(args.ws + 768 * 1024) + 2 * (k), (unsigned long long)__builtin_amdgcn_s_memrealtime(), __ATOMIC_RELAXED, __HIP_MEMORY_SCOPE_AGENT) : (void)0)
#endif
#if PROBE
    unsigned long long* ts = (unsigned long long*)(F.ws + 768 * 1024);
#define STAMP(slot) do { if (blockIdx.x == 0 && F.tid == 0) __hip_atomic_store(ts + (slot), (unsigned long long)__builtin_amdgcn_s_memrealtime(), __ATOMIC_RELAXED, __HIP_MEMORY_SCOPE_AGENT); } while (0)
#define SEAM(k) do { STAMP(2 * (k) + 1); if (PROBE_Q >= 0 && F.tid == 0 && probe_class(k) == PROBE_C) { const unsigned long long t1_ = __builtin_amdgcn_s_memrealtime(); const unsigned long long t0_ = ((unsigned long long)F.MISC[17] << 32) | F.MISC[16]; F.MISC[18] = __float_as_uint(__uint_as_float(F.MISC[18]) + (float)(t1_ - t0_) * 0.01f); } if ((k) + 1 < hi || PROBE) xcd_barrier(bar); } while (0)
#define IN(k) ((lo <= (k) && (k) < hi) && (STAMP2(k), STAMP3(), true))
#define SEAM_G(k) do { STAMP(2 * (k) + 1); if (GROUP_BAR) { ++gcalls; grp_barrier((unsigned*)(F.ws + WS_CTL), mypm, 8u * gcalls, grp_same_xcd); } else xcd_barrier(bar); } while (0)
#define STAMP3() ((PROBE_Q >= 0 && threadIdx.x == 0) ? (void)(tnow_ = __builtin_amdgcn_s_memrealtime(), F.MISC[16] = (unsigned)tnow_, F.MISC[17] = (unsigned)(tnow_ >> 32)) : (void)0)
    unsigned long long tnow_ = 0ull;
#else
#define SEAM_G(k) do { if ((k) + 1 < hi) { if (GROUP_BAR) { ++gcalls; grp_barrier((unsigned*)(F.ws + WS_CTL), mypm, 8u * gcalls, grp_same_xcd); } else xcd_barrier(bar); } } while (0)
#define SEAM(k) do { if ((k) + 1 < hi) { xcd_barrier(bar); if (EXPT == 5) xcd_barrier(bar); if (EXPT == 6) { const unsigned long long t0_ = __builtin_amdgcn_s_memrealtime(); while (__builtin_amdgcn_s_memrealtime() - t0_ < 5000ull) __builtin_amdgcn_s_sleep(32); } } } while (0)
#endif
    unsigned char* ws = F.ws;
    float* H = F.out; bf16* HB = (bf16*)(ws + WS_HB); float* SSQ = (float*)(ws + WS_SSQ); bf16* HFF = (bf16*)(ws + WS_HFF); bf16* AQ = (bf16*)(ws + WS_AQ); bf16* Y = (bf16*)(ws + WS_Y);
    const float* RC = (const float*)(ws + WS_ROPE_C); const float* RS = (const float*)(ws + WS_ROPE_S);
    const int bx = (int)blockIdx.x;
#define KT0(K_) ((KSTAGGER && BAL_DMA && GEMM_SP2) ? ((((bx & 7) * ((K_) / 64)) >> 3) & ~1) : 0)
    int mypm, mypn; { pg8::StaticOrder S0; S0.init(S, D, F.G, bx); pg8::Unit u0; S0.next(0, u0); mypm = u0.pm; mypn = u0.pn; }
    unsigned gcalls = 0u;
    if (GROUP_BAR && F.tid == 0) (void)__hip_atomic_fetch_or((unsigned*)(F.ws + WS_CTL) + CW_GRPX + 64 * mypm, 1u << xb_xcc_id(), __ATOMIC_RELAXED, __HIP_MEMORY_SCOPE_AGENT);
    bool grp_same_xcd = false;

    if (IN(0)) for (int rep = 0; rep < NREP(0); ++rep) { if constexpr (PHON(0)) p0_prologue(F); SEAM(0); }
    if (GROUP_BAR && lo == 0 && hi > 1) {
        const unsigned m = (unsigned)__builtin_amdgcn_readfirstlane((int)__hip_atomic_load((unsigned*)(F.ws + WS_CTL) + CW_GRPX + 64 * mypm, __ATOMIC_RELAXED, __HIP_MEMORY_SCOPE_AGENT));
        grp_same_xcd = (__builtin_popcount(m) == 1) && (GROUP_BAR != 3); }

    for (int i = 0; i < 8; ++i) {
        const int l = i >> 1, half = i & 1, base = 1 + 8 * i;
        if (IN(base)) for (int rep = 0; rep < NREP(1); ++rep) {
            const bf16* WGU = (const bf16*)(ws + WS_WGU + (size_t)i * WGU_BYTES);
            if constexpr (PHON(1)) { pg8::Gemm g{HB, WGU, PD, PD, D}; g.kt0 = KT0(D); pg8::StaticOrder S_; S_.init(S, NGU, F.G, bx); const bool split_tail = (HALFTAIL || SPLITK_TAIL) && i != 0 && i != 4; if (split_tail) S_.maxr = 5; pg8::EpiSwiGLU E{HFF, SSQ, 0};
#if RSTD_LDS
              if (GROUP_BAR) { LAS float* rt_ = (LAS float*)(F.lds + RSTD_TAB_OFF); if (F.tid < 256) rt_[F.tid] = pg8::rstd_of(SSQ, 256 * mypm + F.tid); __syncthreads(); E.rtab = rt_; E.rtab_pm = mypm; }
#endif
#if EXPT
              if (rep) { int ns_ = 1; asm volatile("" : "+s"(ns_)); E.nostore = ns_; S_.flat = (EXPT == 2 || EXPT == 3); if (EXPT == 3) g.A = (const bf16*)(ws + WS_END); }
#endif
#if EXPT == 7 || EXPT == 8
              if (rep) pg8::gemm_phase<pg8::EpiSwiGLU, pg8::StaticOrder, true, GEMM_SP2, false, EXPT - 6>(F.lds + RING_OFF, g, S_, E); else
#endif
#if STAGGER_TICKS
              if (i != 0 && i != 4) { pg8::Unit tu_; if (!S_.next(5, tu_)) { const unsigned long long t0_ = __builtin_amdgcn_s_memrealtime(); while (__builtin_amdgcn_s_memrealtime() - t0_ < (unsigned long long)STAGGER_TICKS) __builtin_amdgcn_s_sleep(16); } }
#endif
              pg8::gemm_phase<pg8::EpiSwiGLU, pg8::StaticOrder, true, GEMM_SP2>(F.lds + RING_OFF, g, S_, E);
#if SPLITK_TAIL
              if (split_tail) {
                  const int j = mypn & 3, role = mypn >> 2, pair = mypm * 4 + j;
                  pg8::Gemm g2{HB + role * 1024, WGU + role * 1024, PD, PD, D / 2}; pg8::OneUnitOrder S2{mypm, 40 + j};
                  pg8::EpiSwiGLUSplit E2{HFF, SSQ, (float*)(ws + WS_SPL + (size_t)pair * 262144), (unsigned*)(ws + WS_CTL) + CW_SPL + 64 * pair, (unsigned*)(ws + WS_CTL) + CW_BAR + XB_TMO, (unsigned)(i < 4 ? i : i - 1), role, grp_same_xcd ? 1 : 0};
                  pg8::gemm_phase<pg8::EpiSwiGLUSplit, pg8::OneUnitOrder, false, GEMM_SP2>(F.lds + RING_OFF, g2, S2, E2); }
#endif
#if HALFTAIL
              if (split_tail) {
                  pg8::StaticOrder S2; S2.init(S, NGU, F.G, bx); S2.halftail = (HALFTAIL == 1); S2.r0 = 5; S2.maxr = 1;
                  pg8::gemm_phase<pg8::EpiSwiGLU, pg8::StaticOrder, false, GEMM_SP2, true>(F.lds + RING_OFF, g, S2, E); }
#endif
              }
            if constexpr (PHON(2)) if (i == 0) {
                pg8::Gemm g{(const bf16*)(ws + WS_MEMN), (const bf16*)(ws + WS_WMKV), PD, PD, D}; g.kt0 = KT0(D); pg8::SubsetOrder S_{128, 16, 16, bx}; pg8::EpiMemKV E{(bf16*)(ws + WS_MK), (bf16*)(ws + WS_MVT)};
                pg8::gemm_phase<pg8::EpiMemKV, pg8::SubsetOrder, false, GEMM_SP2>(F.lds + RING_OFF, g, S_, E); }
            if constexpr (PHON(3)) if (i == 4) {
                pg8::Gemm g{HB, WGU + (size_t)NGU * PD, PD, PD, D}; g.kt0 = KT0(D); pg8::SubsetOrder S_{0, 64, 2, (OWN_KV && (mypn == 4 || mypn == 5)) ? 2 * mypm + (mypn - 4) : (OWN_KV ? -1 : bx - 128)};   pg8::EpiKV E{(bf16*)(ws + WS_KB), (bf16*)(ws + WS_VT), SSQ, RC, RS};
                pg8::gemm_phase<pg8::EpiKV, pg8::SubsetOrder, false, GEMM_SP2>(F.lds + RING_OFF, g, S_, E); }
#if POOL_FOLD
            if (i < 2 && rep == 0) {
                pg8::Gemm g{(const bf16*)(ws + WS_WOUT + (size_t)i * WIO_BYTES), (const bf16*)(ws + WS_WPS) + (size_t)i * 2048 * 384, PD, 384, 384}; g.kt0 = 0;
                pg8::SubsetPoolOrder S_{i == 0 ? 144 : 128, 64, 8, bx}; pg8::EpiFold E{(bf16*)(ws + WS_WOUT2 + (size_t)i * WIO_BYTES)};
                pg8::gemm_phase<pg8::EpiFold, pg8::SubsetPoolOrder, false, GEMM_SP2>(F.lds + RING_OFF, g, S_, E); }
#endif
            if (rep == 0) conv_tail(F, i);
            SEAM_G(base);
        }
        if (IN(base + 1)) for (int rep = 0; rep < NREP(2); ++rep) {
            pg8::Gemm g{HFF, (const bf16*)(ws + WS_WD + (size_t)i * WD_BYTES), PF, PF, FF}; g.kt0 = KT0(FF); pg8::StaticOrder S_; S_.init(S, D, F.G, bx);
            pg8::EpiResid E{(i == 0 && rep == 0) ? F.x : nullptr, HB, (bf16*)(ws + WS_HL), SSQ, rep ? 0.0f : 0.5f, (EXPT == 4 && rep) ? 1 : 0};
#if FINAL_FUSED
            if (GROUP_BAR && i == 7 && hi > 65) { E.OUT = F.out; E.fgain = F.final_norm; E.bctl = (unsigned*)(F.ws + WS_CTL); E.bpm = mypm; E.btarget = 8u * (gcalls + 1); E.bsame = grp_same_xcd; }
#endif
            if constexpr (PHON(4)) pg8::gemm_phase<pg8::EpiResid, pg8::StaticOrder, false, GEMM_SP2>(F.lds + RING_OFF, g, S_, E);
            if (FINAL_FUSED && GROUP_BAR && i == 7 && hi > 65) ++gcalls;
            else if (i == 4 || (!OWN_KV && i == 3) || (!OWN_FINAL && i == 7)) SEAM(base + 1); else SEAM_G(base + 1);
        }
        if (half == 0) {
            if (IN(base + 2)) for (int rep = 0; rep < NREP(3); ++rep) {
                pg8::Gemm g{HB, (const bf16*)(ws + WS_WIN + (size_t)l * WIO_BYTES), PD, PD, D}; g.kt0 = KT0(D); pg8::StaticOrder S_; S_.init(S, D, F.G, bx);
                pg8::EpiWin E{AQ, (bf16*)(ws + WS_QMF), SSQ, RC, RS, l >= 2 ? 1 : 0};
                if constexpr (PHON(5)) pg8::gemm_phase<pg8::EpiWin, pg8::StaticOrder, false, GEMM_SP2>(F.lds + RING_OFF, g, S_, E);
#if FUSE_SWA_MIX
                if (l >= 2) {
                    pg8::Unit u; S_.next(0, u);
                    asm volatile("s_waitcnt vmcnt(0)" ::: "memory");
#if LDS_KV
                    const LAS unsigned char* kvl = (const LAS unsigned char*)(F.lds + RING_OFF);
                    if (u.pn < 6) {
                        const int kvh = u.pn >> 1, t0c = (8 * u.pm - 4) < 0 ? 0 : 8 * u.pm - 4;
                        stage_lds(F, (const bf16*)(ws + WS_KB) + (size_t)((kvh * 256 + t0c) * 4) * 512, RING_OFF, 49152);
                        stage_lds(F, (const bf16*)(ws + WS_VT) + (size_t)((kvh * 256 + t0c) * 4) * 512, RING_OFF + 49152, 49152);
                        asm volatile("s_waitcnt vmcnt(0)" ::: "memory"); __syncthreads();
                        if constexpr (PHON(7)) for (int hh = 0; hh < 4; ++hh) swa_item_lds(F, l, 4 * u.pn + hh, 8 * u.pm + F.wave, kvl, t0c);
                    } else {
                        for (int hb = 0; hb < 2; ++hb) { const int h = 2 * (u.pn - 6) + hb;
                            if (hb) __syncthreads();
                            stage_lds(F, (const bf16*)(ws + WS_MK) + (size_t)((l * 4 + h) * 64) * 512, RING_OFF, 65536);
                            stage_lds(F, (const bf16*)(ws + WS_MVT) + (size_t)((l * 4 + h) * 64) * 512, RING_OFF + 65536, 65536);
                            asm volatile("s_waitcnt vmcnt(0)" ::: "memory"); __syncthreads();
                            if constexpr (PHON(7)) mem_item_lds(F, h, 8 * u.pm + F.wave, kvl); }
                    }
#else
                    if (F.tid == 0) F.MISC[0] = 0u;
                    __syncthreads();
                    const int nit = u.pn < 6 ? 32 : 16;
                    if constexpr (PHON(7)) for (;;) {
                        unsigned idx = 0u;
                        if (F.lane == 0) idx = __hip_atomic_fetch_add((LAS unsigned*)(F.lds + MISC_OFF), 1u, __ATOMIC_RELAXED, __HIP_MEMORY_SCOPE_WORKGROUP);
                        idx = (unsigned)__builtin_amdgcn_readfirstlane((int)idx);
                        if ((int)idx >= nit) break;
                        if (u.pn < 6) swa_item(F, l, 4 * u.pn + ((int)idx >> 3), 8 * u.pm + ((int)idx & 7));
                        else mem_item(F, l, 2 * (u.pn - 6) + ((int)idx >> 3), 8 * u.pm + ((int)idx & 7));
                    }
#endif
                }
#endif
                if (POOL_FOLD && l < 2) SEAM(base + 2); else SEAM_G(base + 2);
            }
            if (!POOL_FOLD && l < 2 && IN(base + 3)) for (int rep = 0; rep < NREP(4); ++rep) {
                pg8::Gemm g{AQ, (const bf16*)(ws + WS_WPOOL) + (size_t)l * 2048 * 384, PD, 384, 384}; g.kt0 = KT0(384); pg8::PoolOrder S_; S_.init(S, D, F.G, bx);
                pg8::EpiPool E{(float*)(ws + WS_Z)};
                if constexpr (PHON(6)) pg8::gemm_phase<pg8::EpiPool, pg8::PoolOrder, false, GEMM_SP2>(F.lds + RING_OFF, g, S_, E);
                SEAM(base + 3);
            }
            if ((l < 2 || !FUSE_SWA_MIX) && IN(base + 4)) for (int rep = 0; rep < (l < 2 ? NREP(5) : NREP(6)); ++rep) {
                if (F.tid == 0) F.MISC[0] = 0u;
#if LDS_KV
                {
                    const int h = OWN_POOLMIX ? (mypn & 3) : (F.vcu & 3);
                    stage_lds(F, (const bf16*)(ws + WS_MK) + (size_t)((l * 4 + h) * 64) * 512, RING_OFF, 65536);
                    stage_lds(F, (const bf16*)(ws + WS_MVT) + (size_t)((l * 4 + h) * 64) * 512, RING_OFF + 65536, 65536);
                    asm volatile("s_waitcnt vmcnt(0)" ::: "memory"); }
#endif
                __syncthreads();
                const int nit = 28;
                if constexpr (PHON(7)) for (;;) {
                    unsigned idx = 0u;
                    if (F.lane == 0) idx = __hip_atomic_fetch_add((LAS unsigned*)(F.lds + MISC_OFF), 1u, __ATOMIC_RELAXED, __HIP_MEMORY_SCOPE_WORKGROUP);
                    idx = (unsigned)__builtin_amdgcn_readfirstlane((int)idx);
                    if ((int)idx >= nit) break;
#if MIXEXP
                    if (rep && ((MIXEXP == 1) != (idx < 4u))) continue;
#endif
                    if (idx < 4u) { if (LDS_KV) mem_item_lds(F, OWN_POOLMIX ? (mypn & 3) : (F.vcu & 3), (OWN_POOLMIX ? 8 * mypm + 4 * (mypn >> 2) : 4 * (F.vcu >> 2)) + (int)idx, (const LAS unsigned char*)(F.lds + RING_OFF)); else if (OWN_POOLMIX) { const int e = 4 * mypn + (int)idx; mem_item(F, l, e >> 3, 8 * mypm + (e & 7)); } else mem_item(F, l, (int)idx, F.vcu); }
                    else if (l < 2) { if (OWN_POOLMIX) { const int e = 24 * mypn + (int)idx - 4; poolw_item(F, l, e % 12, 16 * mypm + e / 12); } else { const int item = 24 * F.vcu + (int)idx - 4; poolw_item(F, l, item % 12, item / 12); } }
                    else { const int k = (int)idx - 4, p = 3 * F.vcu + (k >> 3); swa_item(F, l, (p >> 8) * 8 + (k & 7), p & 255); }
                }
                if (OWN_POOLMIX) SEAM_G(base + 4); else SEAM(base + 4);
            }
            if (IN(base + 5)) for (int rep = 0; rep < NREP(7); ++rep) {
                pg8::Gemm g{Y, (const bf16*)(ws + ((POOL_FOLD && l < 2) ? WS_WOUT2 : WS_WOUT) + (size_t)l * WIO_BYTES), PD, PD, D}; g.kt0 = KT0(D); pg8::StaticOrder S_; S_.init(S, D, F.G, bx);
                pg8::EpiResid E{nullptr, HB, (bf16*)(ws + WS_HL), SSQ, rep ? 0.0f : 1.0f, 0};
                if constexpr (PHON(8)) pg8::gemm_phase<pg8::EpiResid, pg8::StaticOrder, false, GEMM_SP2>(F.lds + RING_OFF, g, S_, E);
                SEAM_G(base + 5);
            }
        }
    }
    if (IN(65) && !(FINAL_FUSED && GROUP_BAR && lo <= 57 + 1)) {
#if OWN_FINAL
        { const int c = 256 * mypn + 4 * F.lane; const f32x4 gg = *(const f32x4*)(F.final_norm + c);
          for (int r0 = F.wave * 32; r0 < F.wave * 32 + 32; r0 += 8) { v2u ra[8], rb[8]; float rs[8];
#pragma unroll
              for (int j = 0; j < 8; ++j) { const int m = 256 * mypm + r0 + j; ra[j] = *(const v2u*)(HB + (size_t)m * PD + c); rb[j] = *(const v2u*)((const bf16*)(ws + WS_HL) + (size_t)m * PD + c); }
#pragma unroll
              for (int j = 0; j < 8; ++j) rs[j] = pg8::rstd_of(SSQ, 256 * mypm + r0 + j);
              asm volatile("" ::: "memory");
#pragma unroll
              for (int j = 0; j < 8; ++j) { const int m = 256 * mypm + r0 + j; const v2u a = ra[j], b = rb[j]; f32x4 h;
                  h[0] = __uint_as_float(a.x << 16) + __uint_as_float(b.x << 16); h[1] = __uint_as_float(a.x & 0xffff0000u) + __uint_as_float(b.x & 0xffff0000u);
                  h[2] = __uint_as_float(a.y << 16) + __uint_as_float(b.y << 16); h[3] = __uint_as_float(a.y & 0xffff0000u) + __uint_as_float(b.y & 0xffff0000u);
                  *(f32x4*)(H + (size_t)m * D + c) = h * rs[j] * gg; } } }
#else
        const int gw = F.vcu * NWAVES + F.wave, NGW = F.G * NWAVES;
        f32x4 gn[8];
#pragma unroll
        for (int j = 0; j < 8; ++j) gn[j] = ((const f32x4*)F.final_norm + F.lane)[64 * j];
        for (int m = gw; m < S; m += NGW) { const float rs = pg8::rstd_of(SSQ, m); f32x4* hr = (f32x4*)(H + (size_t)m * D) + F.lane;
            const v2u* hb = (const v2u*)(HB + (size_t)m * PD) + F.lane; const v2u* hl = (const v2u*)((const bf16*)(ws + WS_HL) + (size_t)m * PD) + F.lane;
            v2u ra[8], rb[8];
#pragma unroll
            for (int j = 0; j < 8; ++j) { ra[j] = hb[64 * j]; rb[j] = hl[64 * j]; }
            asm volatile("" ::: "memory");
#pragma unroll
            for (int j = 0; j < 8; ++j) { const v2u a = ra[j], b = rb[j]; f32x4 h;
                h[0] = __uint_as_float(a.x << 16) + __uint_as_float(b.x << 16); h[1] = __uint_as_float(a.x & 0xffff0000u) + __uint_as_float(b.x & 0xffff0000u);
                h[2] = __uint_as_float(a.y << 16) + __uint_as_float(b.y << 16); h[3] = __uint_as_float(a.y & 0xffff0000u) + __uint_as_float(b.y & 0xffff0000u);
                hr[64 * j] = h * rs * gn[j]; } }
#endif
#if PROBE
        if (F.tid == 0) __hip_atomic_store((unsigned*)(F.ws + 896 * 1024) + blockIdx.x, (unsigned)F.MISC[18], __ATOMIC_RELAXED, __HIP_MEMORY_SCOPE_AGENT);
        SEAM(65);
        if (blockIdx.x == 0 && F.tid == 0 && PROBE_Q >= 0) {
            float mx = -1.f, mn = 1e30f; int amx = 0, amn = 0;
            for (int b = 0; b < (int)gridDim.x; ++b) { const float v = __uint_as_float(__hip_atomic_load((unsigned*)(F.ws + 896 * 1024) + b, __ATOMIC_RELAXED, __HIP_MEMORY_SCOPE_AGENT)); if (v > mx) { mx = v; amx = b; } if (v < mn) { mn = v; amn = b; } }
            float val = 0.f;
            if (PROBE_Q == 0) val = mx * (1.0f / PROBE_SA); else if (PROBE_Q == 1) val = mn * (1.0f / PROBE_SA); else if (PROBE_Q == 2) val = (float)(amx % 8 + 1); else if (PROBE_Q == 3) val = (float)(amx / 8) * 0.25f + 1.0f; else if (PROBE_Q == 4) val = (float)(amn % 8 + 1); else val = (float)(amn / 8) * 0.25f + 1.0f;
            H[0] += val;
        }
        if (blockIdx.x == 0 && F.tid == 0 && PROBE_Q < 0) {
            float wallA = 0.f, wallB = 0.f;
            unsigned long long prev_start = 0ull; int prev_cls = -1;
            for (int k = 0; k <= 66; ++k) {
                bool ex = (k == 0 || k == 65 || k == 66); int c = (k == 0) ? 0 : 8;
                if (k >= 1 && k <= 64) { const int ii = (k - 1) / 8, j = (k - 1) % 8, ll = ii >> 1; ex = (j <= 1) || (!(ii & 1) && (j == 3 ? ll < 2 : (j == 4 ? (ll < 2 || !FUSE_SWA_MIX) : j <= 5))); c = j == 0 ? 1 : j == 1 ? 2 : j == 2 ? 3 : j == 3 ? 4 : j == 4 ? (ll < 2 ? 5 : 6) : 7; }
                if (!ex) continue;
                const unsigned long long st = (k == 66) ? __hip_atomic_load(ts + 2 * 65 + 1, __ATOMIC_RELAXED, __HIP_MEMORY_SCOPE_AGENT) : __hip_atomic_load(ts + 2 * k, __ATOMIC_RELAXED, __HIP_MEMORY_SCOPE_AGENT);
                if (prev_cls >= 0) { const float us = (float)(st - prev_start) * 0.01f; if (prev_cls == PROBE_A) wallA += us; if (prev_cls == PROBE_B) wallB += us; }
                if (k < 66) { const unsigned long long en = __hip_atomic_load(ts + 2 * k + 1, __ATOMIC_RELAXED, __HIP_MEMORY_SCOPE_AGENT); const float own = (float)(en - st) * 0.01f; if (c + 10 == PROBE_A) wallA += own; if (c + 10 == PROBE_B) wallB += own; }
                prev_start = st; prev_cls = c;
            }
            H[0] += wallA * (1.0f / PROBE_SA);
            const float vb = wallB * (1.0f / PROBE_SB);
            if (vb != 0.f) for (int j = 1; j <= 65536; ++j) H[j] += vb;
        }
#endif
    }
#undef IN
#undef SEAM
}

static int g_grid = 0;
static bool setup_grid() {
    if (g_grid != 0) return g_grid > 0;
    int dev = 0, cus = 0, per_cu = 0;
    if (hipGetDevice(&dev) != hipSuccess || hipDeviceGetAttribute(&cus, hipDeviceAttributeMultiprocessorCount, dev) != hipSuccess) { fprintf(stderr, "kernel_launch: device query failed\n"); g_grid = -1; return false; }
    if (hipFuncSetAttribute((const void*)yoco_fwd, hipFuncAttributeMaxDynamicSharedMemorySize, LDS_BYTES) != hipSuccess) { fprintf(stderr, "kernel_launch: hipFuncSetAttribute failed\n"); g_grid = -1; return false; }
    if (hipOccupancyMaxActiveBlocksPerMultiprocessor(&per_cu, (const void*)yoco_fwd, NWAVES * 64, LDS_BYTES) != hipSuccess || per_cu < 1) { fprintf(stderr, "kernel_launch: occupancy query reports %d workgroups per CU\n", per_cu); }
    (void)hipGetLastError();
    g_grid = cus;
    return true;
}
static void launch_phases(hipStream_t stream, void* const* d_in, void* d_out, void* d_ws, int lo, int hi) {
    Args a{};
    for (int i = 0; i < 17; ++i) a.in[i] = (const float*)d_in[i];
    a.out = (float*)d_out; a.ws = (unsigned char*)d_ws; a.ph_lo = lo; a.ph_hi = hi;
    hipLaunchKernelGGL(yoco_fwd, dim3(g_grid), dim3(NWAVES * 64), LDS_BYTES, stream, a);
}
static bool phase_exists(int k) {
    if (k == 0 || k == 65) return true;
    if (k < 1 || k > 64) return false;
    const int i = (k - 1) / 8, j = (k - 1) % 8, l = i >> 1;
    if (j <= 1) return true;
    if (i & 1) return false;
    if (j == 3) return l < 2;
    if (j == 4) return l < 2 || !FUSE_SWA_MIX;
    return j <= 5;
}
#if DBG
namespace dbg {
template <int FT  , int TR  >
__global__ void __launch_bounds__(256) k_cmp(const void* fast, long fld, const float* orc, long old, int rows, int cols, float fscale, unsigned* res) {
    float md = 0.f, mr = 0.f;
    const size_t n = (size_t)rows * cols;
    for (size_t idx = (size_t)blockIdx.x * 256 + threadIdx.x; idx < n; idx += (size_t)gridDim.x * 256) {
        const int r = (int)(idx / cols), c = (int)(idx % cols);
        const float o = orc[(size_t)r * old + c] * fscale;
        const size_t fo = TR ? (size_t)c * fld + r : (size_t)r * fld + c;
        float f;
        if (FT) { const unsigned short b = ((const unsigned short*)fast)[fo]; f = __uint_as_float((unsigned)b << 16); } else f = ((const float*)fast)[fo];
        float d = fabsf(f - o); if (!(d == d) || d > 1e30f) d = 1e30f;
        md = fmaxf(md, d); mr = fmaxf(mr, fabsf(o));
    }
#pragma unroll
    for (int o = 1; o < 64; o <<= 1) { md = fmaxf(md, __shfl_xor(md, o)); mr = fmaxf(mr, __shfl_xor(mr, o)); }
    if ((threadIdx.x & 63) == 0) { atomicMax(res, __float_as_uint(md)); atomicMax(res + 1, __float_as_uint(mr)); }
}
__global__ void __launch_bounds__(1024) k_report(const unsigned* res, int n, float tol, float* out) {
    __shared__ int first; __shared__ float ratio;
    if (threadIdx.x == 0) { first = -1; ratio = 0.f;
        for (int i = 1; i < n; ++i) { const float d = __uint_as_float(res[2 * i]), r = fmaxf(__uint_as_float(res[2 * i + 1]), 1e-20f); if (d > tol * r) { first = i; ratio = d / r; break; } } }
    __syncthreads();
    if (first >= 0) { const float V = 100.0f * (float)first; int nbad = (int)(fminf(ratio, 1000.f) * 1000.f); nbad = nbad < 1 ? 1 : nbad;
        for (int j = threadIdx.x; j < nbad; j += 1024) out[j] = V; }
}
struct Ctx { hipStream_t st; unsigned* res; };
template <int FT, int TR> static void cmp(const Ctx& c, int id, const void* fast, long fld, const float* orc, long old, int rows, int cols, float fscale = 1.f) {
    hipLaunchKernelGGL((k_cmp<FT, TR>), dim3(2048), dim3(256), 0, c.st, fast, fld, orc, old, rows, cols, fscale, c.res + 2 * id);
}
static void run(hipStream_t st, void* const* d_in, void* d_out, void* d_ws, const ref::In& in) {
    using namespace ref;
    unsigned char* ws = (unsigned char*)d_ws;
    unsigned* res = (unsigned*)(ws + 512 * 1024);
    Ctx c{st, res};
    float* ob = (float*)(ws + WS_END);
    float* Ho = ob; float* XN = Ho + (size_t)S * D; float* G = XN + (size_t)S * D; float* U = G + (size_t)S * FF; float* A = U; float* Yo = U + (size_t)S * D; float* DIFF = U + (size_t)2 * S * D;
    float* KV = U + (size_t)S * FF; float* MEMN = KV + (size_t)S * 384; float* MKV = MEMN + (size_t)ML * D;
    const unsigned short* HBf = (const unsigned short*)(ws + WS_HB); const unsigned short* HFFf = (const unsigned short*)(ws + WS_HFF); const unsigned short* AQf = (const unsigned short*)(ws + WS_AQ); const unsigned short* Yf = (const unsigned short*)(ws + WS_Y);
    auto fast = [&](int k) { launch_phases(st, d_in, d_out, d_ws, k, k + 1); };
    hipLaunchKernelGGL(k_rmsnorm, dim3(ML / 4), dim3(256), 0, st, in.mem, in.mem_norm, MEMN, ML, D);
    fast(0);
    cmp<1, 0>(c, 1, ws + WS_MEMN, cfg::PD, MEMN, D, ML, D);
    cmp<1, 0>(c, 2, HBf, cfg::PD, in.x, D, S, D);
    const float* hin = in.x;
    for (int l = 0; l < DEPTH; ++l) {
        const int idb = 5 + 20 * l;
        for (int half = 0; half < 2; ++half) {
            const int i = 2 * l + half, base = 1 + 8 * i;
            hipLaunchKernelGGL(k_rmsnorm, dim3(S / 4), dim3(256), 0, st, hin, in.norms + (size_t)(l * 3 + (half ? 2 : 0)) * D, XN, S, D);
            const size_t wo = (size_t)i * D * FF;
            gemm<0>(st, XN, D, in.gate + wo, FF, G, FF, S, FF, D);
            gemm<0>(st, XN, D, in.up + wo, FF, U, FF, S, FF, D);
            hipLaunchKernelGGL(k_swiglu, dim3(4096), dim3(256), 0, st, G, U, (size_t)S * FF / 4);
            fast(base);
            cmp<1, 0>(c, idb + (half ? 13 : 1), HFFf, cfg::PF, G, FF, S, FF);
            gemm<1>(st, G, FF, in.down + wo, D, Ho, D, S, D, FF, hin, 0.5f);
            hin = Ho;
            fast(base + 1);
            cmp<1, 0>(c, idb + (half ? 15 : 5), HBf, cfg::PD, Ho, D, S, D);
            if (half == 1) break;
            hipLaunchKernelGGL(k_rmsnorm, dim3(S / 4), dim3(256), 0, st, Ho, in.norms + (size_t)(l * 3 + 1) * D, XN, S, D);
            gemm<0>(st, XN, D, in.w_in + (size_t)l * D * D, D, A, D, S, D, D);
            fast(base + 2);
            if (l >= NA) hipLaunchKernelGGL(k_rope, dim3(S * NQH * 32 / 256), dim3(256), 0, st, A, D, NQH, in.pos);
            if (l < NA) cmp<1, 0>(c, idb + 6, AQf, cfg::PD, A, D, S, MIX, 1.f);
            if (l < NA) {
                hipLaunchKernelGGL(k_pool_diff, dim3(S * MIX / 256), dim3(256), 0, st, A, D, DIFF);
                for (int g = 0; g < 4; ++g) gemm<2>(st, DIFF + g * CG, MIX, in.pool_w + (size_t)(l * 4 + g) * CG * CG, CG, Yo + g * CG, D, S, CG, CG, nullptr, 1.f, in.pool_scale + (size_t)l * MIX + g * CG);
                fast(base + 3);
            } else {
                hipLaunchKernelGGL(k_swa, dim3(S * NQH / 4), dim3(256), 0, st, A, D, KV, 384, in.sinks + (size_t)(l - NA) * NQH, Yo, D);
            }
            gemm<0>(st, MEMN, D, in.w_mem_kv + (size_t)l * D * 1024, 1024, MKV, 1024, ML, 1024, D);
            hipLaunchKernelGGL(k_memattn, dim3(S * MH / 4), dim3(256), 0, st, A, D, MKV, Yo, D);
            fast(base + 4);
            cmp<1, 0>(c, idb + 10, Yf, cfg::PD, Yo, D, S, MIX);
            cmp<1, 0>(c, idb + 11, Yf + MIX, cfg::PD, Yo + MIX, D, S, 512);
            gemm<1>(st, Yo, D, in.w_out + (size_t)l * D * D, D, Ho, D, S, D, D, Ho, 1.0f);
            fast(base + 5);
        }
        if (l == NA - 1) {
            hipLaunchKernelGGL(k_rmsnorm, dim3(S / 4), dim3(256), 0, st, Ho, in.kv_norm, XN, S, D);
            gemm<0>(st, XN, D, in.w_kv, 384, KV, 384, S, 384, D);
            hipLaunchKernelGGL(k_rope, dim3(S * NKVH * 32 / 256), dim3(256), 0, st, KV, 384, NKVH, in.pos);
        }
    }
    hipLaunchKernelGGL(k_rmsnorm, dim3(S / 4), dim3(256), 0, st, Ho, in.final_norm, XN, S, D);
    fast(65);
    cmp<0, 0>(c, 90, d_out, D, XN, D, S, D);
    hipLaunchKernelGGL(k_report, dim3(1), dim3(1024), 0, st, res, 100, 0.05f, (float*)d_out);
}
}
#endif

extern "C" void kernel_launch(void* const* d_in, const int* in_sizes, int n_in, void* d_out, int out_size, void* d_ws, size_t ws_size, hipStream_t stream) {
    const size_t need = DBG ? WS_END + (size_t)495 * MiB : WS_END;
    if (n_in != 17 || out_size != cfg::S * cfg::D || ws_size < need) { fprintf(stderr, "kernel_launch: unexpected shapes n_in %d out %d ws %zu (need %zu)\n", n_in, out_size, ws_size, need); return; }
    if (!setup_grid()) return;
#if EXPT == 3
    (void)hipMemsetAsync((char*)d_ws + WS_END, 0, 2 * MiB, stream);
#endif
    if (hipMemsetAsync((char*)d_ws + WS_CTL, 0, CTL_ZERO_BYTES, stream) != hipSuccess) { fprintf(stderr, "kernel_launch: hipMemsetAsync failed\n"); return; }
#if DBG
    ref::In in;
    in.x = (const float*)d_in[0]; in.mem = (const float*)d_in[1]; in.pos = (const int*)d_in[2]; in.norms = (const float*)d_in[3];
    in.gate = (const float*)d_in[4]; in.up = (const float*)d_in[5]; in.down = (const float*)d_in[6]; in.w_in = (const float*)d_in[7]; in.w_out = (const float*)d_in[8];
    in.pool_w = (const float*)d_in[9]; in.pool_scale = (const float*)d_in[10]; in.w_kv = (const float*)d_in[11]; in.kv_norm = (const float*)d_in[12]; in.sinks = (const float*)d_in[13];
    in.w_mem_kv = (const float*)d_in[14]; in.mem_norm = (const float*)d_in[15]; in.final_norm = (const float*)d_in[16];
    dbg::run(stream, d_in, d_out, d_ws, in);
#elif defined(SPLIT_PHASES)
    for (int k = 0; k < PH_END; ++k) if (phase_exists(k)) launch_phases(stream, d_in, d_out, d_ws, k, k + 1);
#else
    launch_phases(stream, d_in, d_out, d_ws, 0, PH_END);
#endif
}
```
